# Optimizing an MI355X kernel written in HIP

```python
import jax, jax.numpy as jnp
from jax import lax
import numpy as np

D_MODEL = 1024
BATCH = 16
SEQ = 256
DEPTH = 2
DEC_BATCH = 4
DEC_SEQ = 4096
PAST_LEN = 512

GRID_W = 64
N_EVEN = (DEPTH + 1) // 2
N_ODD = DEPTH // 2
D_FF = 4 * D_MODEL
EPS = 1e-6
SGU_CHUNK = 128
SGU_GROUPS = 4
SGU_WIDTH = D_MODEL // 2
SGU_GD = SGU_WIDTH // SGU_GROUPS
GLA_HEADS = 4
GLA_DV = (D_MODEL // 2) // GLA_HEADS
GLA_DK = GLA_DV // 2
GLA_RANK = 16
GLA_NORMALIZER = 16.0
GLA_CHUNK = 64
EV_SPLITS = (SGU_WIDTH,
             2 * SGU_WIDTH,
             2 * SGU_WIDTH + GLA_HEADS * GLA_DK,
             2 * SGU_WIDTH + 2 * GLA_HEADS * GLA_DK,
             2 * SGU_WIDTH + 2 * GLA_HEADS * GLA_DK + GLA_HEADS * GLA_DV,
             2 * SGU_WIDTH + 2 * GLA_HEADS * GLA_DK + 2 * GLA_HEADS * GLA_DV,
             2 * SGU_WIDTH + 2 * GLA_HEADS * GLA_DK + 2 * GLA_HEADS * GLA_DV + GLA_RANK)
EV_IN = 2 * SGU_WIDTH + 2 * GLA_HEADS * GLA_DK + 2 * GLA_HEADS * GLA_DV + 2 * GLA_RANK
EV_OUT = SGU_WIDTH + GLA_HEADS * GLA_DV
D_RNN = D_MODEL
RG_BLOCKS = 16
RG_BS = D_RNN // RG_BLOCKS
RG_CONV = 4
RG_PAD_L = 2
RG_PAD_R = 1
RG_C = 8.0

kernel_name = "hybrid_sgu_gla_rglru_diffusion_step"


def rmsnorm(x, g):
    xf = x.astype(jnp.float32)
    y = xf * lax.rsqrt(jnp.mean(xf * xf, axis=-1, keepdims=True) + EPS)
    return (y * g.astype(jnp.float32)).astype(x.dtype)


def layernorm(x, g, b):
    xf = x.astype(jnp.float32)
    mu = jnp.mean(xf, axis=-1, keepdims=True)
    xc = xf - mu
    y = xc * lax.rsqrt(jnp.mean(xc * xc, axis=-1, keepdims=True) + EPS)
    return (y * g.astype(jnp.float32) + b.astype(jnp.float32)).astype(x.dtype)


def grid_pos_embed(L, dtype):
    rows = L // GRID_W
    n = D_MODEL // 4
    omega = 1.0 / (10000.0 ** (jnp.arange(n, dtype=jnp.float32) / n))
    r = jnp.broadcast_to(jnp.arange(rows, dtype=jnp.float32)[:, None], (rows, GRID_W)).reshape(L)
    cc = jnp.broadcast_to(jnp.arange(GRID_W, dtype=jnp.float32)[None, :], (rows, GRID_W)).reshape(L)
    ar = r[:, None] * omega
    ac = cc[:, None] * omega
    return jnp.concatenate([jnp.sin(ar), jnp.cos(ar), jnp.sin(ac), jnp.cos(ac)], axis=-1).astype(dtype)


def gla_chunked(q, k, v, log_a, s0):
    B, H, L, DK = q.shape
    DV = v.shape[-1]
    n = L // GLA_CHUNK
    q, k, v, log_a = (t.reshape(B, H, n, GLA_CHUNK, t.shape[-1]) for t in (q, k, v, log_a))
    b = jnp.cumsum(log_a, axis=3)
    b_last = b[:, :, :, -1:, :]
    q_e = q * jnp.exp(b)
    k_e = k * jnp.exp(-b)
    k_d = k * jnp.exp(b_last - b)
    mask = jnp.tril(jnp.ones((GLA_CHUNK, GLA_CHUNK), dtype=bool))
    att = jnp.where(mask, jnp.einsum('bhnid,bhnjd->bhnij', q_e, k_e), 0.0)
    o_intra = jnp.einsum('bhnij,bhnjv->bhniv', att, v)
    ds = jnp.einsum('bhnjd,bhnjv->bhndv', k_d, v)
    decay = jnp.exp(b_last[:, :, :, 0, :])

    def step(s, inp):
        dec, d = inp
        return dec[..., None] * s + d, s

    s_final, s_in = lax.scan(step, s0, (jnp.moveaxis(decay, 2, 0), jnp.moveaxis(ds, 2, 0)))
    s_in = jnp.moveaxis(s_in, 0, 2)
    o_inter = jnp.einsum('bhnid,bhndv->bhniv', q_e, s_in)
    return (o_intra + o_inter).reshape(B, H, L, DV), s_final


def linear_scan(a, b, h0, reverse):
    idx = -1 if reverse else 0
    b = b.at[:, idx].add(a[:, idx] * h0)

    def combine(left, right):
        a_l, b_l = left
        a_r, b_r = right
        return a_l * a_r, a_r * b_l + b_r

    _, hs = lax.associative_scan(combine, (a, b), reverse=reverse, axis=1)
    final = hs[:, 0] if reverse else hs[:, -1]
    return hs, final


def even_mixer(hin, s0, w_in, w_out, ln_g, ln_b, ws, bs, gw2, gb, gnorm):
    B, L, _ = hin.shape
    u, v, q, k, vv, g, lr_f, lr_b = jnp.split(hin @ w_in, EV_SPLITS, axis=-1)
    u = jax.nn.gelu(u)
    v = layernorm(jax.nn.gelu(v), ln_g, ln_b)
    n = L // SGU_CHUNK
    v = v.reshape(B, n, SGU_CHUNK, SGU_GROUPS, SGU_GD)
    sv = jnp.einsum('gpq,bnqgd->bnpgd', ws, v) + bs.T[None, None, :, :, None]
    out_a = u * sv.reshape(B, L, SGU_WIDTH)
    def heads(t):
        return t.reshape(B, L, GLA_HEADS, -1).transpose(0, 2, 1, 3).astype(jnp.float32)
    qh = heads(q) * (GLA_DK ** -0.5)
    kh = heads(k)
    vh = heads(vv)
    la_f = jax.nn.log_sigmoid(heads(lr_f @ gw2[0] + gb[0])) / GLA_NORMALIZER
    la_b = jax.nn.log_sigmoid(heads(lr_b @ gw2[1] + gb[1])) / GLA_NORMALIZER
    s0 = s0.astype(jnp.float32)
    o_f, sf = gla_chunked(qh, kh, vh, la_f, s0[:, 0])
    rev = lambda t: jnp.flip(t, axis=2)
    o_b, sb = gla_chunked(rev(qh), rev(kh), rev(vh), rev(la_b), s0[:, 1])
    o = o_f + rev(o_b)
    o = o * lax.rsqrt(jnp.mean(o * o, axis=-1, keepdims=True) + EPS) \
        * gnorm.reshape(GLA_HEADS, 1, GLA_DV).astype(jnp.float32)
    o = o.transpose(0, 2, 1, 3).reshape(B, L, GLA_HEADS * GLA_DV).astype(hin.dtype) * jax.nn.silu(g)
    y = jnp.concatenate([out_a, o], axis=-1) @ w_out
    return y, jnp.stack([sf, sb], axis=1)


def odd_mixer(hin, s0, w_in, conv_w, conv_b, wa, ba, wx, bx, lam, w_out):
    B, L, _ = hin.shape
    xb, gbr = jnp.split(hin @ w_in, 2, axis=-1)
    xc = lax.conv_general_dilated(xb, conv_w[:, None, :].astype(xb.dtype), (1,), [(RG_PAD_L, RG_PAD_R)],
                                  dimension_numbers=('NWC', 'WIO', 'NWC'),
                                  feature_group_count=D_RNN) + conv_b
    xf = xc.astype(jnp.float32)
    xblk = xf.reshape(B, L, RG_BLOCKS, RG_BS)
    s0 = s0.astype(jnp.float32)

    def direction(d, reverse):
        r = jax.nn.sigmoid(jnp.einsum('blhi,hij->blhj', xblk, wa[d]).reshape(B, L, D_RNN) + ba[d])
        i = jax.nn.sigmoid(jnp.einsum('blhi,hij->blhj', xblk, wx[d]).reshape(B, L, D_RNN) + bx[d])
        log_a = -RG_C * r * jax.nn.softplus(-lam[d].astype(jnp.float32))
        a = jnp.exp(log_a)
        bt = jnp.sqrt(-jnp.expm1(2.0 * log_a)) * (i * xf)
        return linear_scan(a, bt, s0[:, d], reverse)

    h_f, sf = direction(0, False)
    h_b, sb = direction(1, True)
    y = ((h_f + h_b).astype(hin.dtype) * jax.nn.gelu(gbr)) @ w_out
    return y, jnp.stack([sf, sb], axis=1)


def setup_inputs(seed: int = 0) -> dict:
    key = jax.random.key(seed)
    ks = jax.random.split(key, 32)

    def nrm(k, shape, scale):
        return jax.random.normal(k, shape, jnp.float32) * scale

    D = D_MODEL
    rg_u = jax.random.uniform(ks[29], (N_ODD, 2, D_RNN), jnp.float32, 0.9, 0.999)
    rg_p = rg_u ** (1.0 / RG_C)
    return {
        'x_prompt': nrm(ks[0], (BATCH, SEQ, D), 1.0),
        'x_sample': nrm(ks[1], (DEC_BATCH, DEC_SEQ, D), 1.0),
        'c': nrm(ks[2], (DEC_BATCH, D), 1.0),
        'state_gla': nrm(ks[3], (DEC_BATCH, N_EVEN, 2, GLA_HEADS, GLA_DK, GLA_DV), 1.0),
        'state_rglru': nrm(ks[4], (DEC_BATCH, N_ODD, 2, D_RNN), 1.0),
        'c_ctx': nrm(ks[5], (D,), 1.0),
        'mod_w': nrm(ks[6], (DEPTH, D, 6 * D), D ** -0.5),
        'mod_b': nrm(ks[7], (DEPTH, 6 * D), 0.02),
        'norm_g': 1.0 + nrm(ks[8], (DEPTH, 4, D), 0.02),
        'mlp_w1': nrm(ks[9], (DEPTH, D, D_FF), D ** -0.5),
        'mlp_b1': nrm(ks[10], (DEPTH, D_FF), 0.02),
        'mlp_w2': nrm(ks[11], (DEPTH, D_FF, D), D_FF ** -0.5),
        'mlp_b2': nrm(ks[12], (DEPTH, D), 0.02),
        'ev_w_in': nrm(ks[13], (N_EVEN, D, EV_IN), D ** -0.5),
        'ev_w_out': nrm(ks[14], (N_EVEN, EV_OUT, D), EV_OUT ** -0.5),
        'sgu_ln_g': 1.0 + nrm(ks[15], (N_EVEN, SGU_WIDTH), 0.02),
        'sgu_ln_b': nrm(ks[16], (N_EVEN, SGU_WIDTH), 0.02),
        'sgu_ws': nrm(ks[17], (N_EVEN, SGU_GROUPS, SGU_CHUNK, SGU_CHUNK), SGU_CHUNK ** -0.5),
        'sgu_bs': nrm(ks[18], (N_EVEN, SGU_GROUPS, SGU_CHUNK), 0.02),
        'gla_gate_w2': nrm(ks[19], (N_EVEN, 2, GLA_RANK, GLA_HEADS * GLA_DK), GLA_RANK ** -0.5),
        'gla_gate_b': nrm(ks[20], (N_EVEN, 2, GLA_HEADS * GLA_DK), 0.02),
        'gla_norm_g': 1.0 + nrm(ks[21], (N_EVEN, GLA_HEADS * GLA_DV), 0.02),
        'rg_w_in': nrm(ks[22], (N_ODD, D, 2 * D_RNN), D ** -0.5),
        'rg_conv_w': nrm(ks[23], (N_ODD, RG_CONV, D_RNN), RG_CONV ** -0.5),
        'rg_conv_b': nrm(ks[24], (N_ODD, D_RNN), 0.02),
        'rg_wa': nrm(ks[25], (N_ODD, 2, RG_BLOCKS, RG_BS, RG_BS), RG_BS ** -0.5),
        'rg_ba': nrm(ks[26], (N_ODD, 2, D_RNN), 0.02),
        'rg_wx': nrm(ks[27], (N_ODD, 2, RG_BLOCKS, RG_BS, RG_BS), RG_BS ** -0.5),
        'rg_bx': nrm(ks[28], (N_ODD, 2, D_RNN), 0.02),
        'rg_L': jnp.log(rg_p) - jnp.log1p(-rg_p),
        'rg_w_out': nrm(ks[30], (N_ODD, D_RNN, D), D_RNN ** -0.5),
    }


def reference(x_prompt, x_sample, c, state_gla, state_rglru, c_ctx, mod_w, mod_b, norm_g,
              mlp_w1, mlp_b1, mlp_w2, mlp_b2, ev_w_in, ev_w_out, sgu_ln_g, sgu_ln_b, sgu_ws, sgu_bs,
              gla_gate_w2, gla_gate_b, gla_norm_g, rg_w_in, rg_conv_w, rg_conv_b, rg_wa, rg_ba,
              rg_wx, rg_bx, rg_L, rg_w_out):
    def trunk(x, cond, gla_init, rg_init):
        gla_fin = []
        rg_fin = []
        for i in range(DEPTH):
            mod = (jax.nn.silu(cond) @ mod_w[i] + mod_b[i])[:, None, :]
            sh1, sc1, g1, sh2, sc2, g2 = jnp.split(mod, 6, axis=-1)
            hmix = rmsnorm(x, norm_g[i, 0]) * (1.0 + sc1) + sh1
            if i % 2 == 0:
                e = i // 2
                y, s = even_mixer(hmix, gla_init[:, e], ev_w_in[e], ev_w_out[e], sgu_ln_g[e], sgu_ln_b[e],
                                  sgu_ws[e], sgu_bs[e], gla_gate_w2[e], gla_gate_b[e], gla_norm_g[e])
                gla_fin.append(s)
            else:
                o = i // 2
                y, s = odd_mixer(hmix, rg_init[:, o], rg_w_in[o], rg_conv_w[o], rg_conv_b[o], rg_wa[o],
                                 rg_ba[o], rg_wx[o], rg_bx[o], rg_L[o], rg_w_out[o])
                rg_fin.append(s)
            x = x + g1 * rmsnorm(y, norm_g[i, 1])
            hff = rmsnorm(x, norm_g[i, 2]) * (1.0 + sc2) + sh2
            f = jnp.square(jax.nn.relu(hff @ mlp_w1[i] + mlp_b1[i])) @ mlp_w2[i] + mlp_b2[i]
            x = x + g2 * rmsnorm(f, norm_g[i, 3])
        return x, jnp.stack(gla_fin, axis=1), jnp.stack(rg_fin, axis=1)

    nb = x_prompt.shape[0]
    gla_zero = jnp.zeros((nb, N_EVEN, 2, GLA_HEADS, GLA_DK, GLA_DV), jnp.float32)
    rg_zero = jnp.zeros((nb, N_ODD, 2, D_RNN), jnp.float32)
    y_prompt, new_state_gla, new_state_rglru = trunk(x_prompt, c_ctx[None, :], gla_zero, rg_zero)
    xs = x_sample + grid_pos_embed(x_sample.shape[1], x_sample.dtype)[None]
    y_sample, _, _ = trunk(xs, c, state_gla, state_rglru)
    return (y_prompt, y_sample, new_state_gla, new_state_rglru)
```

```cpp
#include <hip/hip_runtime.h>
#include <hip/hip_cooperative_groups.h>
#include <cstdio>
namespace pg8 {
#define PG8_LAS __attribute__((address_space(3)))
typedef unsigned short bf16_t;
typedef short bf16x8 __attribute__((ext_vector_type(8)));
typedef float f32x4 __attribute__((ext_vector_type(4)));
typedef unsigned u32x4 __attribute__((ext_vector_type(4)));
constexpr int BM = 256, BK = 64, HALF = 128, HTB = HALF * BK * 2  , STAGE_BYTES = 8 * HTB, NXCD = 8, WGM = 8;

__host__ __device__ __forceinline__ int lds_byte(int r, int c) { const int st = (r >> 4) * 2 + (c >> 5), rr = r & 15, cc = c & 31, ob = rr * 64 + cc * 2; return st * 1024 + (ob ^ (((ob >> 9) & 1) << 5)); }
__host__ __device__ __forceinline__ void stage_rc(int b, int& R, int& C) { const int st = b / 1024, sb = b % 1024, swz = sb ^ (((sb >> 9) & 1) << 5); R = (st >> 1) * 16 + swz / 64; C = (st & 1) * 32 + (swz % 64) / 2; }
__host__ __device__ __forceinline__ int perm32(int rho) { const int n = rho >> 4, i = rho & 15; return 8 * (i >> 2) + 4 * n + (i & 3); }

struct Unit { int pm, pn; };
struct Gemm { const bf16_t* A; const bf16_t* Bt; int M, N, K; };

struct StaticOrder {
    int nM, nN, nwg, G, c;
    __host__ __device__ void init(int M, int N, int G_, int c_) { nM = M / BM; nN = N / BM; nwg = nM * nN; G = G_; c = c_; }
    __host__ __device__ bool next(int i, Unit& u) const {
        const long L = (long)i * G + c; if (L >= nwg) return false;
        int wgid = (int)L; { const int q = nwg / NXCD, r = nwg % NXCD, xcd = wgid % NXCD, off = wgid / NXCD; wgid = (xcd < r ? xcd * (q + 1) : r * (q + 1) + (xcd - r) * q) + off; }
        const int nig = WGM * nN, gid = wgid / nig, fm = gid * WGM, gsz = (nM - fm) < WGM ? (nM - fm) : WGM;
        u.pm = fm + ((wgid % nig) % gsz); u.pn = (wgid % nig) / gsz; return true;
    }
    __device__ __forceinline__ void a_ready(const Unit&) const {}
    __device__ __forceinline__ void done(const Unit&) const {}
};
typedef __bf16 bf16x2_n __attribute__((ext_vector_type(2)));
typedef float f32x2_n __attribute__((ext_vector_type(2)));
__device__ __forceinline__ unsigned cvt_pk_bf16(float lo, float hi) { f32x2_n v = {lo, hi}; bf16x2_n b = __builtin_convertvector(v, bf16x2_n); return __builtin_bit_cast(unsigned, b); }
typedef float f32x2 __attribute__((ext_vector_type(2)));
template <class Epi, class Sched, bool STAMP = false>
__device__ __forceinline__ void gemm_phase(PG8_LAS unsigned char* lds, const Gemm g, const Sched& S, const Epi& E, unsigned long long* stamps) {
    int tid_o = threadIdx.x; asm volatile("" : "+v"(tid_o)); const int tid = tid_o, wid = __builtin_amdgcn_readfirstlane(tid >> 6), lane = tid & 63, wr = wid >> 2, wc = wid & 3, fr = lane & 15, fq = lane >> 4;
    const int K = g.K, nt = K / BK;
    int ts_lo = 0, ts_hi = 0, nts = 0; const unsigned long long rt_entry = STAMP ? (unsigned long long)wall_clock64() : 0ull;
#define PG8_STAMP() do { if (STAMP && wid == 0 && nts < 64) { const unsigned long long _c = (unsigned long long)clock64(); \
        ts_lo = (lane == nts) ? (int)(unsigned)_c : ts_lo; ts_hi = (lane == nts) ? (int)(unsigned)(_c >> 32) : ts_hi; ++nts; } } while (0)
    PG8_STAMP();
    unsigned voffA[2], voffB[2];
#pragma unroll
    for (int i = 0; i < 2; ++i) { int R, C; stage_rc(tid * 16 + i * 8192, R, C); const int Rb = Epi::PERM ? ((R & ~31) + perm32(R & 31)) : R;
        voffA[i] = (unsigned)(R * K + C) * 2u; voffB[i] = (unsigned)(Rb * K + C) * 2u; }
    const size_t kstep = (size_t)(BK * 2);
    const size_t hstep = (size_t)HALF * K * 2;
    const size_t tstep = 2 * hstep;
    const unsigned ldsw = (unsigned)wid * 1024u;
    const int aoff = lds_byte(wr * 64 + fr, fq * 8), boff = lds_byte(wc * 32 + fr, fq * 8);
#define PG8_SA(b, h) (((b) * 2 + (h)) * HTB)
#define PG8_SB(b, h) ((4 + (b) * 2 + (h)) * HTB)
#define PG8_STAGE(bufoff, gbase, voff) do { _Pragma("unroll") for (int _i = 0; _i < 2; ++_i) \
        __builtin_amdgcn_global_load_lds((const unsigned*)((const char*)(gbase) + (voff)[_i]), (PG8_LAS unsigned*)(lds + (bufoff) + ldsw + _i * 8192), 16, 0, 0); } while (0)
#define PG8_LDA(dst, b, h) do { _Pragma("unroll") for (int m = 0; m < 4; ++m) _Pragma("unroll") for (int k = 0; k < 2; ++k) dst[m][k] = *(const PG8_LAS bf16x8*)(lds + PG8_SA(b, h) + aoff + m * 2048 + k * 1024); } while (0)
#define PG8_LDB(dst, b, h) do { _Pragma("unroll") for (int n = 0; n < 2; ++n) _Pragma("unroll") for (int k = 0; k < 2; ++k) dst[n][k] = *(const PG8_LAS bf16x8*)(lds + PG8_SB(b, h) + boff + n * 2048 + k * 1024); } while (0)
#define PG8_MMA(ai, bj, At, Bt) do { __builtin_amdgcn_s_setprio(1); _Pragma("unroll") for (int m = 0; m < 4; ++m) _Pragma("unroll") for (int n = 0; n < 2; ++n) _Pragma("unroll") for (int k = 0; k < 2; ++k) \
        acc[ai][bj][m][n] = __builtin_amdgcn_mfma_f32_16x16x32_bf16(Bt[n][k], At[m][k], acc[ai][bj][m][n], 0, 0, 0); __builtin_amdgcn_s_setprio(0); } while (0)
#define PG8_WAIT_V(n) asm volatile("s_waitcnt vmcnt(" #n ")" ::: "memory")
#define PG8_WAIT_L(n) asm volatile("s_waitcnt lgkmcnt(" #n ")" ::: "memory")
#define PG8_BAR __builtin_amdgcn_s_barrier()
#define PG8_SCHED __builtin_amdgcn_sched_barrier(0)
    Unit cur, nxt; int ui = 0;
    if (!S.next(0, cur)) return;
    f32x4 acc[2][2][4][2];
#pragma unroll
    for (int a = 0; a < 2; ++a)
#pragma unroll
        for (int b = 0; b < 2; ++b)
#pragma unroll
            for (int m = 0; m < 4; ++m)
#pragma unroll
                for (int n = 0; n < 2; ++n) acc[a][b][m][n] = (f32x4){0.f, 0.f, 0.f, 0.f};
    bf16x8 At[4][2], B0[2][2], B1[2][2];
    const char* cA = (const char*)g.A + (size_t)cur.pm * tstep; const char* cB = (const char*)g.Bt + (size_t)cur.pn * tstep;
    S.a_ready(cur);
    PG8_STAGE(PG8_SB(0, 0), cB, voffB); PG8_STAGE(PG8_SA(0, 0), cA, voffA); PG8_STAGE(PG8_SB(0, 1), cB + hstep, voffB); PG8_STAGE(PG8_SA(0, 1), cA + hstep, voffA);
    if (wr == 1) PG8_BAR;
    PG8_WAIT_V(4); PG8_BAR;
    PG8_STAGE(PG8_SB(1, 0), cB + kstep, voffB); PG8_STAGE(PG8_SA(1, 0), cA + kstep, voffA); PG8_STAGE(PG8_SB(1, 1), cB + hstep + kstep, voffB);
    PG8_WAIT_V(6); PG8_BAR;
    PG8_STAMP();
    for (;;) {
        const bool has_next = S.next(ui + 1, nxt);
        const char* nA = has_next ? (const char*)g.A + (size_t)nxt.pm * tstep : cA; const char* nB = has_next ? (const char*)g.Bt + (size_t)nxt.pn * tstep : cB;
        for (int t = 0; t < nt; t += 2) {
            const bool last = (t == nt - 2);
            const char* a1 = cA + (size_t)(t + 1) * kstep;
            const char* a2 = last ? nA : cA + (size_t)(t + 2) * kstep; const char* b2 = last ? nB : cB + (size_t)(t + 2) * kstep;
            const char* a3 = a2 + kstep; const char* b3 = b2 + kstep;
            if (last && has_next) S.a_ready(nxt);
            PG8_LDB(B0, 0, 0); PG8_SCHED; PG8_LDA(At, 0, 0); PG8_STAGE(PG8_SA(1, 1), a1 + hstep, voffA);
            PG8_WAIT_L(8); PG8_BAR; PG8_WAIT_L(0); PG8_MMA(0, 0, At, B0); PG8_BAR; PG8_SCHED;
            PG8_LDB(B1, 0, 1); PG8_STAGE(PG8_SB(0, 0), b2, voffB);
            PG8_BAR; PG8_WAIT_L(0); PG8_MMA(0, 1, At, B1); PG8_BAR;
            PG8_LDA(At, 0, 1); PG8_STAGE(PG8_SA(0, 0), a2, voffA);
            PG8_BAR; PG8_WAIT_L(0); PG8_MMA(1, 0, At, B0); PG8_BAR; PG8_SCHED;
            PG8_STAGE(PG8_SB(0, 1), b2 + hstep, voffB);
            PG8_WAIT_V(6); PG8_BAR; PG8_MMA(1, 1, At, B1); PG8_BAR;
            PG8_LDB(B0, 1, 0); PG8_SCHED; PG8_LDA(At, 1, 0); PG8_STAGE(PG8_SA(0, 1), a2 + hstep, voffA);
            PG8_WAIT_L(8); PG8_BAR; PG8_WAIT_L(0); PG8_MMA(0, 0, At, B0); PG8_BAR; PG8_SCHED;
            PG8_LDB(B1, 1, 1); PG8_STAGE(PG8_SB(1, 0), b3, voffB);
            PG8_BAR; PG8_WAIT_L(0); PG8_MMA(0, 1, At, B1); PG8_BAR;
            PG8_LDA(At, 1, 1); PG8_STAGE(PG8_SA(1, 0), a3, voffA);
            PG8_BAR; PG8_WAIT_L(0); PG8_MMA(1, 0, At, B0); PG8_BAR; PG8_SCHED;
            PG8_STAGE(PG8_SB(1, 1), b3 + hstep, voffB);
            PG8_WAIT_V(6); PG8_BAR; PG8_MMA(1, 1, At, B1); PG8_BAR;
        }
        PG8_STAMP();
        if constexpr (!Epi::AFTER_DRAIN) { E(acc, cur, wr, wc, fr, fq); S.done(cur); }
        PG8_STAMP();
        if (!has_next) break;
#pragma unroll
        for (int a = 0; a < 2; ++a)
#pragma unroll
            for (int b = 0; b < 2; ++b)
#pragma unroll
                for (int m = 0; m < 4; ++m)
#pragma unroll
                    for (int n = 0; n < 2; ++n) acc[a][b][m][n] = (f32x4){0.f, 0.f, 0.f, 0.f};
        cur = nxt; cA = nA; cB = nB; ++ui;
    }
    PG8_WAIT_V(0);
    if (wr == 0) PG8_BAR;
    PG8_BAR;
    if constexpr (Epi::AFTER_DRAIN) { E.fused(acc, cur, wr, wc, fr, fq, lds, wid, lane); S.done(cur); }
    PG8_STAMP();
    if (STAMP && wid == 0) { stamps[lane] = lane < nts ? (((unsigned long long)(unsigned)ts_hi << 32) | (unsigned)ts_lo) : 0ull;
        if (lane == 62) stamps[62] = rt_entry; if (lane == 63) stamps[63] = (unsigned long long)wall_clock64(); }
#undef PG8_STAMP
#undef PG8_SA
#undef PG8_SB
#undef PG8_STAGE
#undef PG8_LDA
#undef PG8_LDB
#undef PG8_MMA
#undef PG8_WAIT_V
#undef PG8_WAIT_L
#undef PG8_BAR
#undef PG8_SCHED
}
}

namespace cg = cooperative_groups;
using pg8::bf16_t; using pg8::bf16x8; using pg8::f32x4; using pg8::u32x4; using pg8::cvt_pk_bf16;

#ifndef MK_LAUNCHES
#define MK_LAUNCHES 1
#endif

constexpr int T_TOK = 20480, T_PROMPT = 4096, DM = 1024, DFF = 4096, EVN = 2592, EVNP = 2816;
constexpr int LDS_BYTES = 131072;
constexpr int NPHASE = 19;
constexpr float EPSN = 1e-6f;

constexpr size_t WS_MOD    = 0;
constexpr size_t WS_WEVIN  = 262144;
constexpr size_t WS_WEVOUT = WS_WEVIN  + (size_t)EVNP * 1024 * 2;
constexpr size_t WS_WMLP1  = WS_WEVOUT + (size_t)1024 * 1024 * 2;
constexpr size_t WS_WMLP2  = WS_WMLP1  + (size_t)2 * 4096 * 1024 * 2;
constexpr size_t WS_WRGIN  = WS_WMLP2  + (size_t)2 * 4096 * 1024 * 2;
constexpr size_t WS_WRGOUT = WS_WRGIN  + (size_t)2048 * 1024 * 2;
constexpr size_t WS_WRGG   = WS_WRGOUT + (size_t)1024 * 1024 * 2;
constexpr size_t WS_WSGU   = WS_WRGG   + (size_t)16 * 256 * 64 * 2;
constexpr size_t WS_ABUF   = WS_WSGU   + (size_t)4 * 128 * 128 * 2;
constexpr size_t WS_BIG    = WS_ABUF   + (size_t)T_TOK * 1024 * 2;
constexpr size_t BIG_BYTES = (size_t)T_TOK * 4096 * 2;
constexpr size_t WS_END    = WS_BIG + BIG_BYTES;
static_assert(WS_END <= 268435456ull, "workspace map exceeds 256 MiB");
constexpr size_t BIG_PROJ  = 0;
constexpr size_t BIG_OF    = (size_t)T_TOK * EVN * 2;
constexpr size_t BIG_OB    = BIG_OF + (size_t)T_TOK * 512 * 2;
static_assert(BIG_OB + (size_t)T_TOK * 512 * 2 <= BIG_BYTES, "");
constexpr size_t BIG_Y     = 0;
constexpr size_t BIG_H     = 0;
constexpr size_t BIG_RGP   = 0;
constexpr size_t BIG_RGSUM = (size_t)T_TOK * 2048 * 2;
constexpr size_t BIG_RGCAR = BIG_RGSUM + (size_t)320 * 2 * 2 * 1024 * 4;

struct Params {
    const float* in[31];
    float* out;
    unsigned char* ws;
    int nseq, pad;
    unsigned char seq[64];
    unsigned char dbgv[64];
};

__device__ __forceinline__ float bf2f(unsigned short b) { return __uint_as_float(((unsigned)b) << 16); }
__device__ __forceinline__ float bflo(unsigned w) { return __uint_as_float(w << 16); }
__device__ __forceinline__ float bfhi(unsigned w) { return __uint_as_float(w & 0xffff0000u); }
__device__ __forceinline__ unsigned short f2bf(float f) { return (unsigned short)(cvt_pk_bf16(f, 0.f) & 0xffffu); }
__device__ __forceinline__ float wave_sum(float v) {
#pragma unroll
    for (int o = 32; o > 0; o >>= 1) v += __shfl_xor(v, o, 64);
    return v;
}
__device__ __forceinline__ float gelu_tanh(float x) {
    const float u = 1.5957691216f * (x + 0.044715f * x * x * x);
    return x * __builtin_amdgcn_rcpf(1.0f + __expf(-u));
}
__device__ __forceinline__ float sigmoidf_(float x) { return __builtin_amdgcn_rcpf(1.0f + __expf(-x)); }
__device__ __forceinline__ bf16x8 ldfrag(const unsigned short* base, int pitch, int r0, int k0, int lane) {
    return *(const bf16x8*)(base + (r0 + (lane & 15)) * pitch + k0 + (lane >> 4) * 8);
}
__device__ __forceinline__ int otid() { int t = threadIdx.x; asm volatile("" : "+v"(t)); return t; }
#define MFMA16(a, b, c) __builtin_amdgcn_mfma_f32_16x16x32_bf16((a), (b), (c), 0, 0, 0)

struct EpiGen {
    static constexpr bool PERM = true, AFTER_DRAIN = false;
    void* O; int ldc; const float* bias; int ncols; int mode;
    __device__ __forceinline__ void operator()(const f32x4 (&acc)[2][2][4][2], const pg8::Unit& u, int wr, int wc, int fr, int fq) const {
        const int row0 = u.pm * 256 + wr * 64 + fr, col0 = u.pn * 256 + wc * 32 + 8 * fq;
        const bool act = (mode == 0) ? (u.pn < 4) : ((mode == 3) ? (u.pn >= 4) : false);
        if (mode == 4) {
#pragma unroll
            for (int ai = 0; ai < 2; ++ai)
#pragma unroll
                for (int m = 0; m < 4; ++m) { float* rowp = (float*)O + (size_t)(row0 + ai * 128 + m * 16) * ldc + col0;
#pragma unroll
                    for (int bj = 0; bj < 2; ++bj) { *(f32x4*)(rowp + bj * 128) = acc[ai][bj][m][0]; *(f32x4*)(rowp + bj * 128 + 4) = acc[ai][bj][m][1]; } }
            return;
        }
#pragma unroll
        for (int bj = 0; bj < 2; ++bj) {
            const int col = col0 + bj * 128;
            if (col >= ncols) continue;
            f32x4 b0 = (f32x4){0.f, 0.f, 0.f, 0.f}, b1 = b0;
            if (mode == 1 || mode == 2) { b0 = *(const f32x4*)(bias + col); b1 = *(const f32x4*)(bias + col + 4); }
#pragma unroll
            for (int ai = 0; ai < 2; ++ai)
#pragma unroll
                for (int m = 0; m < 4; ++m) {
                    f32x4 v0 = acc[ai][bj][m][0] + b0, v1 = acc[ai][bj][m][1] + b1;
                    if (mode == 1) {
#pragma unroll
                        for (int j = 0; j < 4; ++j) { float a = fmaxf(v0[j], 0.f), b = fmaxf(v1[j], 0.f); v0[j] = a * a; v1[j] = b * b; }
                    }
                    if (act) {
#pragma unroll
                        for (int j = 0; j < 4; ++j) { v0[j] = gelu_tanh(v0[j]); v1[j] = gelu_tanh(v1[j]); }
                    }
                    u32x4 w; w.x = cvt_pk_bf16(v0[0], v0[1]); w.y = cvt_pk_bf16(v0[2], v0[3]); w.z = cvt_pk_bf16(v1[0], v1[1]); w.w = cvt_pk_bf16(v1[2], v1[3]);
                    *(u32x4*)((bf16_t*)O + (size_t)(row0 + ai * 128 + m * 16) * ldc + col) = w;
                }
        }
    }
};

template <class Epi>
__device__ __forceinline__ void run_gemm(unsigned char* shm, const bf16_t* A, const bf16_t* Bt, int N, int K, const Epi& E) {
    pg8::Gemm g; g.A = A; g.Bt = Bt; g.M = T_TOK; g.N = N; g.K = K;
    pg8::StaticOrder S; S.init(T_TOK, N, (int)gridDim.x, (int)blockIdx.x);
    pg8::gemm_phase<Epi, pg8::StaticOrder, false>((PG8_LAS unsigned char*)shm, g, S, E, nullptr);
}

__device__ void transpose_tile(const float* src, int ldsrc, int k0, int n0, int nvalid, bf16_t* dst, int lddst, float* tile) {
    const int tid = otid();
    {
        const int kk = tid >> 4, n4 = (tid & 15) * 4;
#pragma unroll
        for (int i = 0; i < 2; ++i) {
            const int k = kk + 32 * i;
            float4 v = make_float4(0.f, 0.f, 0.f, 0.f);
            if (n0 + n4 < nvalid) v = *(const float4*)(src + (size_t)(k0 + k) * ldsrc + n0 + n4);
            float* tp = tile + k * 65 + n4; tp[0] = v.x; tp[1] = v.y; tp[2] = v.z; tp[3] = v.w;
        }
    }
    __syncthreads();
    {
        const int nn = tid >> 3, k8 = (tid & 7) * 8;
        float f[8];
#pragma unroll
        for (int j = 0; j < 8; ++j) f[j] = tile[(k8 + j) * 65 + nn];
        u32x4 w; w.x = cvt_pk_bf16(f[0], f[1]); w.y = cvt_pk_bf16(f[2], f[3]); w.z = cvt_pk_bf16(f[4], f[5]); w.w = cvt_pk_bf16(f[6], f[7]);
        *(u32x4*)(dst + (size_t)(n0 + nn) * lddst + k0 + k8) = w;
    }
    __syncthreads();
}

__device__ void phase_prep(const Params& p, unsigned char* shm) {
    const int tid = otid();
    float* fl = (float*)shm;
    constexpr int N_GEMV = 192, N_TR = 5888, N_SGU = 16;
    for (int item = blockIdx.x; item < N_GEMV + N_TR + N_SGU; item += gridDim.x) {
        if (item < N_GEMV) {
            const int l = item / 96, n0 = (item % 96) * 64;
            float* S = fl;
            float* R = fl + 5120;
            for (int e = tid; e < 5120; e += 512) {
                const int c = e >> 10, k = e & 1023;
                const float v = (c == 0) ? p.in[5][k] : p.in[2][(c - 1) * 1024 + k];
                S[e] = v * sigmoidf_(v);
            }
            __syncthreads();
            const int r = tid >> 4, c4 = (tid & 15) * 4;
            float acc[5][4];
#pragma unroll
            for (int c = 0; c < 5; ++c)
#pragma unroll
                for (int j = 0; j < 4; ++j) acc[c][j] = 0.f;
            const float* W = p.in[6] + (size_t)l * 1024 * 6144 + n0 + c4;
#pragma unroll 4
            for (int i = 0; i < 32; ++i) {
                const int k = r + 32 * i;
                const float4 w = *(const float4*)(W + (size_t)k * 6144);
#pragma unroll
                for (int c = 0; c < 5; ++c) { const float s = S[c * 1024 + k]; acc[c][0] += s * w.x; acc[c][1] += s * w.y; acc[c][2] += s * w.z; acc[c][3] += s * w.w; }
            }
#pragma unroll
            for (int c = 0; c < 5; ++c)
#pragma unroll
                for (int j = 0; j < 4; ++j) R[(r * 5 + c) * 64 + c4 + j] = acc[c][j];
            __syncthreads();
            if (tid < 320) {
                const int c = tid >> 6, n = tid & 63;
                float s = p.in[7][l * 6144 + n0 + n];
                for (int rr = 0; rr < 32; ++rr) s += R[(rr * 5 + c) * 64 + n];
                ((float*)(p.ws + WS_MOD))[(l * 5 + c) * 6144 + n0 + n] = s;
            }
            __syncthreads();
        } else if (item < N_GEMV + N_TR) {
            int idx = item - N_GEMV;
            const float* src; bf16_t* dst; int ld, nv, ldd, nkt;
            if (idx < 704) { src = p.in[13]; dst = (bf16_t*)(p.ws + WS_WEVIN); ld = EVN; nv = EVN; ldd = 1024; nkt = 16; }
            else if ((idx -= 704) < 256) { src = p.in[14]; dst = (bf16_t*)(p.ws + WS_WEVOUT); ld = 1024; nv = 1024; ldd = 1024; nkt = 16; }
            else if ((idx -= 256) < 2048) { const int l = idx >> 10; idx &= 1023; src = p.in[9] + (size_t)l * 1024 * 4096; dst = (bf16_t*)(p.ws + WS_WMLP1) + (size_t)l * 4096 * 1024; ld = 4096; nv = 4096; ldd = 1024; nkt = 16; }
            else if ((idx -= 2048) < 2048) { const int l = idx >> 10; idx &= 1023; src = p.in[11] + (size_t)l * 4096 * 1024; dst = (bf16_t*)(p.ws + WS_WMLP2) + (size_t)l * 1024 * 4096; ld = 1024; nv = 1024; ldd = 4096; nkt = 64; }
            else if ((idx -= 2048) < 512) { src = p.in[22]; dst = (bf16_t*)(p.ws + WS_WRGIN); ld = 2048; nv = 2048; ldd = 1024; nkt = 16; }
            else if ((idx -= 512) < 256) { src = p.in[30]; dst = (bf16_t*)(p.ws + WS_WRGOUT); ld = 1024; nv = 1024; ldd = 1024; nkt = 16; }
            else { idx -= 256; const int d = idx >> 5, mat = (idx >> 4) & 1, h = idx & 15;
                src = (mat ? p.in[27] : p.in[25]) + (size_t)(d * 16 + h) * 4096; dst = (bf16_t*)(p.ws + WS_WRGG) + (size_t)h * 256 * 64 + (size_t)(d * 2 + mat) * 4096; ld = 64; nv = 64; ldd = 64; nkt = 1; idx = 0; }
            const int kt = idx % nkt, nt = idx / nkt;
            transpose_tile(src, ld, kt * 64, nt * 64, nv, dst, ldd, fl);
        } else {
            const int it = item - N_GEMV - N_TR;
            const int e = it * 4096 + tid * 8;
            const float4 a = *(const float4*)(p.in[17] + e), b = *(const float4*)(p.in[17] + e + 4);
            u32x4 w; w.x = cvt_pk_bf16(a.x, a.y); w.y = cvt_pk_bf16(a.z, a.w); w.z = cvt_pk_bf16(b.x, b.y); w.w = cvt_pk_bf16(b.z, b.w);
            *(u32x4*)((bf16_t*)(p.ws + WS_WSGU) + e) = w;
        }
    }
}

template <int SRC, bool NEXT>
__device__ void phase_row(const Params& p, const void* ysrc, const float* ng_res, const float* modg  ,
                          const float* ng_next, const float* modn  , int sh_off, int sc_off) {
    const int tid_ = otid(); const int lane = tid_ & 63, wid = tid_ >> 6;
    bf16_t* A = (bf16_t*)(p.ws + WS_ABUF);
    float om[4];
    if (SRC == 0) {
#pragma unroll
        for (int e = 0; e < 4; ++e) om[e] = exp2f(-(float)(lane * 4 + e) * (13.287712379549449f / 256.0f));
    }
    for (int t = blockIdx.x * 8 + wid; t < T_TOK; t += gridDim.x * 8) {
        const int cond = (t < T_PROMPT) ? 0 : 1 + ((t - T_PROMPT) >> 12);
        float4 xv[4];
        float* xo = p.out + (size_t)t * 1024 + lane * 4;
        if (SRC == 0) {
            const float* xi = (t < T_PROMPT) ? (p.in[0] + (size_t)t * 1024) : (p.in[1] + (size_t)(t - T_PROMPT) * 1024);
#pragma unroll
            for (int i = 0; i < 4; ++i) xv[i] = *(const float4*)(xi + lane * 4 + 256 * i);
            if (t >= T_PROMPT) {
                const int tl = (t - T_PROMPT) & 4095;
                const float rr = (float)(tl >> 6), cc = (float)(tl & 63);
#pragma unroll
                for (int i = 0; i < 4; ++i) {
                    const float base = (i < 2) ? rr : cc;
                    float pe[4];
#pragma unroll
                    for (int e = 0; e < 4; ++e) {
                        const float a = base * om[e];
                        const float k = rintf(a * 0.15915494309189535f);
                        float y = fmaf(-k, 6.28318548202514648f, a); y = fmaf(-k, -1.7484555e-07f, y);
                        pe[e] = (i & 1) ? __cosf(y) : __sinf(y);
                    }
                    xv[i].x += pe[0]; xv[i].y += pe[1]; xv[i].z += pe[2]; xv[i].w += pe[3];
                }
            }
        } else {
            float4 yv[4];
            if (SRC == 1) {
                const float* yi = (const float*)ysrc + (size_t)t * 1024 + lane * 4;
#pragma unroll
                for (int i = 0; i < 4; ++i) yv[i] = *(const float4*)(yi + 256 * i);
            } else {
                const bf16_t* yi = (const bf16_t*)ysrc + (size_t)t * 1024 + lane * 4;
#pragma unroll
                for (int i = 0; i < 4; ++i) { const uint2 w = *(const uint2*)(yi + 256 * i); yv[i] = make_float4(bflo(w.x), bfhi(w.x), bflo(w.y), bfhi(w.y)); }
            }
#pragma unroll
            for (int i = 0; i < 4; ++i) xv[i] = *(const float4*)(xo + 256 * i);
            float ss = 0.f;
#pragma unroll
            for (int i = 0; i < 4; ++i) ss += yv[i].x * yv[i].x + yv[i].y * yv[i].y + yv[i].z * yv[i].z + yv[i].w * yv[i].w;
            ss = wave_sum(ss);
            const float r = rsqrtf(ss * (1.0f / 1024.0f) + EPSN);
            const float* gp = modg + cond * 6144 + lane * 4;
#pragma unroll
            for (int i = 0; i < 4; ++i) {
                const float4 g = *(const float4*)(gp + 256 * i), n = *(const float4*)(ng_res + lane * 4 + 256 * i);
                xv[i].x += g.x * (yv[i].x * r * n.x); xv[i].y += g.y * (yv[i].y * r * n.y); xv[i].z += g.z * (yv[i].z * r * n.z); xv[i].w += g.w * (yv[i].w * r * n.w);
            }
        }
#pragma unroll
        for (int i = 0; i < 4; ++i) *(float4*)(xo + 256 * i) = xv[i];
        if (NEXT) {
            float ss = 0.f;
#pragma unroll
            for (int i = 0; i < 4; ++i) ss += xv[i].x * xv[i].x + xv[i].y * xv[i].y + xv[i].z * xv[i].z + xv[i].w * xv[i].w;
            ss = wave_sum(ss);
            const float r = rsqrtf(ss * (1.0f / 1024.0f) + EPSN);
            const float* mp = modn + cond * 6144 + lane * 4;
#pragma unroll
            for (int i = 0; i < 4; ++i) {
                const float4 n = *(const float4*)(ng_next + lane * 4 + 256 * i), sh = *(const float4*)(mp + sh_off + 256 * i), sc = *(const float4*)(mp + sc_off + 256 * i);
                const float h0 = xv[i].x * r * n.x * (1.f + sc.x) + sh.x, h1 = xv[i].y * r * n.y * (1.f + sc.y) + sh.y;
                const float h2 = xv[i].z * r * n.z * (1.f + sc.z) + sh.z, h3 = xv[i].w * r * n.w * (1.f + sc.w) + sh.w;
                uint2 w; w.x = cvt_pk_bf16(h0, h1); w.y = cvt_pk_bf16(h2, h3);
                *(uint2*)(A + (size_t)t * 1024 + lane * 4 + 256 * i) = w;
            }
        }
    }
}

__device__ void phase_gla_combine(const Params& p) {
    const int tid_ = otid(); const int lane = tid_ & 63, wid = tid_ >> 6;
    const bf16_t* proj = (const bf16_t*)(p.ws + WS_BIG + BIG_PROJ);
    const bf16_t* of = (const bf16_t*)(p.ws + WS_BIG + BIG_OF);
    const bf16_t* ob = (const bf16_t*)(p.ws + WS_BIG + BIG_OB);
    bf16_t* A = (bf16_t*)(p.ws + WS_ABUF);
    const float4 gn0 = *(const float4*)(p.in[21] + lane * 8), gn1 = *(const float4*)(p.in[21] + lane * 8 + 4);
    const float gn[8] = {gn0.x, gn0.y, gn0.z, gn0.w, gn1.x, gn1.y, gn1.z, gn1.w};
    for (int t = blockIdx.x * 8 + wid; t < T_TOK; t += gridDim.x * 8) {
        const u32x4 a = *(const u32x4*)(of + (size_t)t * 512 + lane * 8), b = *(const u32x4*)(ob + (size_t)t * 512 + lane * 8);
        const u32x4 g = *(const u32x4*)(proj + (size_t)t * EVN + 2048 + lane * 8);
        float o[8], gg[8];
#pragma unroll
        for (int j = 0; j < 4; ++j) { o[2 * j] = bflo(a[j]) + bflo(b[j]); o[2 * j + 1] = bfhi(a[j]) + bfhi(b[j]); gg[2 * j] = bflo(g[j]); gg[2 * j + 1] = bfhi(g[j]); }
        float ss = 0.f;
#pragma unroll
        for (int j = 0; j < 8; ++j) ss += o[j] * o[j];
#pragma unroll
        for (int m = 8; m > 0; m >>= 1) ss += __shfl_xor(ss, m, 64);
        const float r = rsqrtf(ss * (1.0f / 128.0f) + EPSN);
        float v[8];
#pragma unroll
        for (int j = 0; j < 8; ++j) v[j] = o[j] * r * gn[j] * (gg[j] * sigmoidf_(gg[j]));
        u32x4 w; w.x = cvt_pk_bf16(v[0], v[1]); w.y = cvt_pk_bf16(v[2], v[3]); w.z = cvt_pk_bf16(v[4], v[5]); w.w = cvt_pk_bf16(v[6], v[7]);
        *(u32x4*)(A + (size_t)t * 1024 + 512 + lane * 8) = w;
    }
}

__device__ void sgu_item(const Params& p, unsigned char* shm, int item) {
#ifdef SKIP_SGU
    return;
#endif
    const int tid = otid(), lane = tid & 63, wid = tid >> 6, quad = lane >> 4;
    const int c = item >> 2, g = item & 3, t0 = c * 128;
    const bf16_t* proj = (const bf16_t*)(p.ws + WS_BIG + BIG_PROJ);
    bf16_t* A = (bf16_t*)(p.ws + WS_ABUF);
    float* MU = (float*)shm; float* RS = MU + 128;
    unsigned short* VNT = (unsigned short*)(shm + 1024);
    unsigned short* WSA = (unsigned short*)(shm + 1024 + 34816);
    {
        u32x4 v[16];
#pragma unroll
        for (int rr = 0; rr < 16; ++rr) v[rr] = *(const u32x4*)(proj + (size_t)(t0 + wid * 16 + rr) * EVN + 512 + lane * 8);
#pragma unroll
        for (int rr = 0; rr < 16; ++rr) {
            float s = 0.f, ss = 0.f;
#pragma unroll
            for (int j = 0; j < 4; ++j) { const float a = bflo(v[rr][j]), b = bfhi(v[rr][j]); s += a + b; ss += a * a + b * b; }
            s = wave_sum(s); ss = wave_sum(ss);
            if (lane == 0) { const float mu = s * (1.0f / 512.0f); const float var = fmaxf(ss * (1.0f / 512.0f) - mu * mu, 0.f); MU[wid * 16 + rr] = mu; RS[wid * 16 + rr] = rsqrtf(var + EPSN); }
        }
    }
    {
        const bf16_t* wsg = (const bf16_t*)(p.ws + WS_WSGU) + (size_t)g * 16384;
#pragma unroll
        for (int i = 0; i < 4; ++i) { const int e = tid + 512 * i, row = e >> 4, c8 = (e & 15) * 8; *(u32x4*)(WSA + row * 136 + c8) = *(const u32x4*)(wsg + row * 128 + c8); }
    }
    __syncthreads();
    {
        const int q = tid >> 2, d32 = (tid & 3) * 32;
        const float mu = MU[q], rs = RS[q];
        const bf16_t* src = proj + (size_t)(t0 + q) * EVN + 512 + g * 128 + d32;
        const float* lg = p.in[15] + g * 128 + d32; const float* lb = p.in[16] + g * 128 + d32;
#pragma unroll
        for (int i = 0; i < 4; ++i) {
            const u32x4 w = *(const u32x4*)(src + i * 8);
#pragma unroll
            for (int j = 0; j < 4; ++j) {
                const int d = d32 + i * 8 + 2 * j;
                const float a = (bflo(w[j]) - mu) * rs * lg[i * 8 + 2 * j] + lb[i * 8 + 2 * j];
                const float b = (bfhi(w[j]) - mu) * rs * lg[i * 8 + 2 * j + 1] + lb[i * 8 + 2 * j + 1];
                VNT[d * 136 + q] = f2bf(a); VNT[(d + 1) * 136 + q] = f2bf(b);
            }
        }
    }
    __syncthreads();
    {
        f32x4 acc[8];
#pragma unroll
        for (int dt = 0; dt < 8; ++dt) acc[dt] = (f32x4){0.f, 0.f, 0.f, 0.f};
#pragma unroll
        for (int ks = 0; ks < 4; ++ks) {
            const bf16x8 b = ldfrag(WSA, 136, wid * 16, ks * 32, lane);
#pragma unroll
            for (int dt = 0; dt < 8; ++dt) { const bf16x8 a = ldfrag(VNT, 136, dt * 16, ks * 32, lane); acc[dt] = MFMA16(a, b, acc[dt]); }
        }
        const int pp = wid * 16 + (lane & 15), t = t0 + pp;
        const float bsv = p.in[18][g * 128 + pp];
#pragma unroll
        for (int dt = 0; dt < 8; ++dt) {
            const int d = dt * 16 + quad * 4;
            const uint2 uw = *(const uint2*)(proj + (size_t)t * EVN + g * 128 + d);
            uint2 w; w.x = cvt_pk_bf16(bflo(uw.x) * (acc[dt][0] + bsv), bfhi(uw.x) * (acc[dt][1] + bsv)); w.y = cvt_pk_bf16(bflo(uw.y) * (acc[dt][2] + bsv), bfhi(uw.y) * (acc[dt][3] + bsv));
            *(uint2*)(A + (size_t)t * 1024 + g * 128 + d) = w;
        }
    }
    __syncthreads();
}

__device__ void gla_item(const Params& p, unsigned char* shm, int item) {
    const int tid = otid(), lane = tid & 63, wid = tid >> 6, quad = lane >> 4, l15 = lane & 15;
#ifdef SKIP_GLAP
    if (item >= 128) return;
#endif
    int s, rem;
    if (item < 128) { s = 16 + (item >> 5); rem = item & 31; } else { s = (item - 128) >> 5; rem = (item - 128) & 31; }
    const int h = rem >> 3, dir = (rem >> 2) & 1, sl = rem & 3;
    const int ts = (s < 16) ? s * 256 : T_PROMPT + (s - 16) * 4096, L = (s < 16) ? 256 : 4096, nc = L >> 6;
    const bf16_t* proj = (const bf16_t*)(p.ws + WS_BIG + BIG_PROJ);
    bf16_t* O = (bf16_t*)(p.ws + WS_BIG + (dir ? BIG_OB : BIG_OF));
    unsigned short* QR = (unsigned short*)(shm + 0);
    unsigned short* KR = (unsigned short*)(shm + 8192);
    unsigned short* LR = (unsigned short*)(shm + 16384);
    float* LA = (float*)(shm + 18432);
    float* SEG = (float*)(shm + 34816);
    unsigned short* QE = (unsigned short*)(shm + 36864);
    unsigned short* KE = (unsigned short*)(shm + 46080);
    unsigned short* KDT = (unsigned short*)(shm + 55296);
    unsigned short* VT = (unsigned short*)(shm + 64512);
    unsigned short* ST = (unsigned short*)(shm + 69120);
    unsigned short* ATT = (unsigned short*)(shm + 73728);
    float* GW = (float*)(shm + 82944);
    float* GB = (float*)(shm + 87040);
    float* DEC = (float*)(shm + 87296);
    for (int e = tid; e < 1024; e += 512) { const int r = e >> 6, j = e & 63; GW[e] = p.in[19][(dir * 16 + r) * 256 + h * 64 + j]; }
    if (tid < 64) GB[tid] = p.in[20][dir * 256 + h * 64 + tid];
    const int mt = wid >> 1, nt = wid & 1;
    f32x4 Sacc = (f32x4){0.f, 0.f, 0.f, 0.f};
    if (s >= 16) {
        const float* st = p.in[3] + ((size_t)(((s - 16) * 2 + dir) * 4 + h) * 64) * 128;
#pragma unroll
        for (int j = 0; j < 4; ++j) Sacc[j] = st[(mt * 16 + quad * 4 + j) * 128 + sl * 32 + nt * 16 + l15];
    }
    const int lrow = tid >> 3, lc8 = (tid & 7) * 8;
    u32x4 qreg, kreg, vreg = (u32x4){0, 0, 0, 0};
    auto issue = [&](int n) {
        const int t0 = dir ? (ts + L - 64 * (n + 1)) : (ts + 64 * n);
        const int tq = dir ? (t0 + 63 - lrow) : (t0 + lrow);
        qreg = *(const u32x4*)(proj + (size_t)tq * EVN + 1024 + h * 64 + lc8);
        kreg = *(const u32x4*)(proj + (size_t)tq * EVN + 1280 + h * 64 + lc8);
        if (tid < 256) { const int vr = tid >> 2; const int tv = dir ? (t0 + 63 - vr) : (t0 + vr); vreg = *(const u32x4*)(proj + (size_t)tv * EVN + 1536 + h * 128 + sl * 32 + (tid & 3) * 8); }
        else if (tid < 384) { const int e = tid - 256, r = e >> 1; const int tl = dir ? (t0 + 63 - r) : (t0 + r); vreg = *(const u32x4*)(proj + (size_t)tl * EVN + 2560 + dir * 16 + (e & 1) * 8); }
    };
    unsigned dbgc = 0;
    issue(0);
    for (int n = 0; n < nc; ++n) {
        const int t0 = dir ? (ts + L - 64 * (n + 1)) : (ts + 64 * n);
        *(u32x4*)(QR + lrow * 64 + lc8) = qreg; *(u32x4*)(KR + lrow * 64 + lc8) = kreg;
        if (tid < 256) { const int vr = tid >> 2, d8 = (tid & 3) * 8;
#pragma unroll
            for (int j = 0; j < 4; ++j) { VT[(d8 + 2 * j) * 72 + vr] = (unsigned short)(vreg[j] & 0xffffu); VT[(d8 + 2 * j + 1) * 72 + vr] = (unsigned short)(vreg[j] >> 16); } }
        else if (tid < 384) { const int e = tid - 256; *(u32x4*)(LR + (e >> 1) * 16 + (e & 1) * 8) = vreg; }
        if (n + 1 < nc) issue(n + 1);
        __syncthreads();
        {
            float lrv[16];
            const u32x4 l0 = *(const u32x4*)(LR + lrow * 16), l1 = *(const u32x4*)(LR + lrow * 16 + 8);
#pragma unroll
            for (int j = 0; j < 4; ++j) { lrv[2 * j] = bflo(l0[j]); lrv[2 * j + 1] = bfhi(l0[j]); lrv[8 + 2 * j] = bflo(l1[j]); lrv[8 + 2 * j + 1] = bfhi(l1[j]); }
#ifdef DBG_GLA
            for (int r = 0; r < 4; ++r) if (!(fabsf(Sacc[r]) < 1e30f)) dbgc |= 1u;
#endif
            float z[8];
#pragma unroll
            for (int j = 0; j < 8; ++j) z[j] = GB[lc8 + j];
#pragma unroll
            for (int r = 0; r < 16; ++r) {
                const f32x4 w0 = *(const f32x4*)(GW + r * 64 + lc8), w1 = *(const f32x4*)(GW + r * 64 + lc8 + 4);
#pragma unroll
                for (int j = 0; j < 4; ++j) { z[j] += lrv[r] * w0[j]; z[4 + j] += lrv[r] * w1[j]; }
            }
#pragma unroll
            for (int j = 0; j < 8; ++j) z[j] = (fminf(z[j], 0.f) - __logf(1.0f + __expf(-fabsf(z[j])))) * 0.0625f;
#ifdef DBG_GLA
            for (int j = 0; j < 8; ++j) if (!(fabsf(z[j]) < 10.f)) dbgc |= 2u;
#endif
            *(f32x4*)(LA + lrow * 64 + lc8) = (f32x4){z[0], z[1], z[2], z[3]};
            *(f32x4*)(LA + lrow * 64 + lc8 + 4) = (f32x4){z[4], z[5], z[6], z[7]};
        }
        __syncthreads();
        const int dk = lane, seg = wid;
        float cs[8];
        {
            float run = 0.f;
#pragma unroll
            for (int i = 0; i < 8; ++i) { run += LA[(seg * 8 + i) * 64 + dk]; cs[i] = run; }
            SEG[seg * 64 + dk] = run;
        }
        __syncthreads();
        {
            float pre = 0.f, tot = 0.f;
#pragma unroll
            for (int s2 = 0; s2 < 8; ++s2) { const float v = SEG[s2 * 64 + dk]; if (s2 < seg) pre += v; tot += v; }
            float kd[8];
#pragma unroll
            for (int i = 0; i < 8; ++i) {
                const int row = seg * 8 + i;
                const float b = pre + cs[i];
                const float q = bf2f(QR[row * 64 + dk]) * 0.125f, k = bf2f(KR[row * 64 + dk]);
#ifdef DBG_GLA
                if (!(fabsf(b) < 80.f)) dbgc |= 4u;
                if (!(fabsf(q) < 1e4f) || !(fabsf(k) < 1e4f)) dbgc |= 8u;
#endif
                QE[row * 72 + dk] = f2bf(q * __expf(b));
                KE[row * 72 + dk] = f2bf(k * __expf(-b));
                kd[i] = k * __expf(tot - b);
            }
            u32x4 w; w.x = cvt_pk_bf16(kd[0], kd[1]); w.y = cvt_pk_bf16(kd[2], kd[3]); w.z = cvt_pk_bf16(kd[4], kd[5]); w.w = cvt_pk_bf16(kd[6], kd[7]);
            *(u32x4*)(KDT + dk * 72 + seg * 8) = w;
            if (seg == 0) DEC[dk] = __expf(tot);
            uint2 sw; sw.x = cvt_pk_bf16(Sacc[0], Sacc[1]); sw.y = cvt_pk_bf16(Sacc[2], Sacc[3]);
            *(uint2*)(ST + (nt * 16 + l15) * 72 + mt * 16 + quad * 4) = sw;
        }
        __syncthreads();
#pragma unroll
        for (int tt = 0; tt < 2; ++tt) {
            const int idx = wid * 2 + tt, it = idx >> 2, jt = idx & 3;
            f32x4 acc = (f32x4){0.f, 0.f, 0.f, 0.f};
            if (jt <= it) {
#pragma unroll
                for (int ks = 0; ks < 2; ++ks) { const bf16x8 a = ldfrag(KE, 72, jt * 16, ks * 32, lane), b = ldfrag(QE, 72, it * 16, ks * 32, lane); acc = MFMA16(a, b, acc); }
            }
#ifdef DBG_GLA
            for (int j = 0; j < 4; ++j) if (!(fabsf(acc[j]) < 1e30f)) dbgc |= 16u;
#endif
            const int i = it * 16 + l15, j0 = jt * 16 + quad * 4;
            uint2 w; w.x = cvt_pk_bf16(i >= j0 ? acc[0] : 0.f, i >= j0 + 1 ? acc[1] : 0.f); w.y = cvt_pk_bf16(i >= j0 + 2 ? acc[2] : 0.f, i >= j0 + 3 ? acc[3] : 0.f);
            *(uint2*)(ATT + i * 72 + j0) = w;
        }
        __syncthreads();
        {
            f32x4 acc = (f32x4){0.f, 0.f, 0.f, 0.f};
#pragma unroll
            for (int ks = 0; ks < 2; ++ks) { const bf16x8 a = ldfrag(VT, 72, nt * 16, ks * 32, lane), b = ldfrag(ATT, 72, mt * 16, ks * 32, lane); acc = MFMA16(a, b, acc); }
#pragma unroll
            for (int ks = 0; ks < 2; ++ks) { const bf16x8 a = ldfrag(ST, 72, nt * 16, ks * 32, lane), b = ldfrag(QE, 72, mt * 16, ks * 32, lane); acc = MFMA16(a, b, acc); }
#ifdef DBG_GLA
            for (int j = 0; j < 4; ++j) if (!(fabsf(acc[j]) < 1e30f)) dbgc |= 32u;
#endif
            const int i = mt * 16 + l15; const int t = dir ? (t0 + 63 - i) : (t0 + i);
            uint2 w; w.x = cvt_pk_bf16(acc[0], acc[1]); w.y = cvt_pk_bf16(acc[2], acc[3]);
#ifdef DBG_GLA
            if (s < 16) dbgc |= 2u;
            if ((w.x & 0x7f80u) == 0x7f80u || ((w.x >> 16) & 0x7f80u) == 0x7f80u || (w.y & 0x7f80u) == 0x7f80u || ((w.y >> 16) & 0x7f80u) == 0x7f80u) dbgc |= 16u;
#endif
#ifdef ZERO_O
            if (s < 16) { w.x = 0; w.y = 0; }
#endif
            *(uint2*)(O + (size_t)t * 512 + h * 128 + sl * 32 + nt * 16 + quad * 4) = w;
        }
        {
#pragma unroll
            for (int j = 0; j < 4; ++j) Sacc[j] *= DEC[mt * 16 + quad * 4 + j];
#pragma unroll
            for (int ks = 0; ks < 2; ++ks) { const bf16x8 a = ldfrag(KDT, 72, mt * 16, ks * 32, lane), b = ldfrag(VT, 72, nt * 16, ks * 32, lane); Sacc = MFMA16(a, b, Sacc); }
        }
        __syncthreads();
    }
#ifdef DBG_GLA
    if (dbgc) atomicOr((unsigned*)(p.ws + WS_END) + 1, dbgc | (s < 16 ? 64u : 0u));
#endif
    if (s < 16) {
        float* so = p.out + (size_t)T_TOK * 1024 + ((size_t)((s * 2 + dir) * 4 + h) * 64) * 128;
#pragma unroll
        for (int j = 0; j < 4; ++j) so[(mt * 16 + quad * 4 + j) * 128 + sl * 32 + nt * 16 + l15] = Sacc[j];
    }
}

__device__ void phase_mix_even(const Params& p, unsigned char* shm) {
    constexpr int N_GLA = 640, N_ALL = 1280;
    if (gridDim.x == 256) {
        if (blockIdx.x < 128) gla_item(p, shm, blockIdx.x);
        else for (int it = 128 + (blockIdx.x - 128); it < N_ALL; it += 128) { if (it < N_GLA) gla_item(p, shm, it); else sgu_item(p, shm, it - N_GLA); }
    } else {
        for (int it = blockIdx.x; it < N_ALL; it += gridDim.x) { if (it < N_GLA) gla_item(p, shm, it); else sgu_item(p, shm, it - N_GLA); }
    }
}

template <int PASS>
__device__ void rg_item(const Params& p, unsigned char* shm, int item) {
    const int tid = otid(), lane = tid & 63, wid = tid >> 6, quad = lane >> 4, l15 = lane & 15;
    const int c = item >> 4, hb = item & 15, t0 = c * 64;
    const int s_lo = (t0 < T_PROMPT) ? (t0 & ~255) : (T_PROMPT + ((t0 - T_PROMPT) & ~4095));
    const int s_hi = s_lo + ((t0 < T_PROMPT) ? 256 : 4096);
    const bf16_t* rgp = (const bf16_t*)(p.ws + WS_BIG + BIG_RGP);
    float* XC = (float*)shm;
    float* AF = (float*)(shm + 16384); float* BF = AF + 4096; float* AB = BF + 4096; float* BB = AB + 4096;
    unsigned short* WG = (unsigned short*)(shm + 16384);
    unsigned short* XCB = (unsigned short*)(shm + 53248);
    unsigned short* XB = (unsigned short*)(shm + 62464);
    const int row = tid >> 3, c8 = (tid & 7) * 8;
    {
        const int tt = t0 - 2 + row;
        u32x4 v = (u32x4){0, 0, 0, 0};
        if (tt >= s_lo && tt < s_hi) v = *(const u32x4*)(rgp + (size_t)tt * 2048 + hb * 64 + c8);
        *(u32x4*)(XB + row * 64 + c8) = v;
        if (tid < 24) {
            const int r2 = 64 + (tid >> 3), t2 = t0 - 2 + r2;
            u32x4 v2 = (u32x4){0, 0, 0, 0};
            if (t2 >= s_lo && t2 < s_hi) v2 = *(const u32x4*)(rgp + (size_t)t2 * 2048 + hb * 64 + c8);
            *(u32x4*)(XB + r2 * 64 + c8) = v2;
        }
        const bf16_t* wg = (const bf16_t*)(p.ws + WS_WRGG) + (size_t)hb * 256 * 64;
#pragma unroll
        for (int i = 0; i < 4; ++i) { const int e = tid + 512 * i, r = e >> 3, cc = (e & 7) * 8; *(u32x4*)(WG + r * 72 + cc) = *(const u32x4*)(wg + r * 64 + cc); }
    }
    __syncthreads();
    {
        float xc[8];
        const float* cb = p.in[24] + hb * 64 + c8; const float* cw = p.in[23] + hb * 64 + c8;
#pragma unroll
        for (int j = 0; j < 8; ++j) xc[j] = cb[j];
#pragma unroll
        for (int tap = 0; tap < 4; ++tap) {
            const u32x4 v = *(const u32x4*)(XB + (row + tap) * 64 + c8);
#pragma unroll
            for (int j = 0; j < 4; ++j) { xc[2 * j] += cw[tap * 1024 + 2 * j] * bflo(v[j]); xc[2 * j + 1] += cw[tap * 1024 + 2 * j + 1] * bfhi(v[j]); }
        }
        *(f32x4*)(XC + row * 64 + c8) = (f32x4){xc[0], xc[1], xc[2], xc[3]};
        *(f32x4*)(XC + row * 64 + c8 + 4) = (f32x4){xc[4], xc[5], xc[6], xc[7]};
        u32x4 w; w.x = cvt_pk_bf16(xc[0], xc[1]); w.y = cvt_pk_bf16(xc[2], xc[3]); w.z = cvt_pk_bf16(xc[4], xc[5]); w.w = cvt_pk_bf16(xc[6], xc[7]);
        *(u32x4*)(XCB + row * 72 + c8) = w;
    }
    __syncthreads();
    const int jt = wid & 3, tp = wid >> 2;
    f32x4 acc[2][4];
#pragma unroll
    for (int a = 0; a < 2; ++a)
#pragma unroll
        for (int b = 0; b < 4; ++b) acc[a][b] = (f32x4){0.f, 0.f, 0.f, 0.f};
#pragma unroll
    for (int ks = 0; ks < 2; ++ks) {
        const bf16x8 a0 = ldfrag(XCB, 72, (2 * tp) * 16, ks * 32, lane), a1 = ldfrag(XCB, 72, (2 * tp + 1) * 16, ks * 32, lane);
#pragma unroll
        for (int mat = 0; mat < 4; ++mat) { const bf16x8 b = ldfrag(WG, 72, mat * 64 + jt * 16, ks * 32, lane); acc[0][mat] = MFMA16(a0, b, acc[0][mat]); acc[1][mat] = MFMA16(a1, b, acc[1][mat]); }
    }
    __syncthreads();
    {
        const int ch = jt * 16 + l15, gch = hb * 64 + ch;
        float sp[2], ba[2], bx[2];
#pragma unroll
        for (int d = 0; d < 2; ++d) {
            const float lam = p.in[29][d * 1024 + gch];
            sp[d] = 8.0f * (fmaxf(-lam, 0.f) + __logf(1.0f + __expf(-fabsf(lam))));
            ba[d] = p.in[26][d * 1024 + gch]; bx[d] = p.in[28][d * 1024 + gch];
        }
#pragma unroll
        for (int t2 = 0; t2 < 2; ++t2)
#pragma unroll
            for (int j = 0; j < 4; ++j) {
                const int tok = (2 * tp + t2) * 16 + quad * 4 + j;
                const float x = XC[tok * 64 + ch];
#pragma unroll
                for (int d = 0; d < 2; ++d) {
                    const float r = sigmoidf_(acc[t2][2 * d][j] + ba[d]), ig = sigmoidf_(acc[t2][2 * d + 1][j] + bx[d]);
                    const float la = -r * sp[d];
                    const float a = __expf(la), bt = sqrtf(fmaxf(-expm1f(2.0f * la), 0.f)) * ig * x;
                    (d ? AB : AF)[tok * 64 + ch] = a; (d ? BB : BF)[tok * 64 + ch] = bt;
                }
            }
    }
    __syncthreads();
    if (PASS == 0) {
        if (tid < 128) {
            const int ch = tid & 63, d = tid >> 6;
            const float* Ap = d ? AB : AF; const float* Bp = d ? BB : BF;
            float A = 1.f, B = 0.f;
#pragma unroll 8
            for (int i = 0; i < 64; ++i) { const int tok = d ? 63 - i : i; const float a = Ap[tok * 64 + ch], b = Bp[tok * 64 + ch]; B = a * B + b; A *= a; }
            float* sum = (float*)(p.ws + WS_BIG + BIG_RGSUM) + (size_t)(c * 2 + d) * 2048 + hb * 64 + ch;
            sum[0] = A; sum[1024] = B;
        }
    } else {
        if (tid < 128) {
            const int ch = tid & 63, d = tid >> 6;
            const float* Ap = d ? AB : AF; float* Bp = d ? BB : BF;
            float hcur = ((const float*)(p.ws + WS_BIG + BIG_RGCAR))[(size_t)(c * 2 + d) * 1024 + hb * 64 + ch];
#pragma unroll 8
            for (int i = 0; i < 64; ++i) { const int tok = d ? 63 - i : i; hcur = Ap[tok * 64 + ch] * hcur + Bp[tok * 64 + ch]; Bp[tok * 64 + ch] = hcur; }
        }
        __syncthreads();
        {
            const int t = t0 + row;
            const u32x4 gg = *(const u32x4*)(rgp + (size_t)t * 2048 + 1024 + hb * 64 + c8);
            const f32x4 f0 = *(const f32x4*)(BF + row * 64 + c8), f1 = *(const f32x4*)(BF + row * 64 + c8 + 4);
            const f32x4 b0 = *(const f32x4*)(BB + row * 64 + c8), b1 = *(const f32x4*)(BB + row * 64 + c8 + 4);
            u32x4 w;
            w.x = cvt_pk_bf16((f0[0] + b0[0]) * bflo(gg[0]), (f0[1] + b0[1]) * bfhi(gg[0]));
            w.y = cvt_pk_bf16((f0[2] + b0[2]) * bflo(gg[1]), (f0[3] + b0[3]) * bfhi(gg[1]));
            w.z = cvt_pk_bf16((f1[0] + b1[0]) * bflo(gg[2]), (f1[1] + b1[1]) * bfhi(gg[2]));
            w.w = cvt_pk_bf16((f1[2] + b1[2]) * bflo(gg[3]), (f1[3] + b1[3]) * bfhi(gg[3]));
            *(u32x4*)((bf16_t*)(p.ws + WS_ABUF) + (size_t)t * 1024 + hb * 64 + c8) = w;
        }
    }
    __syncthreads();
}

__device__ void phase_rg_carry(const Params& p) {
    const int idx = blockIdx.x * 512 + otid();
    for (int e = idx; e < 20 * 2 * 1024; e += gridDim.x * 512) {
        const int s = e >> 11, d = (e >> 10) & 1, ch = e & 1023;
        const int nc = (s < 16) ? 4 : 64, cbase = (s < 16) ? s * 4 : 64 + (s - 16) * 64;
        const float* sum = (const float*)(p.ws + WS_BIG + BIG_RGSUM);
        float* car = (float*)(p.ws + WS_BIG + BIG_RGCAR);
        float h = (s < 16) ? 0.f : p.in[4][((s - 16) * 2 + d) * 1024 + ch];
        for (int n0 = 0; n0 < nc; n0 += 4) {
            float A[4], B[4];
#pragma unroll
            for (int j = 0; j < 4; ++j) { const int n = d ? (nc - 1 - (n0 + j)) : (n0 + j); const float* sp = sum + (size_t)((cbase + n) * 2 + d) * 2048 + ch; A[j] = sp[0]; B[j] = sp[1024]; }
#pragma unroll
            for (int j = 0; j < 4; ++j) { const int n = d ? (nc - 1 - (n0 + j)) : (n0 + j); car[(size_t)((cbase + n) * 2 + d) * 1024 + ch] = h; h = A[j] * h + B[j]; }
        }
        if (s < 16) p.out[(size_t)T_TOK * 1024 + 1048576 + (s * 2 + d) * 1024 + ch] = h;
    }
}

__device__ __forceinline__ void run_phase(const Params& p, unsigned char* shm, int ph, int dbg) {
    const float* MOD = (const float*)(p.ws + WS_MOD);
    const float* NG = p.in[8];
    bf16_t* ABUF = (bf16_t*)(p.ws + WS_ABUF);
    unsigned char* BIG = p.ws + WS_BIG;
    const bool is_gemm = (ph == 2) | (ph == 5) | (ph == 7) | (ph == 8) | (ph == 10) | (ph == 14) | (ph == 16) | (ph == 17);
    if (is_gemm) {
        EpiGen E; const bf16_t* A = ABUF; const bf16_t* Bt; int N, K = 1024;
        E.bias = nullptr;
        if (ph == 2) { E.mode = 0; E.O = BIG + BIG_PROJ; E.ldc = EVN; E.ncols = EVN; Bt = (const bf16_t*)(p.ws + WS_WEVIN); N = EVNP; }
        else if (ph == 5) { E.mode = 4; E.O = BIG + BIG_Y; E.ldc = 1024; E.ncols = 1024; Bt = (const bf16_t*)(p.ws + WS_WEVOUT); N = 1024; }
        else if (ph == 14) { E.mode = 4; E.O = BIG + BIG_Y; E.ldc = 1024; E.ncols = 1024; Bt = (const bf16_t*)(p.ws + WS_WRGOUT); N = 1024; }
        else if (ph == 10) { E.mode = 3; E.O = BIG + BIG_RGP; E.ldc = 2048; E.ncols = 2048; Bt = (const bf16_t*)(p.ws + WS_WRGIN); N = 2048; }
        else if (ph == 7 || ph == 16) { const int l = (ph == 16); E.mode = 1; E.O = BIG + BIG_H; E.ldc = 4096; E.ncols = 4096; E.bias = p.in[10] + l * 4096; Bt = (const bf16_t*)(p.ws + WS_WMLP1) + (size_t)l * 4096 * 1024; N = 4096; }
        else { const int l = (ph == 17); E.mode = 2; E.O = ABUF; E.ldc = 1024; E.ncols = 1024; E.bias = p.in[12] + l * 1024; A = (const bf16_t*)(BIG + BIG_H); Bt = (const bf16_t*)(p.ws + WS_WMLP2) + (size_t)l * 1024 * 4096; N = 1024; K = 4096; }
        run_gemm(shm, A, Bt, N, K, E);
        return;
    }
    switch (ph) {
    case 0: phase_prep(p, shm); break;
    case 1: phase_row<0, true>(p, nullptr, nullptr, nullptr, NG + 0 * 1024, MOD, 0, 1024); break;
    case 3: phase_mix_even(p, shm); break;
    case 4: phase_gla_combine(p); break;
    case 6: phase_row<1, true>(p, BIG + BIG_Y, NG + 1 * 1024, MOD + 2048, NG + 2 * 1024, MOD, 3072, 4096); break;
    case 9: phase_row<2, true>(p, ABUF, NG + 3 * 1024, MOD + 5120, NG + 4 * 1024, MOD + 5 * 6144, 0, 1024); break;
    case 11: for (int it = blockIdx.x; it < 5120; it += gridDim.x) rg_item<0>(p, shm, it); break;
    case 12: phase_rg_carry(p); break;
    case 13: for (int it = blockIdx.x; it < 5120; it += gridDim.x) rg_item<1>(p, shm, it); break;
    case 15: phase_row<1, true>(p, BIG + BIG_Y, NG + 5 * 1024, MOD + 5 * 6144 + 2048, NG + 6 * 1024, MOD + 5 * 6144, 3072, 4096); break;
    case 18: phase_row<2, false>(p, ABUF, NG + 7 * 1024, MOD + 5 * 6144 + 5120, nullptr, nullptr, 0, 0); break;
#ifdef DBG_PROBE
    case 97: {
        const int k = dbg;
        unsigned* flag = (unsigned*)(p.ws + WS_END);
        bool bad = false;
        const size_t g0 = (size_t)blockIdx.x * 512 + otid(), gs = (size_t)gridDim.x * 512;
        for (size_t i = g0; i < (size_t)T_TOK * 1024; i += gs) { if (!(fabsf(p.out[i]) < 1e30f)) bad = true; }
        if (k >= 1) for (size_t i = g0; i < (size_t)T_TOK * 1024; i += gs) { if ((((const unsigned short*)(p.ws + WS_ABUF))[i] & 0x7f80u) == 0x7f80u) bad = true; }
        const unsigned char* b = nullptr; size_t n = 0; bool f32 = false;
        if (k == 0) { b = p.ws + WS_MOD; n = 61440; f32 = true; }
        else if (k == 2) { b = BIG + BIG_PROJ; n = (size_t)T_TOK * EVN; }
        else if (k == 3) { b = BIG + BIG_OF; n = (size_t)T_TOK * 1024; }
        else if (k == 5 || k == 14) { b = BIG + BIG_Y; n = (size_t)T_TOK * 1024; f32 = true; }
        else if (k == 7 || k == 16) { b = BIG + BIG_H; n = (size_t)T_TOK * 4096; }
        else if (k == 10) { b = BIG + BIG_RGP; n = (size_t)T_TOK * 2048; }
        else if (k == 11) { b = BIG + BIG_RGSUM; n = (size_t)320 * 4096; f32 = true; }
        else if (k == 12) { b = BIG + BIG_RGCAR; n = (size_t)320 * 2048; f32 = true; }
        for (size_t i = g0; i < n; i += gs) { if (f32) { if (!(fabsf(((const float*)b)[i]) < 1e30f)) bad = true; } else { if ((((const unsigned short*)b)[i] & 0x7f80u) == 0x7f80u) bad = true; } }
        if (bad) atomicMin(flag, (unsigned)k);
    } break;
    case 95: {
        unsigned* flag = (unsigned*)(p.ws + WS_END);
        unsigned code = 0;
        const size_t g0 = (size_t)blockIdx.x * 512 + otid(), gs = (size_t)gridDim.x * 512;
        const unsigned short* ab = (const unsigned short*)(p.ws + WS_ABUF);
        const unsigned short* of = (const unsigned short*)(BIG + BIG_OF);
        const unsigned short* ob = (const unsigned short*)(BIG + BIG_OB);
        for (size_t i = g0; i < (size_t)T_TOK * 512; i += gs) {
            const size_t t = i >> 9, c = i & 511;
            unsigned cc = 0;
            if ((ab[t * 1024 + c] & 0x7f80u) == 0x7f80u) cc |= 1u;
            if ((of[i] & 0x7f80u) == 0x7f80u) cc |= 2u;
            if ((ob[i] & 0x7f80u) == 0x7f80u) cc |= 4u;
            if (cc) cc |= (t < T_PROMPT) ? 8u : 16u;
            code |= cc;
        }
        if (dbg >= 100) { if (code & 6u) atomicOr(flag + 1, 1u << (dbg - 100)); } else if (code) atomicOr(flag + 1, code);
    } break;
    case 94: {
        const unsigned f = ((const unsigned*)(p.ws + WS_END))[1];
        const float v = 1000.0f * (float)(f + 1);
        for (size_t i = (size_t)blockIdx.x * 512 + otid(); i < (size_t)22052864; i += (size_t)gridDim.x * 512) p.out[i] = v;
    } break;
    case 93: break;
    case 96: {
        const unsigned f = *(const unsigned*)(p.ws + WS_END);
        const float v = (f > 100u) ? 50000.0f : 1000.0f * (float)(f + 1);
        for (size_t i = (size_t)blockIdx.x * 512 + otid(); i < (size_t)22052864; i += (size_t)gridDim.x * 512) p.out[i] = v;
    } break;
    case 98: {
        for (size_t i = (size_t)blockIdx.x * 512 + otid(); i < (size_t)22052864; i += (size_t)gridDim.x * 512) {
            const float v = p.out[i];
            if (!(fabsf(v) < 1e30f)) p.out[i] = 12345.0f;
        }
    } break;
    case 99: {
        const unsigned short* a = (const unsigned short*)p.ws;
        const size_t NOUT = 22052864, NW = WS_END / 2;
        for (size_t i = (size_t)blockIdx.x * 512 + otid(); i < NOUT; i += (size_t)gridDim.x * 512) {
            unsigned s = (i < (size_t)T_TOK * 1024) ? ((__float_as_uint(p.out[i]) >> 8) & 0xffffu) : 0u;
            for (int j = 0; j < 6; ++j) { const size_t idx = i + (size_t)j * NOUT; if (idx < NW) s += a[idx]; }
            p.out[i] = (float)s;
        }
    } break;
#endif
    default: break;
    }
}

__global__ void __launch_bounds__(512, 2) fwd_megakernel(Params p) {
    extern __shared__ __attribute__((aligned(16))) unsigned char shm[];
    cg::grid_group grid = cg::this_grid();
    for (int i = 0; i < p.nseq; ++i) {
        if (i > 0) grid.sync();
        run_phase(p, shm, (int)p.seq[i], (int)p.dbgv[i]);
    }
}

extern "C" void kernel_launch(void* const* d_in, const int* in_sizes, int n_in, void* d_out, int out_size, void* d_ws, size_t ws_size, hipStream_t stream) {
    static int grid_blocks = 0;
    if (!grid_blocks) {
        int dev = 0, cus = 0, per_cu = 0;
        hipGetDevice(&dev);
        hipDeviceGetAttribute(&cus, hipDeviceAttributeMultiprocessorCount, dev);
        hipFuncSetAttribute((const void*)fwd_megakernel, hipFuncAttributeMaxDynamicSharedMemorySize, LDS_BYTES);
        hipOccupancyMaxActiveBlocksPerMultiprocessor(&per_cu, (const void*)fwd_megakernel, 512, LDS_BYTES);
        if (per_cu < 1) { fprintf(stderr, "kernel_launch: occupancy query reports %d blocks per CU\n", per_cu); per_cu = 1; }
        if (per_cu > 1) per_cu = 1;
        grid_blocks = cus * per_cu;
        if (ws_size < WS_END) fprintf(stderr, "kernel_launch: workspace too small: %zu < %zu\n", ws_size, (size_t)WS_END);
    }
    Params p{};
    for (int i = 0; i < 31; ++i) p.in[i] = (const float*)d_in[i];
    p.out = (float*)d_out; p.ws = (unsigned char*)d_ws;
    int n = 0;
#if defined(DBG_PROBE) && DBG_PROBE == 1
    hipMemsetAsync((char*)d_ws + WS_END, 0xff, 16, stream);
    for (int ph = 0; ph < NPHASE; ++ph) { p.seq[n] = (unsigned char)ph; p.dbgv[n++] = 0; p.seq[n] = 97; p.dbgv[n++] = (unsigned char)ph; }
    p.seq[n] = 96; p.dbgv[n++] = 0;
#elif defined(DBG_PROBE) && DBG_PROBE == 3
    hipMemsetAsync((char*)d_ws + WS_END, 0xff, 16, stream);
    for (int ph = 0; ph < 4; ++ph) { p.seq[n] = (unsigned char)ph; p.dbgv[n++] = 0; }
    p.seq[n] = 97; p.dbgv[n++] = 3; p.seq[n] = 96; p.dbgv[n++] = 0;
#elif defined(DBG_PROBE) && DBG_PROBE == 2
    hipMemsetAsync((char*)d_ws + WS_END, 0, 16, stream);
    for (int ph = 0; ph < 4; ++ph) { p.seq[n] = (unsigned char)ph; p.dbgv[n++] = 0; }
    p.seq[n] = DBG_P4; p.dbgv[n++] = 0; p.seq[n] = 94; p.dbgv[n++] = 0;
#else
    for (int ph = 0; ph < NPHASE; ++ph) { p.seq[n] = (unsigned char)ph; p.dbgv[n++] = 0; }
#endif
    p.nseq = n;
    void* args[] = {&p};
    hipError_t e = hipLaunchCooperativeKernel((const void*)fwd_megakernel, dim3(grid_blocks), dim3(512), args, LDS_BYTES, stream);
    if (e != hipSuccess) fprintf(stderr, "cooperative launch failed: %s (grid %d)\n", hipGetErrorString(e), grid_blocks);
}
```

```cpp
#include <hip/hip_runtime.h>
#include <hip/hip_cooperative_groups.h>
#include <cstdio>
namespace pg8 {
#define PG8_LAS __attribute__((address_space(3)))
typedef unsigned short bf16_t;
typedef short bf16x8 __attribute__((ext_vector_type(8)));
typedef float f32x4 __attribute__((ext_vector_type(4)));
typedef unsigned u32x4 __attribute__((ext_vector_type(4)));
constexpr int BM = 256, BK = 64, HALF = 128, HTB = HALF * BK * 2  , STAGE_BYTES = 8 * HTB, NXCD = 8, WGM = 8;

__host__ __device__ __forceinline__ int lds_byte(int r, int c) { const int st = (r >> 4) * 2 + (c >> 5), rr = r & 15, cc = c & 31, ob = rr * 64 + cc * 2; return st * 1024 + (ob ^ (((ob >> 9) & 1) << 5)); }
__host__ __device__ __forceinline__ void stage_rc(int b, int& R, int& C) { const int st = b / 1024, sb = b % 1024, swz = sb ^ (((sb >> 9) & 1) << 5); R = (st >> 1) * 16 + swz / 64; C = (st & 1) * 32 + (swz % 64) / 2; }
__host__ __device__ __forceinline__ int perm32(int rho) { const int n = rho >> 4, i = rho & 15; return 8 * (i >> 2) + 4 * n + (i & 3); }

struct Unit { int pm, pn; };
struct Gemm { const bf16_t* A; const bf16_t* Bt; int M, N, K, ld; };

struct StaticOrder {
    int nM, nN, nwg, G, c;
    __host__ __device__ void init(int M, int N, int G_, int c_) { nM = M / BM; nN = N / BM; nwg = nM * nN; G = G_; c = c_; }
    __host__ __device__ bool next(int i, Unit& u) const {
        const long L = (long)i * G + c; if (L >= nwg) return false;
        int wgid = (int)L; { const int q = nwg / NXCD, r = nwg % NXCD, xcd = wgid % NXCD, off = wgid / NXCD; wgid = (xcd < r ? xcd * (q + 1) : r * (q + 1) + (xcd - r) * q) + off; }
        const int nig = WGM * nN, gid = wgid / nig, fm = gid * WGM, gsz = (nM - fm) < WGM ? (nM - fm) : WGM;
        u.pm = fm + ((wgid % nig) % gsz); u.pn = (wgid % nig) / gsz; return true;
    }
    __device__ __forceinline__ void a_ready(const Unit&) const {}
    __device__ __forceinline__ void done(const Unit&) const {}
};
typedef __bf16 bf16x2_n __attribute__((ext_vector_type(2)));
typedef float f32x2_n __attribute__((ext_vector_type(2)));
__device__ __forceinline__ unsigned cvt_pk_bf16(float lo, float hi) { f32x2_n v = {lo, hi}; bf16x2_n b = __builtin_convertvector(v, bf16x2_n); return __builtin_bit_cast(unsigned, b); }
typedef float f32x2 __attribute__((ext_vector_type(2)));
template <class Epi, class Sched, bool STAMP = false>
__device__ __forceinline__ void gemm_phase(PG8_LAS unsigned char* lds, const Gemm g, const Sched& S, const Epi& E, unsigned long long* stamps) {
    int tid_o = threadIdx.x; asm volatile("" : "+v"(tid_o)); const int tid = tid_o, wid = __builtin_amdgcn_readfirstlane(tid >> 6), lane = tid & 63, wr = wid >> 2, wc = wid & 3, fr = lane & 15, fq = lane >> 4;
    const int K = g.ld, nt = g.K / BK;
    int ts_lo = 0, ts_hi = 0, nts = 0; const unsigned long long rt_entry = STAMP ? (unsigned long long)wall_clock64() : 0ull;
#define PG8_STAMP() do { if (STAMP && wid == 0 && nts < 64) { const unsigned long long _c = (unsigned long long)clock64(); \
        ts_lo = (lane == nts) ? (int)(unsigned)_c : ts_lo; ts_hi = (lane == nts) ? (int)(unsigned)(_c >> 32) : ts_hi; ++nts; } } while (0)
    PG8_STAMP();
    unsigned voffA[2], voffB[2];
#pragma unroll
    for (int i = 0; i < 2; ++i) { int R, C; stage_rc(tid * 16 + i * 8192, R, C); const int Rb = Epi::PERM ? ((R & ~31) + perm32(R & 31)) : R;
        voffA[i] = (unsigned)(R * K + C) * 2u; voffB[i] = (unsigned)(Rb * K + C) * 2u; }
    const size_t kstep = (size_t)(BK * 2);
    const size_t hstep = (size_t)HALF * K * 2;
    const size_t tstep = 2 * hstep;
    const unsigned ldsw = (unsigned)wid * 1024u;
    const int aoff = lds_byte(wr * 64 + fr, fq * 8), boff = lds_byte(wc * 32 + fr, fq * 8);
#define PG8_SA(b, h) (((b) * 2 + (h)) * HTB)
#define PG8_SB(b, h) ((4 + (b) * 2 + (h)) * HTB)
#define PG8_STAGE(bufoff, gbase, voff) do { _Pragma("unroll") for (int _i = 0; _i < 2; ++_i) \
        __builtin_amdgcn_global_load_lds((const unsigned*)((const char*)(gbase) + (voff)[_i]), (PG8_LAS unsigned*)(lds + (bufoff) + ldsw + _i * 8192), 16, 0, 0); } while (0)
#define PG8_LDA(dst, b, h) do { _Pragma("unroll") for (int m = 0; m < 4; ++m) _Pragma("unroll") for (int k = 0; k < 2; ++k) dst[m][k] = *(const PG8_LAS bf16x8*)(lds + PG8_SA(b, h) + aoff + m * 2048 + k * 1024); } while (0)
#define PG8_LDB(dst, b, h) do { _Pragma("unroll") for (int n = 0; n < 2; ++n) _Pragma("unroll") for (int k = 0; k < 2; ++k) dst[n][k] = *(const PG8_LAS bf16x8*)(lds + PG8_SB(b, h) + boff + n * 2048 + k * 1024); } while (0)
#define PG8_MMA(ai, bj, At, Bt) do { __builtin_amdgcn_s_setprio(1); _Pragma("unroll") for (int m = 0; m < 4; ++m) _Pragma("unroll") for (int n = 0; n < 2; ++n) _Pragma("unroll") for (int k = 0; k < 2; ++k) \
        acc[ai][bj][m][n] = __builtin_amdgcn_mfma_f32_16x16x32_bf16(Bt[n][k], At[m][k], acc[ai][bj][m][n], 0, 0, 0); __builtin_amdgcn_s_setprio(0); } while (0)
#define PG8_WAIT_V(n) asm volatile("s_waitcnt vmcnt(" #n ")" ::: "memory")
#define PG8_WAIT_L(n) asm volatile("s_waitcnt lgkmcnt(" #n ")" ::: "memory")
#define PG8_BAR __builtin_amdgcn_s_barrier()
#define PG8_SCHED __builtin_amdgcn_sched_barrier(0)
    Unit cur, nxt; int ui = 0;
    if (!S.next(0, cur)) return;
    f32x4 acc[2][2][4][2];
#pragma unroll
    for (int a = 0; a < 2; ++a)
#pragma unroll
        for (int b = 0; b < 2; ++b)
#pragma unroll
            for (int m = 0; m < 4; ++m)
#pragma unroll
                for (int n = 0; n < 2; ++n) acc[a][b][m][n] = (f32x4){0.f, 0.f, 0.f, 0.f};
    bf16x8 At[4][2], B0[2][2], B1[2][2];
    const char* cA = (const char*)g.A + (size_t)cur.pm * tstep; const char* cB = (const char*)g.Bt + (size_t)cur.pn * tstep;
    S.a_ready(cur);
    PG8_STAGE(PG8_SB(0, 0), cB, voffB); PG8_STAGE(PG8_SA(0, 0), cA, voffA); PG8_STAGE(PG8_SB(0, 1), cB + hstep, voffB); PG8_STAGE(PG8_SA(0, 1), cA + hstep, voffA);
    if (wr == 1) PG8_BAR;
    PG8_WAIT_V(4); PG8_BAR;
    PG8_STAGE(PG8_SB(1, 0), cB + kstep, voffB); PG8_STAGE(PG8_SA(1, 0), cA + kstep, voffA); PG8_STAGE(PG8_SB(1, 1), cB + hstep + kstep, voffB);
    PG8_WAIT_V(6); PG8_BAR;
    PG8_STAMP();
    for (;;) {
        const bool has_next = S.next(ui + 1, nxt);
        const char* nA = has_next ? (const char*)g.A + (size_t)nxt.pm * tstep : cA; const char* nB = has_next ? (const char*)g.Bt + (size_t)nxt.pn * tstep : cB;
        for (int t = 0; t < nt; t += 2) {
            const bool last = (t == nt - 2);
            const char* a1 = cA + (size_t)(t + 1) * kstep;
            const char* a2 = last ? nA : cA + (size_t)(t + 2) * kstep; const char* b2 = last ? nB : cB + (size_t)(t + 2) * kstep;
            const char* a3 = a2 + kstep; const char* b3 = b2 + kstep;
            if (last && has_next) S.a_ready(nxt);
            PG8_LDB(B0, 0, 0); PG8_SCHED; PG8_LDA(At, 0, 0); PG8_STAGE(PG8_SA(1, 1), a1 + hstep, voffA);
            PG8_WAIT_L(8); PG8_BAR; PG8_WAIT_L(0); PG8_MMA(0, 0, At, B0); PG8_BAR; PG8_SCHED;
            PG8_LDB(B1, 0, 1); PG8_STAGE(PG8_SB(0, 0), b2, voffB);
            PG8_BAR; PG8_WAIT_L(0); PG8_MMA(0, 1, At, B1); PG8_BAR;
            PG8_LDA(At, 0, 1); PG8_STAGE(PG8_SA(0, 0), a2, voffA);
            PG8_BAR; PG8_WAIT_L(0); PG8_MMA(1, 0, At, B0); PG8_BAR; PG8_SCHED;
            PG8_STAGE(PG8_SB(0, 1), b2 + hstep, voffB);
            PG8_WAIT_V(6); PG8_BAR; PG8_MMA(1, 1, At, B1); PG8_BAR;
            PG8_LDB(B0, 1, 0); PG8_SCHED; PG8_LDA(At, 1, 0); PG8_STAGE(PG8_SA(0, 1), a2 + hstep, voffA);
            PG8_WAIT_L(8); PG8_BAR; PG8_WAIT_L(0); PG8_MMA(0, 0, At, B0); PG8_BAR; PG8_SCHED;
            PG8_LDB(B1, 1, 1); PG8_STAGE(PG8_SB(1, 0), b3, voffB);
            PG8_BAR; PG8_WAIT_L(0); PG8_MMA(0, 1, At, B1); PG8_BAR;
            PG8_LDA(At, 1, 1); PG8_STAGE(PG8_SA(1, 0), a3, voffA);
            PG8_BAR; PG8_WAIT_L(0); PG8_MMA(1, 0, At, B0); PG8_BAR; PG8_SCHED;
            PG8_STAGE(PG8_SB(1, 1), b3 + hstep, voffB);
            PG8_WAIT_V(6); PG8_BAR; PG8_MMA(1, 1, At, B1); PG8_BAR;
        }
        PG8_STAMP();
        if constexpr (!Epi::AFTER_DRAIN) { E(acc, cur, wr, wc, fr, fq); S.done(cur); }
        PG8_STAMP();
        if (!has_next) break;
#pragma unroll
        for (int a = 0; a < 2; ++a)
#pragma unroll
            for (int b = 0; b < 2; ++b)
#pragma unroll
                for (int m = 0; m < 4; ++m)
#pragma unroll
                    for (int n = 0; n < 2; ++n) acc[a][b][m][n] = (f32x4){0.f, 0.f, 0.f, 0.f};
        cur = nxt; cA = nA; cB = nB; ++ui;
    }
    PG8_WAIT_V(0);
    if (wr == 0) PG8_BAR;
    PG8_BAR;
    if constexpr (Epi::AFTER_DRAIN) { E.fused(acc, cur, wr, wc, fr, fq, lds, wid, lane); S.done(cur); }
    PG8_STAMP();
    if (STAMP && wid == 0) { stamps[lane] = lane < nts ? (((unsigned long long)(unsigned)ts_hi << 32) | (unsigned)ts_lo) : 0ull;
        if (lane == 62) stamps[62] = rt_entry; if (lane == 63) stamps[63] = (unsigned long long)wall_clock64(); }
#undef PG8_STAMP
#undef PG8_SA
#undef PG8_SB
#undef PG8_STAGE
#undef PG8_LDA
#undef PG8_LDB
#undef PG8_MMA
#undef PG8_WAIT_V
#undef PG8_WAIT_L
#undef PG8_BAR
#undef PG8_SCHED
}
}

namespace cg = cooperative_groups;
using pg8::bf16_t; using pg8::bf16x8; using pg8::f32x4; using pg8::u32x4; using pg8::cvt_pk_bf16;

#ifndef MK_LAUNCHES
#define MK_LAUNCHES 1
#endif

constexpr int T_TOK = 20480, T_PROMPT = 4096, DM = 1024, DFF = 4096, EVN = 2592, EVNP = 2816;
constexpr int LDS_BYTES = 147456;
constexpr int NPHASE = 19;
constexpr float EPSN = 1e-6f;

constexpr size_t WS_MOD    = 0;
constexpr size_t WS_WEVIN  = 262144;
constexpr size_t WS_WEVOUT = WS_WEVIN  + (size_t)EVNP * 1024 * 2;
constexpr size_t WS_WMLP1  = WS_WEVOUT + (size_t)1024 * 1024 * 2;
constexpr size_t WS_WMLP2  = WS_WMLP1  + (size_t)2 * 4096 * 1024 * 2;
constexpr size_t WS_WRGIN  = WS_WMLP2  + (size_t)2 * 4096 * 1024 * 2;
constexpr size_t WS_WRGOUT = WS_WRGIN  + (size_t)2048 * 1024 * 2;
constexpr size_t WS_WRGG   = WS_WRGOUT + (size_t)1024 * 1024 * 2;
constexpr size_t WS_WSGU   = WS_WRGG   + (size_t)16 * 256 * 64 * 2;
constexpr size_t WS_ABUF   = WS_WSGU   + (size_t)4 * 128 * 128 * 2;
constexpr size_t WS_BIG    = WS_ABUF   + (size_t)T_TOK * 1024 * 2;
constexpr size_t BIG_BYTES = (size_t)T_TOK * 4096 * 2;
constexpr size_t WS_END    = WS_BIG + BIG_BYTES;
static_assert(WS_END <= 268435456ull, "workspace map exceeds 256 MiB");
constexpr size_t BIG_PROJ  = 0;
constexpr size_t BIG_OF    = (size_t)T_TOK * EVN * 2;
constexpr size_t BIG_OB    = BIG_OF + (size_t)T_TOK * 512 * 2;
static_assert(BIG_OB + (size_t)T_TOK * 512 * 2 <= BIG_BYTES, "");
constexpr size_t BIG_Y     = 0;
constexpr size_t BIG_H     = 0;
constexpr size_t BIG_RGP   = 0;
constexpr size_t BIG_RGSUM = (size_t)T_TOK * 2048 * 2;
constexpr size_t WS_BAR = WS_END + 256;
static_assert(WS_BAR + 3456 * 4 <= 268435456ull, "");
constexpr size_t WS_SCR = WS_BAR + 16384;
static_assert(WS_SCR + (size_t)4096 * 1024 * 2 <= 268435456ull, "");
constexpr size_t BIG_RGCAR = BIG_RGSUM + (size_t)320 * 2 * 2 * 1024 * 4;

struct Params {
    const float* in[31];
    float* out;
    unsigned char* ws;
    int nseq, pad;
    unsigned char seq[64];
    unsigned char dbgv[64];
};

__device__ __forceinline__ float bf2f(unsigned short b) { return __uint_as_float(((unsigned)b) << 16); }
__device__ __forceinline__ float bflo(unsigned w) { return __uint_as_float(w << 16); }
__device__ __forceinline__ float bfhi(unsigned w) { return __uint_as_float(w & 0xffff0000u); }
__device__ __forceinline__ unsigned short f2bf(float f) { return (unsigned short)(cvt_pk_bf16(f, 0.f) & 0xffffu); }
__device__ __forceinline__ float wave_sum(float v) {
#pragma unroll
    for (int o = 32; o > 0; o >>= 1) v += __shfl_xor(v, o, 64);
    return v;
}
__device__ __forceinline__ float gelu_tanh(float x) {
    const float u = -2.302208198f * (x + 0.044715f * x * x * x);
    return x * __builtin_amdgcn_rcpf(1.0f + __builtin_amdgcn_exp2f(u));
}
__device__ __forceinline__ float sigmoidf_(float x) { return __builtin_amdgcn_rcpf(1.0f + __expf(-x)); }
__device__ __forceinline__ bf16x8 ldfrag(const unsigned short* base, int pitch, int r0, int k0, int lane) {
    return *(const bf16x8*)(base + (r0 + (lane & 15)) * pitch + k0 + (lane >> 4) * 8);
}
__device__ __forceinline__ int otid() { int t = threadIdx.x; asm volatile("" : "+v"(t)); return t; }
__device__ __forceinline__ void lds_barrier() { asm volatile("s_waitcnt lgkmcnt(0)" ::: "memory"); __builtin_amdgcn_s_barrier(); asm volatile("" ::: "memory"); }
#define MFMA16(a, b, c) __builtin_amdgcn_mfma_f32_16x16x32_bf16((a), (b), (c), 0, 0, 0)

struct EpiGen {
    static constexpr bool PERM = true, AFTER_DRAIN = false;
    void* O; int ldc; const float* bias; int ncols; int mode;
    __device__ __forceinline__ void operator()(const f32x4 (&acc)[2][2][4][2], const pg8::Unit& u, int wr, int wc, int fr, int fq) const {
        const int row0 = u.pm * 256 + wr * 64 + fr, col0 = u.pn * 256 + wc * 32 + 8 * fq;
        const bool act = (mode == 0) ? (u.pn < 4) : ((mode == 3) ? (u.pn >= 4) : false);
        if (mode == 4) {
#pragma unroll
            for (int ai = 0; ai < 2; ++ai)
#pragma unroll
                for (int m = 0; m < 4; ++m) { float* rowp = (float*)O + (size_t)(row0 + ai * 128 + m * 16) * ldc + col0;
#pragma unroll
                    for (int bj = 0; bj < 2; ++bj) { *(f32x4*)(rowp + bj * 128) = acc[ai][bj][m][0]; *(f32x4*)(rowp + bj * 128 + 4) = acc[ai][bj][m][1]; } }
            return;
        }
#pragma unroll
        for (int bj = 0; bj < 2; ++bj) {
            const int col = col0 + bj * 128;
            if (col >= ncols) continue;
            f32x4 b0 = (f32x4){0.f, 0.f, 0.f, 0.f}, b1 = b0;
            if (bias) { b0 = *(const f32x4*)(bias + col); b1 = *(const f32x4*)(bias + col + 4); }
#pragma unroll
            for (int ai = 0; ai < 2; ++ai)
#pragma unroll
                for (int m = 0; m < 4; ++m) {
                    f32x4 v0 = acc[ai][bj][m][0] + b0, v1 = acc[ai][bj][m][1] + b1;
                    if (mode == 1) {
#pragma unroll
                        for (int j = 0; j < 4; ++j) { float a = fmaxf(v0[j], 0.f), b = fmaxf(v1[j], 0.f); v0[j] = a * a; v1[j] = b * b; }
                    }
                    if (act) {
#pragma unroll
                        for (int j = 0; j < 4; ++j) { v0[j] = gelu_tanh(v0[j]); v1[j] = gelu_tanh(v1[j]); }
                    }
                    u32x4 w; w.x = cvt_pk_bf16(v0[0], v0[1]); w.y = cvt_pk_bf16(v0[2], v0[3]); w.z = cvt_pk_bf16(v1[0], v1[1]); w.w = cvt_pk_bf16(v1[2], v1[3]);
                    *(u32x4*)((bf16_t*)O + (size_t)(row0 + ai * 128 + m * 16) * ldc + col) = w;
                }
        }
    }
};

template <class Epi>
__device__ __forceinline__ void run_gemm(unsigned char* shm, const bf16_t* A, const bf16_t* Bt, int M, int N, int K, int ld, int G, int c, const Epi& E) {
    pg8::Gemm g; g.A = A; g.Bt = Bt; g.M = M; g.N = N; g.K = K; g.ld = ld;
    pg8::StaticOrder S; S.init(M, N, G, c);
    pg8::gemm_phase<Epi, pg8::StaticOrder, false>((PG8_LAS unsigned char*)shm, g, S, E, nullptr);
}

__device__ __forceinline__ void transpose_tile(const float* src, int ldsrc, int k0, int n0, int nvalid, int nstore, bf16_t* dst, int lddst, float* tile) {
    const int tid = otid();
    {
        const int kk = tid >> 6, n4 = (tid & 63) * 4;
        float4 v[8];
#pragma unroll
        for (int i = 0; i < 8; ++i) {
            v[i] = make_float4(0.f, 0.f, 0.f, 0.f);
            if (n0 + n4 < nvalid) v[i] = *(const float4*)(src + (size_t)(k0 + kk + 8 * i) * ldsrc + n0 + n4);
        }
#pragma unroll
        for (int i = 0; i < 8; ++i) { float* tp = tile + (kk + 8 * i) * 257 + n4; tp[0] = v[i].x; tp[1] = v[i].y; tp[2] = v[i].z; tp[3] = v[i].w; }
    }
    __syncthreads();
    {
        const int nn = tid >> 1, k32 = (tid & 1) * 32;
        if (n0 + nn < nstore) {
            bf16_t* dp = dst + (size_t)(n0 + nn) * lddst + k0 + k32;
#pragma unroll
            for (int q = 0; q < 4; ++q) {
                float f[8];
#pragma unroll
                for (int j = 0; j < 8; ++j) f[j] = tile[(k32 + q * 8 + j) * 257 + nn];
                u32x4 w; w.x = cvt_pk_bf16(f[0], f[1]); w.y = cvt_pk_bf16(f[2], f[3]); w.z = cvt_pk_bf16(f[4], f[5]); w.w = cvt_pk_bf16(f[6], f[7]);
                *(u32x4*)(dp + q * 8) = w;
            }
        }
    }
    __syncthreads();
}

__device__ __forceinline__ void convert_weight_tile(const Params& p, float* fl, int idx) {
    const float* src; bf16_t* dst; int ld, nv, ns, ldd, nkt;
    if (idx < 176) { src = p.in[13]; dst = (bf16_t*)(p.ws + WS_WEVIN); ld = EVN; nv = EVN; ns = EVNP; ldd = 1024; nkt = 16; }
    else if ((idx -= 176) < 64) { src = p.in[14]; dst = (bf16_t*)(p.ws + WS_WEVOUT); ld = 1024; nv = 1024; ns = 1024; ldd = 1024; nkt = 16; }
    else if ((idx -= 64) < 512) { const int l = idx >> 8; idx &= 255; src = p.in[9] + (size_t)l * 1024 * 4096; dst = (bf16_t*)(p.ws + WS_WMLP1) + (size_t)l * 4096 * 1024; ld = 4096; nv = 4096; ns = 4096; ldd = 1024; nkt = 16; }
    else if ((idx -= 512) < 512) { const int l = idx >> 8; idx &= 255; src = p.in[11] + (size_t)l * 4096 * 1024; dst = (bf16_t*)(p.ws + WS_WMLP2) + (size_t)l * 1024 * 4096; ld = 1024; nv = 1024; ns = 1024; ldd = 4096; nkt = 64; }
    else if ((idx -= 512) < 128) { src = p.in[22]; dst = (bf16_t*)(p.ws + WS_WRGIN); ld = 2048; nv = 2048; ns = 2048; ldd = 1024; nkt = 16; }
    else if ((idx -= 128) < 64) { src = p.in[30]; dst = (bf16_t*)(p.ws + WS_WRGOUT); ld = 1024; nv = 1024; ns = 1024; ldd = 1024; nkt = 16; }
    else { idx -= 64; const int d = idx >> 5, mat = (idx >> 4) & 1, h = idx & 15;
        src = (mat ? p.in[27] : p.in[25]) + (size_t)(d * 16 + h) * 4096; dst = (bf16_t*)(p.ws + WS_WRGG) + (size_t)h * 256 * 64 + (size_t)(d * 2 + mat) * 4096; ld = 64; nv = 64; ns = 64; ldd = 64; nkt = 1; idx = 0; }
    const int kt = idx % nkt, nt = idx / nkt;
    transpose_tile(src, ld, kt * 64, nt * 256, nv, ns, dst, ldd, fl);
}
__device__ __forceinline__ int deferred1_tile(int d) { return d < 256 ? 240 + d : d < 512 ? 752 + (d - 256) : d < 640 ? 1264 + (d - 512) : 1392 + (d - 640); }
__device__ __forceinline__ int deferred2_tile(int d) { return d < 256 ? 496 + d : 1008 + (d - 256); }
__device__ __forceinline__ void phase_prep(const Params& p, unsigned char* shm) {
    const int tid = otid();
    float* fl = (float*)shm;
    constexpr int N_GEMV = 192, N_SGU = 16;
    const bool early = (gridDim.x == 256);
    const int N_TR = early ? 304 : 1520;
    for (int item = blockIdx.x; item < N_GEMV + N_TR + N_SGU; item += gridDim.x) {
        if (item < N_GEMV) {
            const int l = item / 96, n0 = (item % 96) * 64;
            float* S = fl;
            float* R = fl + 5120;
            for (int e = tid; e < 5120; e += 512) {
                const int c = e >> 10, k = e & 1023;
                const float v = (c == 0) ? p.in[5][k] : p.in[2][(c - 1) * 1024 + k];
                S[e] = v * sigmoidf_(v);
            }
            __syncthreads();
            const int r = tid >> 4, c4 = (tid & 15) * 4;
            float acc[5][4];
#pragma unroll
            for (int c = 0; c < 5; ++c)
#pragma unroll
                for (int j = 0; j < 4; ++j) acc[c][j] = 0.f;
            const float* W = p.in[6] + (size_t)l * 1024 * 6144 + n0 + c4;
            for (int i0 = 0; i0 < 32; i0 += 8) {
                float4 w[8];
#pragma unroll
                for (int j = 0; j < 8; ++j) w[j] = *(const float4*)(W + (size_t)(r + 32 * (i0 + j)) * 6144);
#pragma unroll
                for (int j = 0; j < 8; ++j) {
                    const int k = r + 32 * (i0 + j);
#pragma unroll
                    for (int c = 0; c < 5; ++c) { const float s = S[c * 1024 + k]; acc[c][0] += s * w[j].x; acc[c][1] += s * w[j].y; acc[c][2] += s * w[j].z; acc[c][3] += s * w[j].w; }
                }
            }
#pragma unroll
            for (int c = 0; c < 5; ++c)
#pragma unroll
                for (int j = 0; j < 4; ++j) R[(r * 5 + c) * 64 + c4 + j] = acc[c][j];
            __syncthreads();
            if (tid < 320) {
                const int c = tid >> 6, n = tid & 63;
                float s = p.in[7][l * 6144 + n0 + n];
                for (int rr = 0; rr < 32; ++rr) s += R[(rr * 5 + c) * 64 + n];
                ((float*)(p.ws + WS_MOD))[(l * 5 + c) * 6144 + n0 + n] = s;
            }
            __syncthreads();
        } else if (item < N_GEMV + N_TR) {
            const int e = item - N_GEMV;
            convert_weight_tile(p, fl, early ? (e < 240 ? e : 1456 + (e - 240)) : e);
        } else {
            const int it = item - N_GEMV - N_TR;
            const int e = it * 4096 + tid * 8;
            const float4 a = *(const float4*)(p.in[17] + e), b = *(const float4*)(p.in[17] + e + 4);
            u32x4 w; w.x = cvt_pk_bf16(a.x, a.y); w.y = cvt_pk_bf16(a.z, a.w); w.z = cvt_pk_bf16(b.x, b.y); w.w = cvt_pk_bf16(b.z, b.w);
            *(u32x4*)((bf16_t*)(p.ws + WS_WSGU) + e) = w;
        }
    }
}

template <int SRC, bool NEXT, bool XIN = false, bool XST = true>
__device__ __forceinline__ void phase_row(const Params& p, const void* ysrc, const float* ng_res, const float* modg  ,
                          const float* ng_next, const float* modn  , int sh_off, int sc_off, bool part,
                          int row_lo = 0, int row_hi = T_TOK, int wave0 = 0, int nwaves = 0) {
    const int tid_ = otid(); const int lane = tid_ & 63, wid = tid_ >> 6;
    bf16_t* A = (bf16_t*)(p.ws + WS_ABUF);
    float om[4];
    if (SRC == 0 || XIN) {
#pragma unroll
        for (int e = 0; e < 4; ++e) om[e] = exp2f(-(float)(lane * 4 + e) * (13.287712379549449f / 256.0f));
    }
    const int nw = nwaves ? nwaves : (int)gridDim.x * 8, R = (row_hi - row_lo + nw - 1) / nw;
    const int gw = (int)blockIdx.x * 8 + wid - wave0;
    int r_lo = row_lo + gw * R, r_hi = (r_lo + R < row_hi) ? (r_lo + R) : row_hi;
    if (gw < 0 || gw >= nw) { r_lo = 0; r_hi = 0; }
    const bool dopart = (SRC == 2) && part && (gridDim.x == 256);
    int cur_cond = -1;
    float4 gn[4], nn[4], shv[4];
    float4 cx[4], nx[4];
    float4 cy[4], ny[4];
    uint2 cyb[4], nyb[4], cpb[4], npb[4];
#pragma unroll
    for (int i = 0; i < 4; ++i) { cx[i] = nx[i] = cy[i] = ny[i] = make_float4(0.f, 0.f, 0.f, 0.f); cyb[i] = nyb[i] = cpb[i] = npb[i] = make_uint2(0u, 0u); }
    auto load_row = [&](int t, float4 (&x)[4], float4 (&y)[4], uint2 (&yb)[4], uint2 (&pb)[4]) {
        const float* xi = (SRC == 0 || XIN) ? ((t < T_PROMPT) ? (p.in[0] + (size_t)t * 1024) : (p.in[1] + (size_t)(t - T_PROMPT) * 1024)) : (p.out + (size_t)t * 1024);
#pragma unroll
        for (int i = 0; i < 4; ++i) x[i] = *(const float4*)(xi + lane * 4 + 256 * i);
        if (SRC == 1) {
#pragma unroll
            for (int i = 0; i < 4; ++i) y[i] = *(const float4*)((const float*)ysrc + (size_t)t * 1024 + lane * 4 + 256 * i);
        }
        if (SRC == 2) {
#pragma unroll
            for (int i = 0; i < 4; ++i) yb[i] = *(const uint2*)((const bf16_t*)ysrc + (size_t)t * 1024 + lane * 4 + 256 * i);
            if (dopart && t >= 16384) {
#pragma unroll
                for (int i = 0; i < 4; ++i) pb[i] = *(const uint2*)((const bf16_t*)(p.ws + WS_SCR) + (size_t)(t - 16384) * 1024 + lane * 4 + 256 * i);
            }
        }
    };
    if (r_lo < r_hi) load_row(r_lo, cx, cy, cyb, cpb);
    for (int t = r_lo; t < r_hi; ++t) {
        if (t + 1 < r_hi) load_row(t + 1, nx, ny, nyb, npb);
        const int cond = (t < T_PROMPT) ? 0 : 1 + ((t - T_PROMPT) >> 12);
        if (cond != cur_cond) {
            cur_cond = cond;
#pragma unroll
            for (int i = 0; i < 4; ++i) {
                if (SRC != 0) {
                    const float4 g = *(const float4*)(modg + cond * 6144 + lane * 4 + 256 * i), n = *(const float4*)(ng_res + lane * 4 + 256 * i);
                    gn[i] = make_float4(g.x * n.x, g.y * n.y, g.z * n.z, g.w * n.w);
                }
                if (NEXT) {
                    const float* mp = modn + cond * 6144 + lane * 4 + 256 * i;
                    const float4 n = *(const float4*)(ng_next + lane * 4 + 256 * i), sc = *(const float4*)(mp + sc_off);
                    shv[i] = *(const float4*)(mp + sh_off);
                    nn[i] = make_float4(n.x * (1.f + sc.x), n.y * (1.f + sc.y), n.z * (1.f + sc.z), n.w * (1.f + sc.w));
                }
            }
        }
        float4 xv[4];
#pragma unroll
        for (int i = 0; i < 4; ++i) xv[i] = cx[i];
        float* xo = p.out + (size_t)t * 1024 + lane * 4;
        if ((SRC == 0 || XIN) && t >= T_PROMPT) {
            const int tl = (t - T_PROMPT) & 4095;
            const float rr = (float)(tl >> 6), cc = (float)(tl & 63);
#pragma unroll
            for (int i = 0; i < 4; ++i) {
                const float base = (i < 2) ? rr : cc;
                float pe[4];
#pragma unroll
                for (int e = 0; e < 4; ++e) {
                    const float a = base * om[e];
                    const float k = rintf(a * 0.15915494309189535f);
                    float y = fmaf(-k, 6.28318548202514648f, a); y = fmaf(-k, -1.7484555e-07f, y);
                    pe[e] = (i & 1) ? __cosf(y) : __sinf(y);
                }
                xv[i].x += pe[0]; xv[i].y += pe[1]; xv[i].z += pe[2]; xv[i].w += pe[3];
            }
        }
        if (SRC != 0) {
            float4 yv[4];
            if (SRC == 1) {
#pragma unroll
                for (int i = 0; i < 4; ++i) yv[i] = cy[i];
            } else {
#pragma unroll
                for (int i = 0; i < 4; ++i) yv[i] = make_float4(bflo(cyb[i].x), bfhi(cyb[i].x), bflo(cyb[i].y), bfhi(cyb[i].y));
                if (dopart && t >= 16384) {
#pragma unroll
                    for (int i = 0; i < 4; ++i) { yv[i].x += bflo(cpb[i].x); yv[i].y += bfhi(cpb[i].x); yv[i].z += bflo(cpb[i].y); yv[i].w += bfhi(cpb[i].y); }
                }
            }
            float ss = 0.f;
#pragma unroll
            for (int i = 0; i < 4; ++i) ss += yv[i].x * yv[i].x + yv[i].y * yv[i].y + yv[i].z * yv[i].z + yv[i].w * yv[i].w;
            ss = wave_sum(ss);
            const float r = rsqrtf(ss * (1.0f / 1024.0f) + EPSN);
#pragma unroll
            for (int i = 0; i < 4; ++i) {
                xv[i].x += gn[i].x * (yv[i].x * r); xv[i].y += gn[i].y * (yv[i].y * r); xv[i].z += gn[i].z * (yv[i].z * r); xv[i].w += gn[i].w * (yv[i].w * r);
            }
        }
        if (XST) {
#pragma unroll
            for (int i = 0; i < 4; ++i) *(float4*)(xo + 256 * i) = xv[i];
        }
        if (NEXT) {
            float ss = 0.f;
#pragma unroll
            for (int i = 0; i < 4; ++i) ss += xv[i].x * xv[i].x + xv[i].y * xv[i].y + xv[i].z * xv[i].z + xv[i].w * xv[i].w;
            ss = wave_sum(ss);
            const float r = rsqrtf(ss * (1.0f / 1024.0f) + EPSN);
#pragma unroll
            for (int i = 0; i < 4; ++i) {
                const float h0 = xv[i].x * r * nn[i].x + shv[i].x, h1 = xv[i].y * r * nn[i].y + shv[i].y;
                const float h2 = xv[i].z * r * nn[i].z + shv[i].z, h3 = xv[i].w * r * nn[i].w + shv[i].w;
                uint2 w; w.x = cvt_pk_bf16(h0, h1); w.y = cvt_pk_bf16(h2, h3);
                *(uint2*)(A + (size_t)t * 1024 + lane * 4 + 256 * i) = w;
            }
        }
#pragma unroll
        for (int i = 0; i < 4; ++i) { cx[i] = nx[i]; cy[i] = ny[i]; cyb[i] = nyb[i]; cpb[i] = npb[i]; }
    }
}

__device__ __forceinline__ void phase_gla_combine(const Params& p) {
    const int tid_ = otid(); const int lane = tid_ & 63, wid = tid_ >> 6;
    const bf16_t* proj = (const bf16_t*)(p.ws + WS_BIG + BIG_PROJ);
    const bf16_t* of = (const bf16_t*)(p.ws + WS_BIG + BIG_OF);
    const bf16_t* ob = (const bf16_t*)(p.ws + WS_BIG + BIG_OB);
    bf16_t* A = (bf16_t*)(p.ws + WS_ABUF);
    const float4 gn0 = *(const float4*)(p.in[21] + lane * 8), gn1 = *(const float4*)(p.in[21] + lane * 8 + 4);
    const float gn[8] = {gn0.x, gn0.y, gn0.z, gn0.w, gn1.x, gn1.y, gn1.z, gn1.w};
    const int nw = gridDim.x * 8, R = (T_TOK + nw - 1) / nw, gw = blockIdx.x * 8 + wid;
    const int r_lo = gw * R, r_hi = (r_lo + R < T_TOK) ? (r_lo + R) : T_TOK;
    u32x4 a = (u32x4){0, 0, 0, 0}, b = a, g = a, na = a, nb = a, ngv = a;
    if (r_lo < r_hi) { a = *(const u32x4*)(of + (size_t)r_lo * 512 + lane * 8); b = *(const u32x4*)(ob + (size_t)r_lo * 512 + lane * 8); g = *(const u32x4*)(proj + (size_t)r_lo * EVN + 2048 + lane * 8); }
    for (int t = r_lo; t < r_hi; ++t) {
        if (t + 1 < r_hi) { na = *(const u32x4*)(of + (size_t)(t + 1) * 512 + lane * 8); nb = *(const u32x4*)(ob + (size_t)(t + 1) * 512 + lane * 8); ngv = *(const u32x4*)(proj + (size_t)(t + 1) * EVN + 2048 + lane * 8); }
        float o[8], gg[8];
#pragma unroll
        for (int j = 0; j < 4; ++j) { o[2 * j] = bflo(a[j]) + bflo(b[j]); o[2 * j + 1] = bfhi(a[j]) + bfhi(b[j]); gg[2 * j] = bflo(g[j]); gg[2 * j + 1] = bfhi(g[j]); }
        float ss = 0.f;
#pragma unroll
        for (int j = 0; j < 8; ++j) ss += o[j] * o[j];
#pragma unroll
        for (int m = 8; m > 0; m >>= 1) ss += __shfl_xor(ss, m, 64);
        const float r = rsqrtf(ss * (1.0f / 128.0f) + EPSN);
        float v[8];
#pragma unroll
        for (int j = 0; j < 8; ++j) v[j] = o[j] * r * gn[j] * (gg[j] * sigmoidf_(gg[j]));
        u32x4 w; w.x = cvt_pk_bf16(v[0], v[1]); w.y = cvt_pk_bf16(v[2], v[3]); w.z = cvt_pk_bf16(v[4], v[5]); w.w = cvt_pk_bf16(v[6], v[7]);
        *(u32x4*)(A + (size_t)t * 1024 + 512 + lane * 8) = w;
        a = na; b = nb; g = ngv;
    }
}

__device__ __forceinline__ void sgu_item(const Params& p, unsigned char* shm, int item) {
#ifdef SKIP_SGU
    return;
#endif
    const int tid = otid(), lane = tid & 63, wid = tid >> 6, quad = lane >> 4;
    const int c = item >> 2, g = item & 3, t0 = c * 128;
    const bf16_t* proj = (const bf16_t*)(p.ws + WS_BIG + BIG_PROJ);
    bf16_t* A = (bf16_t*)(p.ws + WS_ABUF);
    float* MU = (float*)shm; float* RS = MU + 128;
    unsigned short* VNT = (unsigned short*)(shm + 1024);
    unsigned short* WSA = (unsigned short*)(shm + 1024 + 34816);
    {
        u32x4 v[16];
#pragma unroll
        for (int rr = 0; rr < 16; ++rr) v[rr] = *(const u32x4*)(proj + (size_t)(t0 + wid * 16 + rr) * EVN + 512 + lane * 8);
#pragma unroll
        for (int rr = 0; rr < 16; ++rr) {
            float s = 0.f, ss = 0.f;
#pragma unroll
            for (int j = 0; j < 4; ++j) { const float a = bflo(v[rr][j]), b = bfhi(v[rr][j]); s += a + b; ss += a * a + b * b; }
            s = wave_sum(s); ss = wave_sum(ss);
            if (lane == 0) { const float mu = s * (1.0f / 512.0f); const float var = fmaxf(ss * (1.0f / 512.0f) - mu * mu, 0.f); MU[wid * 16 + rr] = mu; RS[wid * 16 + rr] = rsqrtf(var + EPSN); }
        }
    }
    {
        const bf16_t* wsg = (const bf16_t*)(p.ws + WS_WSGU) + (size_t)g * 16384;
#pragma unroll
        for (int i = 0; i < 4; ++i) { const int e = tid + 512 * i, row = e >> 4, c8 = (e & 15) * 8; *(u32x4*)(WSA + row * 136 + c8) = *(const u32x4*)(wsg + row * 128 + c8); }
    }
    lds_barrier();
    {
        const int q = tid >> 2, d32 = (tid & 3) * 32;
        const float mu = MU[q], rs = RS[q];
        const bf16_t* src = proj + (size_t)(t0 + q) * EVN + 512 + g * 128 + d32;
        const float* lg = p.in[15] + g * 128 + d32; const float* lb = p.in[16] + g * 128 + d32;
#pragma unroll
        for (int i = 0; i < 4; ++i) {
            const u32x4 w = *(const u32x4*)(src + i * 8);
#pragma unroll
            for (int j = 0; j < 4; ++j) {
                const int d = d32 + i * 8 + 2 * j;
                const float a = (bflo(w[j]) - mu) * rs * lg[i * 8 + 2 * j] + lb[i * 8 + 2 * j];
                const float b = (bfhi(w[j]) - mu) * rs * lg[i * 8 + 2 * j + 1] + lb[i * 8 + 2 * j + 1];
                VNT[d * 136 + q] = f2bf(a); VNT[(d + 1) * 136 + q] = f2bf(b);
            }
        }
    }
    lds_barrier();
    {
        f32x4 acc[8];
#pragma unroll
        for (int dt = 0; dt < 8; ++dt) acc[dt] = (f32x4){0.f, 0.f, 0.f, 0.f};
#pragma unroll
        for (int ks = 0; ks < 4; ++ks) {
            const bf16x8 b = ldfrag(WSA, 136, wid * 16, ks * 32, lane);
#pragma unroll
            for (int dt = 0; dt < 8; ++dt) { const bf16x8 a = ldfrag(VNT, 136, dt * 16, ks * 32, lane); acc[dt] = MFMA16(a, b, acc[dt]); }
        }
        const int pp = wid * 16 + (lane & 15), t = t0 + pp;
        const float bsv = p.in[18][g * 128 + pp];
#pragma unroll
        for (int dt = 0; dt < 8; ++dt) {
            const int d = dt * 16 + quad * 4;
            const uint2 uw = *(const uint2*)(proj + (size_t)t * EVN + g * 128 + d);
            uint2 w; w.x = cvt_pk_bf16(bflo(uw.x) * (acc[dt][0] + bsv), bfhi(uw.x) * (acc[dt][1] + bsv)); w.y = cvt_pk_bf16(bflo(uw.y) * (acc[dt][2] + bsv), bfhi(uw.y) * (acc[dt][3] + bsv));
            *(uint2*)(A + (size_t)t * 1024 + g * 128 + d) = w;
        }
    }
    lds_barrier();
}

__device__ __forceinline__ float fexp(float x) { return __builtin_amdgcn_exp2f(x * 1.4426950408889634f); }
__device__ __forceinline__ float flog(float x) { return __builtin_amdgcn_logf(x) * 0.6931471805599453f; }
__device__ __forceinline__ void gla_item(const Params& p, unsigned char* shm, int item) {
    const int tid = otid(), lane = tid & 63, wid = tid >> 6, quad = lane >> 4, l15 = lane & 15;
#ifdef SKIP_GLAP
    if (item >= 128) return;
#endif
    int s, rem;
    if (item < 128) { s = 16 + (item >> 5); rem = item & 31; } else { s = (item - 128) >> 5; rem = (item - 128) & 31; }
    const int h = rem >> 3, dir = (rem >> 2) & 1, sl = rem & 3;
    const int ts = (s < 16) ? s * 256 : T_PROMPT + (s - 16) * 4096, L = (s < 16) ? 256 : 4096, nc = L >> 6;
    const bf16_t* proj = (const bf16_t*)(p.ws + WS_BIG + BIG_PROJ);
    bf16_t* O = (bf16_t*)(p.ws + WS_BIG + (dir ? BIG_OB : BIG_OF));
    unsigned short* QR = (unsigned short*)(shm + 0);
    unsigned short* KR = (unsigned short*)(shm + 8192);
    unsigned short* LR = (unsigned short*)(shm + 82944);
    float* LA = (float*)(shm + 18432);
    float* SEG = (float*)(shm + 34816);
    unsigned short* QE = (unsigned short*)(shm + 36864);
    unsigned short* KE = (unsigned short*)(shm + 46080);
    unsigned short* KDT = (unsigned short*)(shm + 55296);
    unsigned short* VT = (unsigned short*)(shm + 64512);
    unsigned short* ST = (unsigned short*)(shm + 69120);
    unsigned short* ATT = (unsigned short*)(shm + 73728);
    float* DEC = (float*)(shm + 88064);
    const int lrow = tid >> 3, lc8 = (tid & 7) * 8;
    u32x4 qreg, kreg, vreg = (u32x4){0, 0, 0, 0};
    auto issue = [&](int n) {
        const int t0 = dir ? (ts + L - 64 * (n + 1)) : (ts + 64 * n);
        const int tq = dir ? (t0 + 63 - lrow) : (t0 + lrow);
        qreg = *(const u32x4*)(proj + (size_t)tq * EVN + 1024 + h * 64 + lc8);
        kreg = *(const u32x4*)(proj + (size_t)tq * EVN + 1280 + h * 64 + lc8);
        if (tid < 256) { const int vr = tid >> 2; const int tv = dir ? (t0 + 63 - vr) : (t0 + vr); vreg = *(const u32x4*)(proj + (size_t)tv * EVN + 1536 + h * 128 + sl * 32 + (tid & 3) * 8); }
        else if (tid < 384) { const int e = tid - 256, r = e >> 1; const int tl = dir ? (t0 + 63 - r) : (t0 + r); vreg = *(const u32x4*)(proj + (size_t)tl * EVN + 2560 + dir * 16 + (e & 1) * 8); }
    };
    issue(0);
    const int gmt = (wid * 2) >> 2, gnt0 = (wid * 2) & 3;
    bf16x8 gwf[2]; float gbv[2];
#pragma unroll
    for (int tt = 0; tt < 2; ++tt) {
        const int dkc = h * 64 + (gnt0 + tt) * 16 + l15;
        float wv[8];
#pragma unroll
        for (int j = 0; j < 8; ++j) wv[j] = (quad < 2) ? p.in[19][(dir * 16 + quad * 8 + j) * 256 + dkc] : 0.f;
        u32x4 pw; pw.x = cvt_pk_bf16(wv[0], wv[1]); pw.y = cvt_pk_bf16(wv[2], wv[3]); pw.z = cvt_pk_bf16(wv[4], wv[5]); pw.w = cvt_pk_bf16(wv[6], wv[7]);
        gwf[tt] = __builtin_bit_cast(bf16x8, pw);
        gbv[tt] = p.in[20][dir * 256 + dkc];
    }
    { unsigned z0 = 0; asm volatile("" : "+v"(z0));
      if (tid < 128) *(u32x4*)(LR + (tid >> 1) * 40 + 16 + (tid & 1) * 8) = (u32x4){z0, z0, z0, z0}; }
    const int mt = wid >> 1, nt = wid & 1;
    f32x4 Sacc = (f32x4){0.f, 0.f, 0.f, 0.f};
    if (s >= 16) {
        const float* st = p.in[3] + ((size_t)(((s - 16) * 2 + dir) * 4 + h) * 64) * 128;
#pragma unroll
        for (int j = 0; j < 4; ++j) Sacc[j] = st[(mt * 16 + quad * 4 + j) * 128 + sl * 32 + nt * 16 + l15];
    }
    unsigned dbgc = 0;
    uint2 pend_w = make_uint2(0u, 0u); bf16_t* pend_ptr = nullptr;
    for (int n = 0; n < nc; ++n) {
        const int t0 = dir ? (ts + L - 64 * (n + 1)) : (ts + 64 * n);
        *(u32x4*)(QR + lrow * 64 + lc8) = qreg; *(u32x4*)(KR + lrow * 64 + lc8) = kreg;
        if (tid < 256) { const int vr = tid >> 2, d8 = (tid & 3) * 8;
#pragma unroll
            for (int j = 0; j < 4; ++j) { VT[(d8 + 2 * j) * 72 + vr] = (unsigned short)(vreg[j] & 0xffffu); VT[(d8 + 2 * j + 1) * 72 + vr] = (unsigned short)(vreg[j] >> 16); } }
        else if (tid < 384) { const int e = tid - 256; *(u32x4*)(LR + (e >> 1) * 40 + (e & 1) * 8) = vreg; }
        if (n > 0) *(uint2*)pend_ptr = pend_w;
        if (n + 1 < nc) issue(n + 1);
        lds_barrier();
        {
            const bf16x8 af = ldfrag(LR, 40, gmt * 16, 0, lane);
#pragma unroll
            for (int tt = 0; tt < 2; ++tt) {
                f32x4 zc = (f32x4){0.f, 0.f, 0.f, 0.f};
                zc = MFMA16(af, gwf[tt], zc);
#pragma unroll
                for (int j = 0; j < 4; ++j) {
                    const float z = zc[j] + gbv[tt];
                    LA[(gmt * 16 + quad * 4 + j) * 64 + (gnt0 + tt) * 16 + l15] = (fminf(z, 0.f) - flog(1.0f + fexp(-fabsf(z)))) * 0.0625f;
                }
            }
        }
        lds_barrier();
        const int dk = lane, seg = wid;
        float cs[8];
        {
            float run = 0.f;
#pragma unroll
            for (int i = 0; i < 8; ++i) { run += LA[(seg * 8 + i) * 64 + dk]; cs[i] = run; }
            SEG[seg * 64 + dk] = run;
        }
        lds_barrier();
        {
            float pre = 0.f, tot = 0.f;
#pragma unroll
            for (int s2 = 0; s2 < 8; ++s2) { const float v = SEG[s2 * 64 + dk]; if (s2 < seg) pre += v; tot += v; }
            float kd[8];
            const float etot = fexp(tot);
#pragma unroll
            for (int i = 0; i < 8; ++i) {
                const int row = seg * 8 + i;
                const float b = pre + cs[i];
                const float q = bf2f(QR[row * 64 + dk]) * 0.125f, k = bf2f(KR[row * 64 + dk]);
#ifdef DBG_GLA
                if (!(fabsf(b) < 80.f)) dbgc |= 4u;
                if (!(fabsf(q) < 1e4f) || !(fabsf(k) < 1e4f)) dbgc |= 8u;
#endif
                const float eb = fexp(b), ke = k * __builtin_amdgcn_rcpf(eb);
                QE[row * 72 + dk] = f2bf(q * eb);
                KE[row * 72 + dk] = f2bf(ke);
                kd[i] = ke * etot;
            }
            u32x4 w; w.x = cvt_pk_bf16(kd[0], kd[1]); w.y = cvt_pk_bf16(kd[2], kd[3]); w.z = cvt_pk_bf16(kd[4], kd[5]); w.w = cvt_pk_bf16(kd[6], kd[7]);
            *(u32x4*)(KDT + dk * 72 + seg * 8) = w;
            if (seg == 0) DEC[dk] = etot;
            uint2 sw; sw.x = cvt_pk_bf16(Sacc[0], Sacc[1]); sw.y = cvt_pk_bf16(Sacc[2], Sacc[3]);
            *(uint2*)(ST + (nt * 16 + l15) * 72 + mt * 16 + quad * 4) = sw;
        }
        lds_barrier();
#pragma unroll
        for (int tt = 0; tt < 2; ++tt) {
            const int idx = wid * 2 + tt, it = idx >> 2, jt = idx & 3;
            f32x4 acc = (f32x4){0.f, 0.f, 0.f, 0.f};
            if (jt <= it) {
#pragma unroll
                for (int ks = 0; ks < 2; ++ks) { const bf16x8 a = ldfrag(KE, 72, jt * 16, ks * 32, lane), b = ldfrag(QE, 72, it * 16, ks * 32, lane); acc = MFMA16(a, b, acc); }
            }
#ifdef DBG_GLA
            for (int j = 0; j < 4; ++j) if (!(fabsf(acc[j]) < 1e30f)) dbgc |= 16u;
#endif
            const int i = it * 16 + l15, j0 = jt * 16 + quad * 4;
            uint2 w; w.x = cvt_pk_bf16(i >= j0 ? acc[0] : 0.f, i >= j0 + 1 ? acc[1] : 0.f); w.y = cvt_pk_bf16(i >= j0 + 2 ? acc[2] : 0.f, i >= j0 + 3 ? acc[3] : 0.f);
            *(uint2*)(ATT + i * 72 + j0) = w;
        }
        lds_barrier();
        {
            f32x4 acc = (f32x4){0.f, 0.f, 0.f, 0.f};
#pragma unroll
            for (int ks = 0; ks < 2; ++ks) { const bf16x8 a = ldfrag(VT, 72, nt * 16, ks * 32, lane), b = ldfrag(ATT, 72, mt * 16, ks * 32, lane); acc = MFMA16(a, b, acc); }
#pragma unroll
            for (int ks = 0; ks < 2; ++ks) { const bf16x8 a = ldfrag(ST, 72, nt * 16, ks * 32, lane), b = ldfrag(QE, 72, mt * 16, ks * 32, lane); acc = MFMA16(a, b, acc); }
#ifdef DBG_GLA
            for (int j = 0; j < 4; ++j) if (!(fabsf(acc[j]) < 1e30f)) dbgc |= 32u;
#endif
            const int i = mt * 16 + l15; const int t = dir ? (t0 + 63 - i) : (t0 + i);
            uint2 w; w.x = cvt_pk_bf16(acc[0], acc[1]); w.y = cvt_pk_bf16(acc[2], acc[3]);
            pend_w = w; pend_ptr = O + (size_t)t * 512 + h * 128 + sl * 32 + nt * 16 + quad * 4;
        }
        {
#pragma unroll
            for (int j = 0; j < 4; ++j) Sacc[j] *= DEC[mt * 16 + quad * 4 + j];
#pragma unroll
            for (int ks = 0; ks < 2; ++ks) { const bf16x8 a = ldfrag(KDT, 72, mt * 16, ks * 32, lane), b = ldfrag(VT, 72, nt * 16, ks * 32, lane); Sacc = MFMA16(a, b, Sacc); }
        }
        lds_barrier();
    }
    *(uint2*)pend_ptr = pend_w;
    if (s < 16) {
        float* so = p.out + (size_t)T_TOK * 1024 + ((size_t)((s * 2 + dir) * 4 + h) * 64) * 128;
#pragma unroll
        for (int j = 0; j < 4; ++j) so[(mt * 16 + quad * 4 + j) * 128 + sl * 32 + nt * 16 + l15] = Sacc[j];
    }
}

__device__ __forceinline__ void phase_mix_even(const Params& p, unsigned char* shm) {
    constexpr int N_GLA = 640, N_ALL = 1280;
    if (gridDim.x == 256) {
        if (blockIdx.x < 128) gla_item(p, shm, blockIdx.x);
        else for (int it = 128 + (blockIdx.x - 128); it < N_ALL; it += 128) { if (it < N_GLA) gla_item(p, shm, it); else sgu_item(p, shm, it - N_GLA); }
    } else {
        for (int it = blockIdx.x; it < N_ALL; it += gridDim.x) { if (it < N_GLA) gla_item(p, shm, it); else sgu_item(p, shm, it - N_GLA); }
    }
}

template <int PASS>
__device__ __forceinline__ void phase_rg(const Params& p, unsigned char* shm) {
    const int tid = otid(), lane = tid & 63, wid = tid >> 6, quad = lane >> 4, l15 = lane & 15;
    const bf16_t* rgp = (const bf16_t*)(p.ws + WS_BIG + BIG_RGP);
    unsigned short* WG = (unsigned short*)(shm);
    float* XC = (float*)(shm + 36864);
    float* AF = (float*)(shm + 53248); float* BF = AF + 4096; float* AB = BF + 4096; float* BB = AB + 4096;
    unsigned short* XCB = (unsigned short*)(shm + 118784);
    unsigned short* XB = (unsigned short*)(shm + 128000);
    float2* SG = (float2*)(shm + 136576);
    const int row = tid >> 3, c8 = (tid & 7) * 8;
    const int jt = wid & 3, tp = wid >> 2;
    int cur_hb = -1;
    float sp[2], ba[2], bx[2], cbv[8], cwv[4][8];
    u32x4 xreg = (u32x4){0, 0, 0, 0}, xreg2 = (u32x4){0, 0, 0, 0}, greg = (u32x4){0, 0, 0, 0};
    auto issue = [&](int item) {
        const int c = item >> 4, hb = item & 15, t0 = c * 64;
        const int s_lo = (t0 < T_PROMPT) ? (t0 & ~255) : (T_PROMPT + ((t0 - T_PROMPT) & ~4095));
        const int s_hi = s_lo + ((t0 < T_PROMPT) ? 256 : 4096);
        const int tt = t0 - 2 + row;
        xreg = (u32x4){0, 0, 0, 0};
        if (tt >= s_lo && tt < s_hi) xreg = *(const u32x4*)(rgp + (size_t)tt * 2048 + hb * 64 + c8);
        if (tid < 24) {
            const int t2 = t0 + 62 + (tid >> 3);
            xreg2 = (u32x4){0, 0, 0, 0};
            if (t2 >= s_lo && t2 < s_hi) xreg2 = *(const u32x4*)(rgp + (size_t)t2 * 2048 + hb * 64 + c8);
        }
        if (PASS == 1) greg = *(const u32x4*)(rgp + (size_t)(t0 + row) * 2048 + 1024 + hb * 64 + c8);
    };
    u32x4 pend_w = (u32x4){0, 0, 0, 0}; bf16_t* pend_ptr = nullptr; float pend_a = 0.f, pend_b = 0.f; float* pend_s = nullptr;
    int item = blockIdx.x;
    if (item < 5120) issue(item);
    for (; item < 5120; item += gridDim.x) {
        const int c = item >> 4, hb = item & 15, t0 = c * 64;
        if (hb != cur_hb) {
            lds_barrier();
            cur_hb = hb;
            const bf16_t* wg = (const bf16_t*)(p.ws + WS_WRGG) + (size_t)hb * 256 * 64;
#pragma unroll
            for (int i = 0; i < 4; ++i) { const int e = tid + 512 * i, r = e >> 3, cc = (e & 7) * 8; *(u32x4*)(WG + r * 72 + cc) = *(const u32x4*)(wg + r * 64 + cc); }
            const int gch = hb * 64 + jt * 16 + l15;
#pragma unroll
            for (int d = 0; d < 2; ++d) {
                const float lam = p.in[29][d * 1024 + gch];
                sp[d] = 8.0f * (fmaxf(-lam, 0.f) + __logf(1.0f + __expf(-fabsf(lam))));
                ba[d] = p.in[26][d * 1024 + gch]; bx[d] = p.in[28][d * 1024 + gch];
            }
#pragma unroll
            for (int j = 0; j < 8; ++j) { cbv[j] = p.in[24][hb * 64 + c8 + j];
#pragma unroll
                for (int tap = 0; tap < 4; ++tap) cwv[tap][j] = p.in[23][tap * 1024 + hb * 64 + c8 + j]; }
        }
        *(u32x4*)(XB + row * 64 + c8) = xreg;
        if (tid < 24) *(u32x4*)(XB + (64 + (tid >> 3)) * 64 + c8) = xreg2;
        const u32x4 gg = greg;
        if (PASS == 0) { if (pend_s) { pend_s[0] = pend_a; pend_s[1024] = pend_b; } } else { if (pend_ptr) *(u32x4*)pend_ptr = pend_w; }
        if (item + (int)gridDim.x < 5120) issue(item + gridDim.x);
        lds_barrier();
        {
            float xc[8];
#pragma unroll
            for (int j = 0; j < 8; ++j) xc[j] = cbv[j];
#pragma unroll
            for (int tap = 0; tap < 4; ++tap) {
                const u32x4 v = *(const u32x4*)(XB + (row + tap) * 64 + c8);
#pragma unroll
                for (int j = 0; j < 4; ++j) { xc[2 * j] += cwv[tap][2 * j] * bflo(v[j]); xc[2 * j + 1] += cwv[tap][2 * j + 1] * bfhi(v[j]); }
            }
            *(f32x4*)(XC + row * 64 + c8) = (f32x4){xc[0], xc[1], xc[2], xc[3]};
            *(f32x4*)(XC + row * 64 + c8 + 4) = (f32x4){xc[4], xc[5], xc[6], xc[7]};
            u32x4 w; w.x = cvt_pk_bf16(xc[0], xc[1]); w.y = cvt_pk_bf16(xc[2], xc[3]); w.z = cvt_pk_bf16(xc[4], xc[5]); w.w = cvt_pk_bf16(xc[6], xc[7]);
            *(u32x4*)(XCB + row * 72 + c8) = w;
        }
        lds_barrier();
        {
            f32x4 acc[2][4];
#pragma unroll
            for (int a = 0; a < 2; ++a)
#pragma unroll
                for (int b = 0; b < 4; ++b) acc[a][b] = (f32x4){0.f, 0.f, 0.f, 0.f};
#pragma unroll
            for (int ks = 0; ks < 2; ++ks) {
                const bf16x8 a0 = ldfrag(XCB, 72, (2 * tp) * 16, ks * 32, lane), a1 = ldfrag(XCB, 72, (2 * tp + 1) * 16, ks * 32, lane);
#pragma unroll
                for (int mat = 0; mat < 4; ++mat) { const bf16x8 b = ldfrag(WG, 72, mat * 64 + jt * 16, ks * 32, lane); acc[0][mat] = MFMA16(a0, b, acc[0][mat]); acc[1][mat] = MFMA16(a1, b, acc[1][mat]); }
            }
            const int ch = jt * 16 + l15;
#pragma unroll
            for (int t2 = 0; t2 < 2; ++t2)
#pragma unroll
                for (int j = 0; j < 4; ++j) {
                    const int tok = (2 * tp + t2) * 16 + quad * 4 + j;
                    const float x = XC[tok * 64 + ch];
#pragma unroll
                    for (int d = 0; d < 2; ++d) {
                        const float e1 = fexp(-(acc[t2][2 * d][j] + ba[d])), e2 = fexp(-(acc[t2][2 * d + 1][j] + bx[d]));
                        const float p1 = 1.0f + e1, p2 = 1.0f + e2, inv = __builtin_amdgcn_rcpf(p1 * p2);
                        const float r = p2 * inv, ig = p1 * inv;
                        const float a = fexp(-r * sp[d]);
                        const float bt = __builtin_amdgcn_sqrtf(fmaxf(1.0f - a * a, 0.f)) * ig * x;
                        (d ? AB : AF)[tok * 64 + ch] = a; (d ? BB : BF)[tok * 64 + ch] = bt;
                    }
                }
        }
        lds_barrier();
        {
            const int ch = tid & 63, d = (tid >> 6) & 1, q = tid >> 7;
            const float* Ap = d ? AB : AF; float* Bp = d ? BB : BF;
            float av[16], bv[16];
#pragma unroll
            for (int i = 0; i < 16; ++i) { const int st = q * 16 + i, tok = d ? 63 - st : st; av[i] = Ap[tok * 64 + ch]; bv[i] = Bp[tok * 64 + ch]; }
            float A = 1.f, B = 0.f;
#pragma unroll
            for (int i = 0; i < 16; ++i) { B = av[i] * B + bv[i]; A *= av[i]; }
            SG[(q * 2 + d) * 64 + ch] = make_float2(A, B);
            lds_barrier();
            if (PASS == 0) {
                if (q == 0) {
                    float A2 = 1.f, B2 = 0.f;
#pragma unroll
                    for (int k = 0; k < 4; ++k) { const float2 sg = SG[(k * 2 + d) * 64 + ch]; B2 = sg.x * B2 + sg.y; A2 *= sg.x; }
                    pend_s = (float*)(p.ws + WS_BIG + BIG_RGSUM) + (size_t)(c * 2 + d) * 2048 + hb * 64 + ch; pend_a = A2; pend_b = B2;
                }
            } else {
                float hcur = ((const float*)(p.ws + WS_BIG + BIG_RGCAR))[(size_t)(c * 2 + d) * 1024 + hb * 64 + ch];
                for (int k = 0; k < q; ++k) { const float2 sg = SG[(k * 2 + d) * 64 + ch]; hcur = sg.x * hcur + sg.y; }
#pragma unroll
                for (int i = 0; i < 16; ++i) { const int st = q * 16 + i, tok = d ? 63 - st : st; hcur = av[i] * hcur + bv[i]; Bp[tok * 64 + ch] = hcur; }
            }
        }
        if (PASS == 1) {
            lds_barrier();
            {
                const int t = t0 + row;
                const f32x4 f0 = *(const f32x4*)(BF + row * 64 + c8), f1 = *(const f32x4*)(BF + row * 64 + c8 + 4);
                const f32x4 b0 = *(const f32x4*)(BB + row * 64 + c8), b1 = *(const f32x4*)(BB + row * 64 + c8 + 4);
                u32x4 w;
                w.x = cvt_pk_bf16((f0[0] + b0[0]) * bflo(gg[0]), (f0[1] + b0[1]) * bfhi(gg[0]));
                w.y = cvt_pk_bf16((f0[2] + b0[2]) * bflo(gg[1]), (f0[3] + b0[3]) * bfhi(gg[1]));
                w.z = cvt_pk_bf16((f1[0] + b1[0]) * bflo(gg[2]), (f1[1] + b1[1]) * bfhi(gg[2]));
                w.w = cvt_pk_bf16((f1[2] + b1[2]) * bflo(gg[3]), (f1[3] + b1[3]) * bfhi(gg[3]));
                pend_w = w; pend_ptr = (bf16_t*)(p.ws + WS_ABUF) + (size_t)t * 1024 + hb * 64 + c8;
            }
        }
    }
    if (PASS == 0) { if (pend_s) { pend_s[0] = pend_a; pend_s[1024] = pend_b; } } else { if (pend_ptr) *(u32x4*)pend_ptr = pend_w; }
    lds_barrier();
}

__device__ __forceinline__ void phase_rg_carry(const Params& p) {
    const int idx = blockIdx.x * 512 + otid();
    for (int e = idx; e < 20 * 2 * 1024; e += gridDim.x * 512) {
        const int s = e >> 11, d = (e >> 10) & 1, ch = e & 1023;
        const int nc = (s < 16) ? 4 : 64, cbase = (s < 16) ? s * 4 : 64 + (s - 16) * 64;
        const float* sum = (const float*)(p.ws + WS_BIG + BIG_RGSUM);
        float* car = (float*)(p.ws + WS_BIG + BIG_RGCAR);
        float h = (s < 16) ? 0.f : p.in[4][((s - 16) * 2 + d) * 1024 + ch];
        for (int n0 = 0; n0 < nc; n0 += 4) {
            float A[4], B[4];
#pragma unroll
            for (int j = 0; j < 4; ++j) { const int n = d ? (nc - 1 - (n0 + j)) : (n0 + j); const float* sp = sum + (size_t)((cbase + n) * 2 + d) * 2048 + ch; A[j] = sp[0]; B[j] = sp[1024]; }
#pragma unroll
            for (int j = 0; j < 4; ++j) { const int n = d ? (nc - 1 - (n0 + j)) : (n0 + j); car[(size_t)((cbase + n) * 2 + d) * 1024 + ch] = h; h = A[j] * h + B[j]; }
        }
        if (s < 16) p.out[(size_t)T_TOK * 1024 + 1048576 + (s * 2 + d) * 1024 + ch] = h;
    }
}

#define XB_TMO      128
#define XB_XCNT(j)  (256  + 64 * (j))
#define XB_XSUB(j)  (1280 + 64 * (j))
#define XB_XGEN(j)  (2304 + 64 * (j))
#define XB_TOP      3328
#define XB_TOPGEN   3392
#define XCD_BAR_WORDS 3456
#define XB_SPIN_CAP (1u << 18)
#define LAS __attribute__((address_space(3)))

__device__ __forceinline__ unsigned xb_ld(unsigned* p)              { return __hip_atomic_load(p, __ATOMIC_RELAXED, __HIP_MEMORY_SCOPE_AGENT); }
__device__ __forceinline__ unsigned xb_add(unsigned* p, unsigned v) { return __hip_atomic_fetch_add(p, v, __ATOMIC_RELAXED, __HIP_MEMORY_SCOPE_AGENT); }
__device__ __forceinline__ unsigned xb_xcc_id() { return (unsigned)__builtin_amdgcn_s_getreg((3 << 11) | 20) & 0xFu; }
#define XB_SPIN(cond, bar) do { unsigned _sp = 0; while (cond) { __builtin_amdgcn_s_sleep(1); \
    if ((++_sp & 255u) == 0u) { if (xb_ld(&(bar)[XB_TMO])) break; if (_sp > XB_SPIN_CAP) { atomicAdd(&(bar)[XB_TMO], 1u); break; } } } } while (0)

struct XcdBarrier {
    unsigned* bar; unsigned x;
    volatile LAS unsigned* st;
};

__device__ __forceinline__ XcdBarrier xcd_barrier_post(unsigned* bar, volatile LAS unsigned* st) {
    XcdBarrier b; b.bar = bar; b.x = xb_xcc_id(); b.st = st;
    if (threadIdx.x == 0) (void)xb_add(&bar[XB_XCNT(b.x)], 1u);
    return b;
}
__device__ __forceinline__ void xcd_barrier_complete(unsigned* bar, unsigned x, unsigned& nloc, unsigned& nx) {
    const unsigned G = gridDim.x * gridDim.y * gridDim.z;
    unsigned sum, cnt, mine, sp = 0u;
    for (;;) {
        sum = 0u; cnt = 0u; mine = 0u;
#pragma unroll
        for (unsigned j = 0; j < 16; ++j) { const unsigned c = xb_ld(&bar[XB_XCNT(j)]); sum += c; cnt += (c > 0u) ? 1u : 0u; mine = (j == x) ? c : mine; }
        if (sum == G) break;
        __builtin_amdgcn_s_sleep(1);
        if ((++sp & 255u) == 0u) { if (xb_ld(&bar[XB_TMO])) break; if (sp > XB_SPIN_CAP) { atomicAdd(&bar[XB_TMO], 1u); break; } }
    }
    nloc = mine > 0u ? mine : 1u; nx = cnt > 0u ? cnt : 1u;
}

__device__ __forceinline__ void xcd_barrier(const XcdBarrier& b) {
    asm volatile("s_waitcnt vmcnt(0)" ::: "memory");
    __syncthreads();
    if (threadIdx.x == 0) {
        unsigned* bar = b.bar;
        __builtin_amdgcn_s_waitcnt(0);
        unsigned nloc = b.st[0], nx = b.st[1];
        if (nloc == 0u) { xcd_barrier_complete(bar, b.x, nloc, nx); b.st[0] = nloc; b.st[1] = nx; }
        const unsigned old = xb_add(&bar[XB_XSUB(b.x)], 1u);
        const unsigned gen = old / nloc;
        if (old + 1u == (gen + 1u) * nloc) {
            __builtin_amdgcn_fence(__ATOMIC_RELEASE, "agent");
            asm volatile("s_waitcnt vmcnt(0)" ::: "memory");
            const unsigned og = xb_add(&bar[XB_TOP], 1u);
            const unsigned tg = og / nx;
            if (og + 1u == (tg + 1u) * nx) xb_add(&bar[XB_TOPGEN], 1u);
            else XB_SPIN(xb_ld(&bar[XB_TOPGEN]) == tg, bar);
            __builtin_amdgcn_fence(__ATOMIC_ACQUIRE, "agent");
            xb_add(&bar[XB_XGEN(b.x)], 1u);
            asm volatile("s_waitcnt vmcnt(0)" ::: "memory");
        } else {
            XB_SPIN(xb_ld(&bar[XB_XGEN(b.x)]) == gen, bar);
            __builtin_amdgcn_fence(__ATOMIC_ACQUIRE, "agent");
            asm volatile("s_waitcnt vmcnt(0)" ::: "memory");
        }
    }
    __syncthreads();
}

constexpr size_t WS_CNT = WS_BAR + 14336;
__device__ __forceinline__ void xcd_arrive(unsigned* xcnt, unsigned* gcnt, const XcdBarrier& xb) {
    asm volatile("s_waitcnt vmcnt(0)" ::: "memory");
    __syncthreads();
    if (threadIdx.x == 0) {
        const unsigned nloc = xb.st[0];
        const unsigned old = __hip_atomic_fetch_add(xcnt + xb.x, 1u, __ATOMIC_RELAXED, __HIP_MEMORY_SCOPE_AGENT);
        if (old + 1u == nloc) {
            __builtin_amdgcn_fence(__ATOMIC_RELEASE, "agent");
            asm volatile("s_waitcnt vmcnt(0)" ::: "memory");
            __hip_atomic_fetch_add(gcnt, nloc, __ATOMIC_RELAXED, __HIP_MEMORY_SCOPE_AGENT);
        }
    }
}
__device__ __forceinline__ void wg_wait(unsigned* cnt, unsigned need) {
    if (threadIdx.x == 0) {
        unsigned sp = 0;
        while (__hip_atomic_load(cnt, __ATOMIC_RELAXED, __HIP_MEMORY_SCOPE_AGENT) < need) { __builtin_amdgcn_s_sleep(2); if (++sp > (1u << 22)) break; }
        __builtin_amdgcn_fence(__ATOMIC_ACQUIRE, "agent");
        asm volatile("s_waitcnt vmcnt(0)" ::: "memory");
    }
    __syncthreads();
}

__device__ __forceinline__ void run_phase(const Params& p, unsigned char* shm, int ph, int dbg, const XcdBarrier& xb) {
    const float* MOD = (const float*)(p.ws + WS_MOD);
    const float* NG = p.in[8];
    bf16_t* ABUF = (bf16_t*)(p.ws + WS_ABUF);
    unsigned char* BIG = p.ws + WS_BIG;
    const bool is_gemm = (ph == 2) | (ph == 5) | (ph == 7) | (ph == 8) | (ph == 10) | (ph == 14) | (ph == 16) | (ph == 17);
    if (is_gemm) {
        EpiGen E; const bf16_t* A = ABUF; const bf16_t* Bt; int N, K = 1024;
        E.bias = nullptr;
        if (ph == 2) { E.mode = 0; E.O = BIG + BIG_PROJ; E.ldc = EVN; E.ncols = EVN; Bt = (const bf16_t*)(p.ws + WS_WEVIN); N = EVNP; }
        else if (ph == 5) { E.mode = 5; E.O = BIG + BIG_Y; E.ldc = 1024; E.ncols = 1024; Bt = (const bf16_t*)(p.ws + WS_WEVOUT); N = 1024; }
        else if (ph == 14) { E.mode = 5; E.O = BIG + BIG_Y; E.ldc = 1024; E.ncols = 1024; Bt = (const bf16_t*)(p.ws + WS_WRGOUT); N = 1024; }
        else if (ph == 10) { E.mode = 3; E.O = BIG + BIG_RGP; E.ldc = 2048; E.ncols = 2048; Bt = (const bf16_t*)(p.ws + WS_WRGIN); N = 2048; }
        else if (ph == 7 || ph == 16) { const int l = (ph == 16); E.mode = 1; E.O = BIG + BIG_H; E.ldc = 4096; E.ncols = 4096; E.bias = p.in[10] + l * 4096; Bt = (const bf16_t*)(p.ws + WS_WMLP1) + (size_t)l * 4096 * 1024; N = 4096; }
        else { const int l = (ph == 17); E.mode = 2; E.O = ABUF; E.ldc = 1024; E.ncols = 1024; E.bias = p.in[12] + l * 1024; A = (const bf16_t*)(BIG + BIG_H); Bt = (const bf16_t*)(p.ws + WS_WMLP2) + (size_t)l * 1024 * 4096; N = 1024; K = 4096; }
        if ((E.mode == 2 || E.mode == 5) && gridDim.x == 256) {
            unsigned* xcA = (unsigned*)(p.ws + WS_CNT) + 128 * (ph == 5 ? 0 : ph == 8 ? 1 : ph == 14 ? 2 : 3);
            unsigned* cntA = xcA + 64;
            const int nb = (E.mode == 2) ? 128 : 64;
            const int hsplit = (E.mode == 2) ? 12288 : 14336;
            run_gemm(shm, A, Bt, 16384, 1024, K, K, 256, (int)blockIdx.x, E);
            xcd_arrive(xcA, cntA, xb);
            if ((int)blockIdx.x < nb) {
                if (E.mode == 2) {
                    const int sp = blockIdx.x & 1;
                    EpiGen E2 = E;
                    E2.O = sp ? (void*)(p.ws + WS_SCR) : (void*)((bf16_t*)E.O + (size_t)16384 * 1024);
                    E2.bias = sp ? nullptr : E.bias;
                    run_gemm(shm, A + (size_t)16384 * 4096 + sp * 2048, Bt + sp * 2048, 4096, 1024, 2048, 4096, 64, (int)(blockIdx.x >> 1), E2);
                } else {
                    EpiGen E2 = E; E2.O = (void*)((bf16_t*)E.O + (size_t)16384 * 1024);
                    run_gemm(shm, A + (size_t)16384 * 1024, Bt, 4096, 1024, 1024, 1024, 64, (int)blockIdx.x, E2);
                }
            } else {
                wg_wait(cntA, 256u);
                const int w0 = nb * 8, nwv = (256 - nb) * 8;
                if (ph == 5) phase_row<2, true, true, true>(p, BIG + BIG_Y, NG + 1 * 1024, MOD + 2048, NG + 2 * 1024, MOD, 3072, 4096, false, 0, hsplit, w0, nwv);
                else if (ph == 8) phase_row<2, true>(p, ABUF, NG + 3 * 1024, MOD + 5120, NG + 4 * 1024, MOD + 5 * 6144, 0, 1024, true, 0, hsplit, w0, nwv);
                else if (ph == 14) phase_row<2, true>(p, BIG + BIG_Y, NG + 5 * 1024, MOD + 5 * 6144 + 2048, NG + 6 * 1024, MOD + 5 * 6144, 3072, 4096, false, 0, hsplit, w0, nwv);
                else phase_row<2, false>(p, ABUF, NG + 7 * 1024, MOD + 5 * 6144 + 5120, nullptr, nullptr, 0, 0, true, 0, hsplit, w0, nwv);
            }
            xcd_barrier(xb);
            if (ph == 5) phase_row<2, true, true, true>(p, BIG + BIG_Y, NG + 1 * 1024, MOD + 2048, NG + 2 * 1024, MOD, 3072, 4096, false, hsplit, T_TOK, 0, 0);
            else if (ph == 8) phase_row<2, true>(p, ABUF, NG + 3 * 1024, MOD + 5120, NG + 4 * 1024, MOD + 5 * 6144, 0, 1024, true, hsplit, T_TOK, 0, 0);
            else if (ph == 14) phase_row<2, true>(p, BIG + BIG_Y, NG + 5 * 1024, MOD + 5 * 6144 + 2048, NG + 6 * 1024, MOD + 5 * 6144, 3072, 4096, false, hsplit, T_TOK, 0, 0);
            else phase_row<2, false>(p, ABUF, NG + 7 * 1024, MOD + 5 * 6144 + 5120, nullptr, nullptr, 0, 0, true, hsplit, T_TOK, 0, 0);
            return;
        }
        run_gemm(shm, A, Bt, T_TOK, N, K, K, (int)gridDim.x, (int)blockIdx.x, E);
        if (gridDim.x == 256) {
            if (ph == 2 && blockIdx.x >= 112) for (int d = (int)blockIdx.x - 112; d < 704; d += 144) convert_weight_tile(p, (float*)shm, deferred1_tile(d));
            if (ph == 10 && blockIdx.x >= 128) for (int d = (int)blockIdx.x - 128; d < 512; d += 128) convert_weight_tile(p, (float*)shm, deferred2_tile(d));
        }
        return;
    }
    switch (ph) {
    case 0: phase_prep(p, shm); break;
    case 1: phase_row<0, true, false, false>(p, nullptr, nullptr, nullptr, NG + 0 * 1024, MOD, 0, 1024, false); break;
    case 3: phase_mix_even(p, shm); break;
#ifdef EXTRA_PH
    case 60: if (blockIdx.x < 128) gla_item(p, shm, blockIdx.x); break;
    case 61: if (blockIdx.x >= 128) for (int it = blockIdx.x; it < 1280; it += 128) { if (it < 640) gla_item(p, shm, it); else sgu_item(p, shm, it - 640); } break;
    case 62: if (blockIdx.x >= 128) for (int it = blockIdx.x; it < 640; it += 128) gla_item(p, shm, it); break;
#endif
    case 4: phase_gla_combine(p); break;
    case 6: phase_row<2, true, true, true>(p, BIG + BIG_Y, NG + 1 * 1024, MOD + 2048, NG + 2 * 1024, MOD, 3072, 4096, false); break;
    case 9: phase_row<2, true>(p, ABUF, NG + 3 * 1024, MOD + 5120, NG + 4 * 1024, MOD + 5 * 6144, 0, 1024, true); break;
    case 11: phase_rg<0>(p, shm); break;
    case 12: phase_rg_carry(p); break;
    case 13: phase_rg<1>(p, shm); break;
    case 15: phase_row<2, true>(p, BIG + BIG_Y, NG + 5 * 1024, MOD + 5 * 6144 + 2048, NG + 6 * 1024, MOD + 5 * 6144, 3072, 4096, false); break;
    case 18: phase_row<2, false>(p, ABUF, NG + 7 * 1024, MOD + 5 * 6144 + 5120, nullptr, nullptr, 0, 0, true); break;
#ifdef DBG_PROBE
    case 97: {
        const int k = dbg;
        unsigned* flag = (unsigned*)(p.ws + WS_END);
        bool bad = false;
        const size_t g0 = (size_t)blockIdx.x * 512 + otid(), gs = (size_t)gridDim.x * 512;
        for (size_t i = g0; i < (size_t)T_TOK * 1024; i += gs) { if (!(fabsf(p.out[i]) < 1e30f)) bad = true; }
        if (k >= 1) for (size_t i = g0; i < (size_t)T_TOK * 1024; i += gs) { if ((((const unsigned short*)(p.ws + WS_ABUF))[i] & 0x7f80u) == 0x7f80u) bad = true; }
        const unsigned char* b = nullptr; size_t n = 0; bool f32 = false;
        if (k == 0) { b = p.ws + WS_MOD; n = 61440; f32 = true; }
        else if (k == 2) { b = BIG + BIG_PROJ; n = (size_t)T_TOK * EVN; }
        else if (k == 3) { b = BIG + BIG_OF; n = (size_t)T_TOK * 1024; }
        else if (k == 5 || k == 14) { b = BIG + BIG_Y; n = (size_t)T_TOK * 1024; f32 = true; }
        else if (k == 7 || k == 16) { b = BIG + BIG_H; n = (size_t)T_TOK * 4096; }
        else if (k == 10) { b = BIG + BIG_RGP; n = (size_t)T_TOK * 2048; }
        else if (k == 11) { b = BIG + BIG_RGSUM; n = (size_t)320 * 4096; f32 = true; }
        else if (k == 12) { b = BIG + BIG_RGCAR; n = (size_t)320 * 2048; f32 = true; }
        for (size_t i = g0; i < n; i += gs) { if (f32) { if (!(fabsf(((const float*)b)[i]) < 1e30f)) bad = true; } else { if ((((const unsigned short*)b)[i] & 0x7f80u) == 0x7f80u) bad = true; } }
        if (bad) atomicMin(flag, (unsigned)k);
    } break;
    case 95: {
        unsigned* flag = (unsigned*)(p.ws + WS_END);
        unsigned code = 0;
        const size_t g0 = (size_t)blockIdx.x * 512 + otid(), gs = (size_t)gridDim.x * 512;
        const unsigned short* ab = (const unsigned short*)(p.ws + WS_ABUF);
        const unsigned short* of = (const unsigned short*)(BIG + BIG_OF);
        const unsigned short* ob = (const unsigned short*)(BIG + BIG_OB);
        for (size_t i = g0; i < (size_t)T_TOK * 512; i += gs) {
            const size_t t = i >> 9, c = i & 511;
            unsigned cc = 0;
            if ((ab[t * 1024 + c] & 0x7f80u) == 0x7f80u) cc |= 1u;
            if ((of[i] & 0x7f80u) == 0x7f80u) cc |= 2u;
            if ((ob[i] & 0x7f80u) == 0x7f80u) cc |= 4u;
            if (cc) cc |= (t < T_PROMPT) ? 8u : 16u;
            code |= cc;
        }
        if (dbg >= 100) { if (code & 6u) atomicOr(flag + 1, 1u << (dbg - 100)); } else if (code) atomicOr(flag + 1, code);
    } break;
    case 94: {
        const unsigned f = ((const unsigned*)(p.ws + WS_END))[1];
        const float v = 1000.0f * (float)(f + 1);
        for (size_t i = (size_t)blockIdx.x * 512 + otid(); i < (size_t)22052864; i += (size_t)gridDim.x * 512) p.out[i] = v;
    } break;
    case 93: break;
    case 96: {
        const unsigned f = *(const unsigned*)(p.ws + WS_END);
        const float v = (f > 100u) ? 50000.0f : 1000.0f * (float)(f + 1);
        for (size_t i = (size_t)blockIdx.x * 512 + otid(); i < (size_t)22052864; i += (size_t)gridDim.x * 512) p.out[i] = v;
    } break;
    case 98: {
        for (size_t i = (size_t)blockIdx.x * 512 + otid(); i < (size_t)22052864; i += (size_t)gridDim.x * 512) {
            const float v = p.out[i];
            if (!(fabsf(v) < 1e30f)) p.out[i] = 12345.0f;
        }
    } break;
    case 99: {
        const unsigned short* a = (const unsigned short*)p.ws;
        const size_t NOUT = 22052864, NW = WS_END / 2;
        for (size_t i = (size_t)blockIdx.x * 512 + otid(); i < NOUT; i += (size_t)gridDim.x * 512) {
            unsigned s = (i < (size_t)T_TOK * 1024) ? ((__float_as_uint(p.out[i]) >> 8) & 0xffffu) : 0u;
            for (int j = 0; j < 6; ++j) { const size_t idx = i + (size_t)j * NOUT; if (idx < NW) s += a[idx]; }
            p.out[i] = (float)s;
        }
    } break;
#endif
    default: break;
    }
}

__global__ void __launch_bounds__(512, 2) fwd_megakernel(Params p) {
    extern __shared__ __attribute__((aligned(16))) unsigned char shm[];
    cg::grid_group grid = cg::this_grid();
    volatile LAS unsigned* st = (volatile LAS unsigned*)(shm + LDS_BYTES - 16);
    if (threadIdx.x < 4) st[threadIdx.x] = 0u;
    __syncthreads();
    if (blockIdx.x == 0) { unsigned* bw = (unsigned*)(p.ws + WS_BAR); for (int i = threadIdx.x; i < 4096; i += 512) bw[i] = 0u; }
    XcdBarrier xb; xb.bar = (unsigned*)(p.ws + WS_BAR); xb.x = xb_xcc_id(); xb.st = st;
    for (int i = 0; i < p.nseq; ++i) {
        if (i == 1) { grid.sync(); if (threadIdx.x == 0) (void)xb_add(&xb.bar[XB_XCNT(xb.x)], 1u); }
        else if (i > 1) xcd_barrier(xb);
        run_phase(p, shm, (int)p.seq[i], (int)p.dbgv[i], xb);
    }
}

extern "C" void kernel_launch(void* const* d_in, const int* in_sizes, int n_in, void* d_out, int out_size, void* d_ws, size_t ws_size, hipStream_t stream) {
    static int grid_blocks = 0;
    if (!grid_blocks) {
        int dev = 0, cus = 0, per_cu = 0;
        hipGetDevice(&dev);
        hipDeviceGetAttribute(&cus, hipDeviceAttributeMultiprocessorCount, dev);
        hipFuncSetAttribute((const void*)fwd_megakernel, hipFuncAttributeMaxDynamicSharedMemorySize, LDS_BYTES);
        hipOccupancyMaxActiveBlocksPerMultiprocessor(&per_cu, (const void*)fwd_megakernel, 512, LDS_BYTES);
        if (per_cu < 1) { fprintf(stderr, "kernel_launch: occupancy query reports %d blocks per CU\n", per_cu); per_cu = 1; }
        if (per_cu > 1) per_cu = 1;
        grid_blocks = cus * per_cu;
        if (ws_size < WS_END) fprintf(stderr, "kernel_launch: workspace too small: %zu < %zu\n", ws_size, (size_t)WS_END);
    }
    Params p{};
    for (int i = 0; i < 31; ++i) p.in[i] = (const float*)d_in[i];
    p.out = (float*)d_out; p.ws = (unsigned char*)d_ws;
    int n = 0;
#if defined(DBG_PROBE) && DBG_PROBE == 1
    hipMemsetAsync((char*)d_ws + WS_END, 0xff, 16, stream);
    for (int ph = 0; ph < NPHASE; ++ph) { p.seq[n] = (unsigned char)ph; p.dbgv[n++] = 0; p.seq[n] = 97; p.dbgv[n++] = (unsigned char)ph; }
    p.seq[n] = 96; p.dbgv[n++] = 0;
#elif defined(DBG_PROBE) && DBG_PROBE == 3
    hipMemsetAsync((char*)d_ws + WS_END, 0xff, 16, stream);
    for (int ph = 0; ph < 4; ++ph) { p.seq[n] = (unsigned char)ph; p.dbgv[n++] = 0; }
    p.seq[n] = 97; p.dbgv[n++] = 3; p.seq[n] = 96; p.dbgv[n++] = 0;
#elif defined(DBG_PROBE) && DBG_PROBE == 2
    hipMemsetAsync((char*)d_ws + WS_END, 0, 16, stream);
    for (int ph = 0; ph < 4; ++ph) { p.seq[n] = (unsigned char)ph; p.dbgv[n++] = 0; }
    p.seq[n] = DBG_P4; p.dbgv[n++] = 0; p.seq[n] = 94; p.dbgv[n++] = 0;
#else
    for (int ph = 0; ph < NPHASE; ++ph) {
        if (grid_blocks == 256 && (ph == 6 || ph == 9 || ph == 15 || ph == 18)) continue;
        p.seq[n] = (unsigned char)ph; p.dbgv[n++] = 0;
#ifdef EXTRA_PH
        if (ph == 3) { p.seq[n] = EXTRA_PH; p.dbgv[n++] = 0; }
#endif
#ifdef EXTRA_SYNCS
        if (ph == 5) for (int q = 0; q < EXTRA_SYNCS; ++q) { p.seq[n] = 50; p.dbgv[n++] = 0; }
#endif
#ifdef DUP_MASK
        if ((DUP_MASK >> ph) & 1) { p.seq[n] = (unsigned char)ph; p.dbgv[n++] = 0; }
#endif
    }
#endif
    p.nseq = n;
    void* args[] = {&p};
    hipError_t e = hipLaunchCooperativeKernel((const void*)fwd_megakernel, dim3(grid_blocks), dim3(512), args, LDS_BYTES, stream);
    if (e != hipSuccess) fprintf(stderr, "cooperative launch failed: %s (grid %d)\n", hipGetErrorString(e), grid_blocks);
}
```

```cpp
#include <hip/hip_runtime.h>
#include <hip/hip_cooperative_groups.h>
#include <cstdio>
namespace pg8 {
#define PG8_LAS __attribute__((address_space(3)))
typedef unsigned short bf16_t;
typedef short bf16x8 __attribute__((ext_vector_type(8)));
typedef float f32x4 __attribute__((ext_vector_type(4)));
typedef unsigned u32x4 __attribute__((ext_vector_type(4)));
constexpr int BM = 256, BK = 64, HALF = 128, HTB = HALF * BK * 2  , STAGE_BYTES = 8 * HTB, NXCD = 8, WGM = 8;

__host__ __device__ __forceinline__ int lds_byte(int r, int c) { const int st = (r >> 4) * 2 + (c >> 5), rr = r & 15, cc = c & 31, ob = rr * 64 + cc * 2; return st * 1024 + (ob ^ (((ob >> 9) & 1) << 5)); }
__host__ __device__ __forceinline__ void stage_rc(int b, int& R, int& C) { const int st = b / 1024, sb = b % 1024, swz = sb ^ (((sb >> 9) & 1) << 5); R = (st >> 1) * 16 + swz / 64; C = (st & 1) * 32 + (swz % 64) / 2; }
__host__ __device__ __forceinline__ int perm32(int rho) { const int n = rho >> 4, i = rho & 15; return 8 * (i >> 2) + 4 * n + (i & 3); }

struct Unit { int pm, pn; };
struct Gemm { const bf16_t* A; const bf16_t* Bt; int M, N, K, ld; };

struct StaticOrder {
    int nM, nN, nwg, G, c;
    __host__ __device__ void init(int M, int N, int G_, int c_) { nM = M / BM; nN = N / BM; nwg = nM * nN; G = G_; c = c_; }
    __host__ __device__ bool next(int i, Unit& u) const {
        const long L = (long)i * G + c; if (L >= nwg) return false;
        int wgid = (int)L; { const int q = nwg / NXCD, r = nwg % NXCD, xcd = wgid % NXCD, off = wgid / NXCD; wgid = (xcd < r ? xcd * (q + 1) : r * (q + 1) + (xcd - r) * q) + off; }
        const int nig = WGM * nN, gid = wgid / nig, fm = gid * WGM, gsz = (nM - fm) < WGM ? (nM - fm) : WGM;
        u.pm = fm + ((wgid % nig) % gsz); u.pn = (wgid % nig) / gsz; return true;
    }
    __device__ __forceinline__ void a_ready(const Unit&) const {}
    __device__ __forceinline__ void done(const Unit&) const {}
};
typedef __bf16 bf16x2_n __attribute__((ext_vector_type(2)));
typedef float f32x2_n __attribute__((ext_vector_type(2)));
__device__ __forceinline__ unsigned cvt_pk_bf16(float lo, float hi) { f32x2_n v = {lo, hi}; bf16x2_n b = __builtin_convertvector(v, bf16x2_n); return __builtin_bit_cast(unsigned, b); }
typedef float f32x2 __attribute__((ext_vector_type(2)));
template <class Epi, class Sched, bool STAMP = false>
__device__ __forceinline__ void gemm_phase(PG8_LAS unsigned char* lds, const Gemm g, const Sched& S, const Epi& E, unsigned long long* stamps) {
    int tid_o = threadIdx.x; asm volatile("" : "+v"(tid_o)); const int tid = tid_o, wid = __builtin_amdgcn_readfirstlane(tid >> 6), lane = tid & 63, wr = wid >> 2, wc = wid & 3, fr = lane & 15, fq = lane >> 4;
    const int K = g.ld, nt = g.K / BK;
    int ts_lo = 0, ts_hi = 0, nts = 0; const unsigned long long rt_entry = STAMP ? (unsigned long long)wall_clock64() : 0ull;
#define PG8_STAMP() do { if (STAMP && wid == 0 && nts < 64) { const unsigned long long _c = (unsigned long long)clock64(); \
        ts_lo = (lane == nts) ? (int)(unsigned)_c : ts_lo; ts_hi = (lane == nts) ? (int)(unsigned)(_c >> 32) : ts_hi; ++nts; } } while (0)
    PG8_STAMP();
    unsigned voffA[2], voffB[2];
#pragma unroll
    for (int i = 0; i < 2; ++i) { int R, C; stage_rc(tid * 16 + i * 8192, R, C); const int Rb = Epi::PERM ? ((R & ~31) + perm32(R & 31)) : R;
        voffA[i] = (unsigned)(R * K + C) * 2u; voffB[i] = (unsigned)(Rb * K + C) * 2u; }
    const size_t kstep = (size_t)(BK * 2);
    const size_t hstep = (size_t)HALF * K * 2;
    const size_t tstep = 2 * hstep;
    const unsigned ldsw = (unsigned)wid * 1024u;
    const int aoff = lds_byte(wr * 64 + fr, fq * 8), boff = lds_byte(wc * 32 + fr, fq * 8);
#define PG8_SA(b, h) (((b) * 2 + (h)) * HTB)
#define PG8_SB(b, h) ((4 + (b) * 2 + (h)) * HTB)
#define PG8_STAGE(bufoff, gbase, voff) do { _Pragma("unroll") for (int _i = 0; _i < 2; ++_i) \
        __builtin_amdgcn_global_load_lds((const unsigned*)((const char*)(gbase) + (voff)[_i]), (PG8_LAS unsigned*)(lds + (bufoff) + ldsw + _i * 8192), 16, 0, 0); } while (0)
#define PG8_LDA(dst, b, h) do { _Pragma("unroll") for (int m = 0; m < 4; ++m) _Pragma("unroll") for (int k = 0; k < 2; ++k) dst[m][k] = *(const PG8_LAS bf16x8*)(lds + PG8_SA(b, h) + aoff + m * 2048 + k * 1024); } while (0)
#define PG8_LDB(dst, b, h) do { _Pragma("unroll") for (int n = 0; n < 2; ++n) _Pragma("unroll") for (int k = 0; k < 2; ++k) dst[n][k] = *(const PG8_LAS bf16x8*)(lds + PG8_SB(b, h) + boff + n * 2048 + k * 1024); } while (0)
#define PG8_MMA(ai, bj, At, Bt) do { __builtin_amdgcn_s_setprio(1); _Pragma("unroll") for (int m = 0; m < 4; ++m) _Pragma("unroll") for (int n = 0; n < 2; ++n) _Pragma("unroll") for (int k = 0; k < 2; ++k) \
        acc[ai][bj][m][n] = __builtin_amdgcn_mfma_f32_16x16x32_bf16(Bt[n][k], At[m][k], acc[ai][bj][m][n], 0, 0, 0); __builtin_amdgcn_s_setprio(0); } while (0)
#define PG8_WAIT_V(n) asm volatile("s_waitcnt vmcnt(" #n ")" ::: "memory")
#define PG8_WAIT_L(n) asm volatile("s_waitcnt lgkmcnt(" #n ")" ::: "memory")
#define PG8_BAR __builtin_amdgcn_s_barrier()
#define PG8_SCHED __builtin_amdgcn_sched_barrier(0)
    Unit cur, nxt; int ui = 0;
    if (!S.next(0, cur)) return;
    f32x4 acc[2][2][4][2];
#pragma unroll
    for (int a = 0; a < 2; ++a)
#pragma unroll
        for (int b = 0; b < 2; ++b)
#pragma unroll
            for (int m = 0; m < 4; ++m)
#pragma unroll
                for (int n = 0; n < 2; ++n) acc[a][b][m][n] = (f32x4){0.f, 0.f, 0.f, 0.f};
    bf16x8 At[4][2], B0[2][2], B1[2][2];
    const char* cA = (const char*)g.A + (size_t)cur.pm * tstep; const char* cB = (const char*)g.Bt + (size_t)cur.pn * tstep;
    S.a_ready(cur);
    PG8_STAGE(PG8_SB(0, 0), cB, voffB); PG8_STAGE(PG8_SA(0, 0), cA, voffA); PG8_STAGE(PG8_SB(0, 1), cB + hstep, voffB); PG8_STAGE(PG8_SA(0, 1), cA + hstep, voffA);
    if (wr == 1) PG8_BAR;
    PG8_WAIT_V(4); PG8_BAR;
    PG8_STAGE(PG8_SB(1, 0), cB + kstep, voffB); PG8_STAGE(PG8_SA(1, 0), cA + kstep, voffA); PG8_STAGE(PG8_SB(1, 1), cB + hstep + kstep, voffB);
    PG8_WAIT_V(6); PG8_BAR;
    PG8_STAMP();
    for (;;) {
        const bool has_next = S.next(ui + 1, nxt);
        const char* nA = has_next ? (const char*)g.A + (size_t)nxt.pm * tstep : cA; const char* nB = has_next ? (const char*)g.Bt + (size_t)nxt.pn * tstep : cB;
        for (int t = 0; t < nt; t += 2) {
            const bool last = (t == nt - 2);
            const char* a1 = cA + (size_t)(t + 1) * kstep;
            const char* a2 = last ? nA : cA + (size_t)(t + 2) * kstep; const char* b2 = last ? nB : cB + (size_t)(t + 2) * kstep;
            const char* a3 = a2 + kstep; const char* b3 = b2 + kstep;
            if (last && has_next) S.a_ready(nxt);
            PG8_LDB(B0, 0, 0); PG8_SCHED; PG8_LDA(At, 0, 0); PG8_STAGE(PG8_SA(1, 1), a1 + hstep, voffA);
            PG8_WAIT_L(8); PG8_BAR; PG8_WAIT_L(0); PG8_MMA(0, 0, At, B0); PG8_BAR; PG8_SCHED;
            PG8_LDB(B1, 0, 1); PG8_STAGE(PG8_SB(0, 0), b2, voffB);
            PG8_BAR; PG8_WAIT_L(0); PG8_MMA(0, 1, At, B1); PG8_BAR;
            PG8_LDA(At, 0, 1); PG8_STAGE(PG8_SA(0, 0), a2, voffA);
            PG8_BAR; PG8_WAIT_L(0); PG8_MMA(1, 0, At, B0); PG8_BAR; PG8_SCHED;
            PG8_STAGE(PG8_SB(0, 1), b2 + hstep, voffB);
            PG8_WAIT_V(6); PG8_BAR; PG8_MMA(1, 1, At, B1); PG8_BAR;
            PG8_LDB(B0, 1, 0); PG8_SCHED; PG8_LDA(At, 1, 0); PG8_STAGE(PG8_SA(0, 1), a2 + hstep, voffA);
            PG8_WAIT_L(8); PG8_BAR; PG8_WAIT_L(0); PG8_MMA(0, 0, At, B0); PG8_BAR; PG8_SCHED;
            PG8_LDB(B1, 1, 1); PG8_STAGE(PG8_SB(1, 0), b3, voffB);
            PG8_BAR; PG8_WAIT_L(0); PG8_MMA(0, 1, At, B1); PG8_BAR;
            PG8_LDA(At, 1, 1); PG8_STAGE(PG8_SA(1, 0), a3, voffA);
            PG8_BAR; PG8_WAIT_L(0); PG8_MMA(1, 0, At, B0); PG8_BAR; PG8_SCHED;
            PG8_STAGE(PG8_SB(1, 1), b3 + hstep, voffB);
            PG8_WAIT_V(6); PG8_BAR; PG8_MMA(1, 1, At, B1); PG8_BAR;
        }
        PG8_STAMP();
        if constexpr (!Epi::AFTER_DRAIN) { E(acc, cur, wr, wc, fr, fq); S.done(cur); }
        PG8_STAMP();
        if (!has_next) break;
#pragma unroll
        for (int a = 0; a < 2; ++a)
#pragma unroll
            for (int b = 0; b < 2; ++b)
#pragma unroll
                for (int m = 0; m < 4; ++m)
#pragma unroll
                    for (int n = 0; n < 2; ++n) acc[a][b][m][n] = (f32x4){0.f, 0.f, 0.f, 0.f};
        cur = nxt; cA = nA; cB = nB; ++ui;
    }
    PG8_WAIT_V(0);
    if (wr == 0) PG8_BAR;
    PG8_BAR;
    if constexpr (Epi::AFTER_DRAIN) { E.fused(acc, cur, wr, wc, fr, fq, lds, wid, lane); S.done(cur); }
    PG8_STAMP();
    if (STAMP && wid == 0) { stamps[lane] = lane < nts ? (((unsigned long long)(unsigned)ts_hi << 32) | (unsigned)ts_lo) : 0ull;
        if (lane == 62) stamps[62] = rt_entry; if (lane == 63) stamps[63] = (unsigned long long)wall_clock64(); }
#undef PG8_STAMP
#undef PG8_SA
#undef PG8_SB
#undef PG8_STAGE
#undef PG8_LDA
#undef PG8_LDB
#undef PG8_MMA
#undef PG8_WAIT_V
#undef PG8_WAIT_L
#undef PG8_BAR
#undef PG8_SCHED
}
}

namespace cg = cooperative_groups;
using pg8::bf16_t; using pg8::bf16x8; using pg8::f32x4; using pg8::u32x4; using pg8::cvt_pk_bf16;

#ifndef MK_LAUNCHES
#define MK_LAUNCHES 1
#endif

constexpr int T_TOK = 20480, T_PROMPT = 4096, DM = 1024, DFF = 4096, EVN = 2592, EVNP = 2816;
constexpr int LDS_BYTES = 147456;
constexpr int NPHASE = 19;
constexpr float EPSN = 1e-6f;

constexpr size_t WS_MOD    = 0;
constexpr size_t WS_WEVIN  = 262144;
constexpr size_t WS_WEVOUT = WS_WEVIN  + (size_t)EVNP * 1024 * 2;
constexpr size_t WS_WMLP1  = WS_WEVOUT + (size_t)1024 * 1024 * 2;
constexpr size_t WS_WMLP2  = WS_WMLP1  + (size_t)2 * 4096 * 1024 * 2;
constexpr size_t WS_WRGIN  = WS_WMLP2  + (size_t)2 * 4096 * 1024 * 2;
constexpr size_t WS_WRGOUT = WS_WRGIN  + (size_t)2048 * 1024 * 2;
constexpr size_t WS_WRGG   = WS_WRGOUT + (size_t)1024 * 1024 * 2;
constexpr size_t WS_WSGU   = WS_WRGG   + (size_t)16 * 256 * 64 * 2;
constexpr size_t WS_ABUF   = WS_WSGU   + (size_t)4 * 128 * 128 * 2;
constexpr size_t WS_BIG    = WS_ABUF   + (size_t)T_TOK * 1024 * 2;
constexpr size_t BIG_BYTES = (size_t)T_TOK * 4096 * 2;
constexpr size_t WS_END    = WS_BIG + BIG_BYTES;
static_assert(WS_END <= 268435456ull, "workspace map exceeds 256 MiB");
constexpr size_t BIG_PROJ  = 0;
constexpr size_t BIG_OF    = (size_t)T_TOK * EVN * 2;
constexpr size_t BIG_OB    = BIG_OF + (size_t)T_TOK * 512 * 2;
static_assert(BIG_OB + (size_t)T_TOK * 512 * 2 <= BIG_BYTES, "");
constexpr size_t BIG_Y     = 0;
constexpr size_t BIG_H     = 0;
constexpr size_t BIG_RGP   = 0;
constexpr size_t BIG_RGSUM = (size_t)T_TOK * 2048 * 2;
constexpr size_t WS_BAR = WS_END + 256;
static_assert(WS_BAR + 3456 * 4 <= 268435456ull, "");
constexpr size_t WS_SCR = WS_BAR + 16384;
static_assert(WS_SCR + (size_t)4096 * 1024 * 2 <= 268435456ull, "");
constexpr size_t BIG_RGCAR = BIG_RGSUM + (size_t)320 * 2 * 2 * 1024 * 4;

struct Params {
    const float* in[31];
    float* out;
    unsigned char* ws;
    int nseq, pad;
    unsigned char seq[64];
    unsigned char dbgv[64];
};

__device__ __forceinline__ float bf2f(unsigned short b) { return __uint_as_float(((unsigned)b) << 16); }
__device__ __forceinline__ float bflo(unsigned w) { return __uint_as_float(w << 16); }
__device__ __forceinline__ float bfhi(unsigned w) { return __uint_as_float(w & 0xffff0000u); }
__device__ __forceinline__ unsigned short f2bf(float f) { return (unsigned short)(cvt_pk_bf16(f, 0.f) & 0xffffu); }
__device__ __forceinline__ float wave_sum(float v) {
#pragma unroll
    for (int o = 32; o > 0; o >>= 1) v += __shfl_xor(v, o, 64);
    return v;
}
__device__ __forceinline__ float gelu_tanh(float x) {
    const float u = -2.302208198f * (x + 0.044715f * x * x * x);
    return x * __builtin_amdgcn_rcpf(1.0f + __builtin_amdgcn_exp2f(u));
}
__device__ __forceinline__ float sigmoidf_(float x) { return __builtin_amdgcn_rcpf(1.0f + __expf(-x)); }
__device__ __forceinline__ bf16x8 ldfrag(const unsigned short* base, int pitch, int r0, int k0, int lane) {
    return *(const bf16x8*)(base + (r0 + (lane & 15)) * pitch + k0 + (lane >> 4) * 8);
}
__device__ __forceinline__ int otid() { int t = threadIdx.x; asm volatile("" : "+v"(t)); return t; }
__device__ __forceinline__ void lds_barrier() { asm volatile("s_waitcnt lgkmcnt(0)" ::: "memory"); __builtin_amdgcn_s_barrier(); asm volatile("" ::: "memory"); }
#define MFMA16(a, b, c) __builtin_amdgcn_mfma_f32_16x16x32_bf16((a), (b), (c), 0, 0, 0)

struct EpiGen {
    static constexpr bool PERM = true, AFTER_DRAIN = false;
    void* O; int ldc; const float* bias; int ncols; int mode;
    __device__ __forceinline__ void operator()(const f32x4 (&acc)[2][2][4][2], const pg8::Unit& u, int wr, int wc, int fr, int fq) const {
        const int row0 = u.pm * 256 + wr * 64 + fr, col0 = u.pn * 256 + wc * 32 + 8 * fq;
        const bool act = (mode == 0) ? (u.pn < 4) : ((mode == 3) ? (u.pn >= 4) : false);
        if (mode == 4) {
#pragma unroll
            for (int ai = 0; ai < 2; ++ai)
#pragma unroll
                for (int m = 0; m < 4; ++m) { float* rowp = (float*)O + (size_t)(row0 + ai * 128 + m * 16) * ldc + col0;
#pragma unroll
                    for (int bj = 0; bj < 2; ++bj) { *(f32x4*)(rowp + bj * 128) = acc[ai][bj][m][0]; *(f32x4*)(rowp + bj * 128 + 4) = acc[ai][bj][m][1]; } }
            return;
        }
#pragma unroll
        for (int bj = 0; bj < 2; ++bj) {
            const int col = col0 + bj * 128;
            if (col >= ncols) continue;
            f32x4 b0 = (f32x4){0.f, 0.f, 0.f, 0.f}, b1 = b0;
            if (bias) { b0 = *(const f32x4*)(bias + col); b1 = *(const f32x4*)(bias + col + 4); }
#pragma unroll
            for (int ai = 0; ai < 2; ++ai)
#pragma unroll
                for (int m = 0; m < 4; ++m) {
                    f32x4 v0 = acc[ai][bj][m][0] + b0, v1 = acc[ai][bj][m][1] + b1;
                    if (mode == 1) {
#pragma unroll
                        for (int j = 0; j < 4; ++j) { float a = fmaxf(v0[j], 0.f), b = fmaxf(v1[j], 0.f); v0[j] = a * a; v1[j] = b * b; }
                    }
                    if (act) {
#pragma unroll
                        for (int j = 0; j < 4; ++j) { v0[j] = gelu_tanh(v0[j]); v1[j] = gelu_tanh(v1[j]); }
                    }
                    u32x4 w; w.x = cvt_pk_bf16(v0[0], v0[1]); w.y = cvt_pk_bf16(v0[2], v0[3]); w.z = cvt_pk_bf16(v1[0], v1[1]); w.w = cvt_pk_bf16(v1[2], v1[3]);
                    *(u32x4*)((bf16_t*)O + (size_t)(row0 + ai * 128 + m * 16) * ldc + col) = w;
                }
        }
    }
};

template <class Epi>
__device__ __forceinline__ void run_gemm(unsigned char* shm, const bf16_t* A, const bf16_t* Bt, int M, int N, int K, int ld, int G, int c, const Epi& E) {
    pg8::Gemm g; g.A = A; g.Bt = Bt; g.M = M; g.N = N; g.K = K; g.ld = ld;
    pg8::StaticOrder S; S.init(M, N, G, c);
    pg8::gemm_phase<Epi, pg8::StaticOrder, false>((PG8_LAS unsigned char*)shm, g, S, E, nullptr);
}

__device__ __forceinline__ void transpose_tile(const float* src, int ldsrc, int k0, int n0, int nvalid, int nstore, bf16_t* dst, int lddst, float* tile) {
    const int tid = otid();
    {
        const int kk = tid >> 6, n4 = (tid & 63) * 4;
        float4 v[8];
#pragma unroll
        for (int i = 0; i < 8; ++i) {
            v[i] = make_float4(0.f, 0.f, 0.f, 0.f);
            if (n0 + n4 < nvalid) v[i] = *(const float4*)(src + (size_t)(k0 + kk + 8 * i) * ldsrc + n0 + n4);
        }
#pragma unroll
        for (int i = 0; i < 8; ++i) { float* tp = tile + (kk + 8 * i) * 257 + n4; tp[0] = v[i].x; tp[1] = v[i].y; tp[2] = v[i].z; tp[3] = v[i].w; }
    }
    __syncthreads();
    {
        const int nn = tid >> 1, k32 = (tid & 1) * 32;
        if (n0 + nn < nstore) {
            bf16_t* dp = dst + (size_t)(n0 + nn) * lddst + k0 + k32;
#pragma unroll
            for (int q = 0; q < 4; ++q) {
                float f[8];
#pragma unroll
                for (int j = 0; j < 8; ++j) f[j] = tile[(k32 + q * 8 + j) * 257 + nn];
                u32x4 w; w.x = cvt_pk_bf16(f[0], f[1]); w.y = cvt_pk_bf16(f[2], f[3]); w.z = cvt_pk_bf16(f[4], f[5]); w.w = cvt_pk_bf16(f[6], f[7]);
                *(u32x4*)(dp + q * 8) = w;
            }
        }
    }
    __syncthreads();
}

__device__ __forceinline__ void convert_weight_tile(const Params& p, float* fl, int idx) {
    const float* src; bf16_t* dst; int ld, nv, ns, ldd, nkt;
    if (idx < 176) { src = p.in[13]; dst = (bf16_t*)(p.ws + WS_WEVIN); ld = EVN; nv = EVN; ns = EVNP; ldd = 1024; nkt = 16; }
    else if ((idx -= 176) < 64) { src = p.in[14]; dst = (bf16_t*)(p.ws + WS_WEVOUT); ld = 1024; nv = 1024; ns = 1024; ldd = 1024; nkt = 16; }
    else if ((idx -= 64) < 512) { const int l = idx >> 8; idx &= 255; src = p.in[9] + (size_t)l * 1024 * 4096; dst = (bf16_t*)(p.ws + WS_WMLP1) + (size_t)l * 4096 * 1024; ld = 4096; nv = 4096; ns = 4096; ldd = 1024; nkt = 16; }
    else if ((idx -= 512) < 512) { const int l = idx >> 8; idx &= 255; src = p.in[11] + (size_t)l * 4096 * 1024; dst = (bf16_t*)(p.ws + WS_WMLP2) + (size_t)l * 1024 * 4096; ld = 1024; nv = 1024; ns = 1024; ldd = 4096; nkt = 64; }
    else if ((idx -= 512) < 128) { src = p.in[22]; dst = (bf16_t*)(p.ws + WS_WRGIN); ld = 2048; nv = 2048; ns = 2048; ldd = 1024; nkt = 16; }
    else if ((idx -= 128) < 64) { src = p.in[30]; dst = (bf16_t*)(p.ws + WS_WRGOUT); ld = 1024; nv = 1024; ns = 1024; ldd = 1024; nkt = 16; }
    else { idx -= 64; const int d = idx >> 5, mat = (idx >> 4) & 1, h = idx & 15;
        src = (mat ? p.in[27] : p.in[25]) + (size_t)(d * 16 + h) * 4096; dst = (bf16_t*)(p.ws + WS_WRGG) + (size_t)h * 256 * 64 + (size_t)(d * 2 + mat) * 4096; ld = 64; nv = 64; ns = 64; ldd = 64; nkt = 1; idx = 0; }
    const int kt = idx % nkt, nt = idx / nkt;
    transpose_tile(src, ld, kt * 64, nt * 256, nv, ns, dst, ldd, fl);
}
__device__ __forceinline__ int deferred1_tile(int d) { return d < 256 ? 240 + d : d < 512 ? 752 + (d - 256) : d < 640 ? 1264 + (d - 512) : 1392 + (d - 640); }
__device__ __forceinline__ int deferred2_tile(int d) { return d < 256 ? 496 + d : 1008 + (d - 256); }
__device__ __forceinline__ void phase_prep(const Params& p, unsigned char* shm) {
    const int tid = otid();
    float* fl = (float*)shm;
    constexpr int N_GEMV = 192, N_SGU = 16;
    const bool early = (gridDim.x == 256);
    const int N_TR = early ? 304 : 1520;
    for (int item = blockIdx.x; item < N_GEMV + N_TR + N_SGU; item += gridDim.x) {
        if (item < N_GEMV) {
            const int l = item / 96, n0 = (item % 96) * 64;
            float* S = fl;
            float* R = fl + 5120;
            const int r = tid >> 4, c4 = (tid & 15) * 4;
            const float* W = p.in[6] + (size_t)l * 1024 * 6144 + n0 + c4;
            float4 w[8];
#pragma unroll
            for (int j = 0; j < 8; ++j) w[j] = *(const float4*)(W + (size_t)(r + 32 * j) * 6144);
            for (int e = tid; e < 5120; e += 512) {
                const int c = e >> 10, k = e & 1023;
                const float v = (c == 0) ? p.in[5][k] : p.in[2][(c - 1) * 1024 + k];
                S[e] = v * sigmoidf_(v);
            }
            __syncthreads();
            float acc[5][4];
#pragma unroll
            for (int c = 0; c < 5; ++c)
#pragma unroll
                for (int j = 0; j < 4; ++j) acc[c][j] = 0.f;
            for (int i0 = 0; i0 < 32; i0 += 8) {
                float4 wn[8];
                if (i0 + 8 < 32) {
#pragma unroll
                    for (int j = 0; j < 8; ++j) wn[j] = *(const float4*)(W + (size_t)(r + 32 * (i0 + 8 + j)) * 6144);
                }
#pragma unroll
                for (int j = 0; j < 8; ++j) {
                    const int k = r + 32 * (i0 + j);
#pragma unroll
                    for (int c = 0; c < 5; ++c) { const float sv = S[c * 1024 + k]; acc[c][0] += sv * w[j].x; acc[c][1] += sv * w[j].y; acc[c][2] += sv * w[j].z; acc[c][3] += sv * w[j].w; }
                }
                if (i0 + 8 < 32) {
#pragma unroll
                    for (int j = 0; j < 8; ++j) w[j] = wn[j];
                }
            }
#pragma unroll
            for (int c = 0; c < 5; ++c)
#pragma unroll
                for (int j = 0; j < 4; ++j) R[(r * 5 + c) * 64 + c4 + j] = acc[c][j];
            __syncthreads();
            if (tid < 320) {
                const int c = tid >> 6, n = tid & 63;
                float s = p.in[7][l * 6144 + n0 + n];
                for (int rr = 0; rr < 32; ++rr) s += R[(rr * 5 + c) * 64 + n];
                ((float*)(p.ws + WS_MOD))[(l * 5 + c) * 6144 + n0 + n] = s;
            }
            __syncthreads();
        } else if (item < N_GEMV + N_TR) {
            const int e = item - N_GEMV;
            convert_weight_tile(p, fl, early ? (e < 240 ? e : 1456 + (e - 240)) : e);
        } else {
            const int it = item - N_GEMV - N_TR;
            const int e = it * 4096 + tid * 8;
            const float4 a = *(const float4*)(p.in[17] + e), b = *(const float4*)(p.in[17] + e + 4);
            u32x4 w; w.x = cvt_pk_bf16(a.x, a.y); w.y = cvt_pk_bf16(a.z, a.w); w.z = cvt_pk_bf16(b.x, b.y); w.w = cvt_pk_bf16(b.z, b.w);
            *(u32x4*)((bf16_t*)(p.ws + WS_WSGU) + e) = w;
        }
    }
}

template <int SRC, bool NEXT, bool XIN = false, bool XST = true>
__device__ __forceinline__ void phase_row(const Params& p, const void* ysrc, const float* ng_res, const float* modg  ,
                          const float* ng_next, const float* modn  , int sh_off, int sc_off, bool part,
                          int row_lo = 0, int row_hi = T_TOK, int wave0 = 0, int nwaves = 0) {
    const int tid_ = otid(); const int lane = tid_ & 63, wid = tid_ >> 6;
    bf16_t* A = (bf16_t*)(p.ws + WS_ABUF);
    float om[4];
    if (SRC == 0 || XIN) {
#pragma unroll
        for (int e = 0; e < 4; ++e) om[e] = exp2f(-(float)(lane * 4 + e) * (13.287712379549449f / 256.0f));
    }
    const int nw = nwaves ? nwaves : (int)gridDim.x * 8, R = (row_hi - row_lo + nw - 1) / nw;
    const int gw = (int)blockIdx.x * 8 + wid - wave0;
    int r_lo = row_lo + gw * R, r_hi = (r_lo + R < row_hi) ? (r_lo + R) : row_hi;
    if (gw < 0 || gw >= nw) { r_lo = 0; r_hi = 0; }
    const bool dopart = (SRC == 2) && part && (gridDim.x == 256);
    int cur_cond = -1;
    float4 gn[4], nn[4], shv[4];
    float4 cx[4], nx[4];
    float4 cy[4], ny[4];
    uint2 cyb[4], nyb[4], cpb[4], npb[4];
#pragma unroll
    for (int i = 0; i < 4; ++i) { cx[i] = nx[i] = cy[i] = ny[i] = make_float4(0.f, 0.f, 0.f, 0.f); cyb[i] = nyb[i] = cpb[i] = npb[i] = make_uint2(0u, 0u); }
    auto load_row = [&](int t, float4 (&x)[4], float4 (&y)[4], uint2 (&yb)[4], uint2 (&pb)[4]) {
        const float* xi = (SRC == 0 || XIN) ? ((t < T_PROMPT) ? (p.in[0] + (size_t)t * 1024) : (p.in[1] + (size_t)(t - T_PROMPT) * 1024)) : (p.out + (size_t)t * 1024);
#pragma unroll
        for (int i = 0; i < 4; ++i) x[i] = *(const float4*)(xi + lane * 4 + 256 * i);
        if (SRC == 1) {
#pragma unroll
            for (int i = 0; i < 4; ++i) y[i] = *(const float4*)((const float*)ysrc + (size_t)t * 1024 + lane * 4 + 256 * i);
        }
        if (SRC == 2) {
#pragma unroll
            for (int i = 0; i < 4; ++i) yb[i] = *(const uint2*)((const bf16_t*)ysrc + (size_t)t * 1024 + lane * 4 + 256 * i);
            if (dopart && t >= 16384) {
#pragma unroll
                for (int i = 0; i < 4; ++i) pb[i] = *(const uint2*)((const bf16_t*)(p.ws + WS_SCR) + (size_t)(t - 16384) * 1024 + lane * 4 + 256 * i);
            }
        }
    };
    if (r_lo < r_hi) load_row(r_lo, cx, cy, cyb, cpb);
    for (int t = r_lo; t < r_hi; ++t) {
        if (t + 1 < r_hi) load_row(t + 1, nx, ny, nyb, npb);
        const int cond = (t < T_PROMPT) ? 0 : 1 + ((t - T_PROMPT) >> 12);
        if (cond != cur_cond) {
            cur_cond = cond;
#pragma unroll
            for (int i = 0; i < 4; ++i) {
                if (SRC != 0) {
                    const float4 g = *(const float4*)(modg + cond * 6144 + lane * 4 + 256 * i), n = *(const float4*)(ng_res + lane * 4 + 256 * i);
                    gn[i] = make_float4(g.x * n.x, g.y * n.y, g.z * n.z, g.w * n.w);
                }
                if (NEXT) {
                    const float* mp = modn + cond * 6144 + lane * 4 + 256 * i;
                    const float4 n = *(const float4*)(ng_next + lane * 4 + 256 * i), sc = *(const float4*)(mp + sc_off);
                    shv[i] = *(const float4*)(mp + sh_off);
                    nn[i] = make_float4(n.x * (1.f + sc.x), n.y * (1.f + sc.y), n.z * (1.f + sc.z), n.w * (1.f + sc.w));
                }
            }
        }
        float4 xv[4];
#pragma unroll
        for (int i = 0; i < 4; ++i) xv[i] = cx[i];
        float* xo = p.out + (size_t)t * 1024 + lane * 4;
        if ((SRC == 0 || XIN) && t >= T_PROMPT) {
            const int tl = (t - T_PROMPT) & 4095;
            const float rr = (float)(tl >> 6), cc = (float)(tl & 63);
#pragma unroll
            for (int i = 0; i < 4; ++i) {
                const float base = (i < 2) ? rr : cc;
                float pe[4];
#pragma unroll
                for (int e = 0; e < 4; ++e) {
                    const float a = base * om[e];
                    const float k = rintf(a * 0.15915494309189535f);
                    float y = fmaf(-k, 6.28318548202514648f, a); y = fmaf(-k, -1.7484555e-07f, y);
                    pe[e] = (i & 1) ? __cosf(y) : __sinf(y);
                }
                xv[i].x += pe[0]; xv[i].y += pe[1]; xv[i].z += pe[2]; xv[i].w += pe[3];
            }
        }
        if (SRC != 0) {
            float4 yv[4];
            if (SRC == 1) {
#pragma unroll
                for (int i = 0; i < 4; ++i) yv[i] = cy[i];
            } else {
#pragma unroll
                for (int i = 0; i < 4; ++i) yv[i] = make_float4(bflo(cyb[i].x), bfhi(cyb[i].x), bflo(cyb[i].y), bfhi(cyb[i].y));
                if (dopart && t >= 16384) {
#pragma unroll
                    for (int i = 0; i < 4; ++i) { yv[i].x += bflo(cpb[i].x); yv[i].y += bfhi(cpb[i].x); yv[i].z += bflo(cpb[i].y); yv[i].w += bfhi(cpb[i].y); }
                }
            }
            float ss = 0.f;
#pragma unroll
            for (int i = 0; i < 4; ++i) ss += yv[i].x * yv[i].x + yv[i].y * yv[i].y + yv[i].z * yv[i].z + yv[i].w * yv[i].w;
            ss = wave_sum(ss);
            const float r = rsqrtf(ss * (1.0f / 1024.0f) + EPSN);
#pragma unroll
            for (int i = 0; i < 4; ++i) {
                xv[i].x += gn[i].x * (yv[i].x * r); xv[i].y += gn[i].y * (yv[i].y * r); xv[i].z += gn[i].z * (yv[i].z * r); xv[i].w += gn[i].w * (yv[i].w * r);
            }
        }
        if (XST) {
#pragma unroll
            for (int i = 0; i < 4; ++i) *(float4*)(xo + 256 * i) = xv[i];
        }
        if (NEXT) {
            float ss = 0.f;
#pragma unroll
            for (int i = 0; i < 4; ++i) ss += xv[i].x * xv[i].x + xv[i].y * xv[i].y + xv[i].z * xv[i].z + xv[i].w * xv[i].w;
            ss = wave_sum(ss);
            const float r = rsqrtf(ss * (1.0f / 1024.0f) + EPSN);
#pragma unroll
            for (int i = 0; i < 4; ++i) {
                const float h0 = xv[i].x * r * nn[i].x + shv[i].x, h1 = xv[i].y * r * nn[i].y + shv[i].y;
                const float h2 = xv[i].z * r * nn[i].z + shv[i].z, h3 = xv[i].w * r * nn[i].w + shv[i].w;
                uint2 w; w.x = cvt_pk_bf16(h0, h1); w.y = cvt_pk_bf16(h2, h3);
                *(uint2*)(A + (size_t)t * 1024 + lane * 4 + 256 * i) = w;
            }
        }
#pragma unroll
        for (int i = 0; i < 4; ++i) { cx[i] = nx[i]; cy[i] = ny[i]; cyb[i] = nyb[i]; cpb[i] = npb[i]; }
    }
}

__device__ __forceinline__ void phase_gla_combine(const Params& p) {
    const int tid_ = otid(); const int lane = tid_ & 63, wid = tid_ >> 6;
    const bf16_t* proj = (const bf16_t*)(p.ws + WS_BIG + BIG_PROJ);
    const bf16_t* of = (const bf16_t*)(p.ws + WS_BIG + BIG_OF);
    const bf16_t* ob = (const bf16_t*)(p.ws + WS_BIG + BIG_OB);
    bf16_t* A = (bf16_t*)(p.ws + WS_ABUF);
    const float4 gn0 = *(const float4*)(p.in[21] + lane * 8), gn1 = *(const float4*)(p.in[21] + lane * 8 + 4);
    const float gn[8] = {gn0.x, gn0.y, gn0.z, gn0.w, gn1.x, gn1.y, gn1.z, gn1.w};
    const int nw = gridDim.x * 8, R = (T_TOK + nw - 1) / nw, gw = blockIdx.x * 8 + wid;
    const int r_lo = gw * R, r_hi = (r_lo + R < T_TOK) ? (r_lo + R) : T_TOK;
    u32x4 a = (u32x4){0, 0, 0, 0}, b = a, g = a, na = a, nb = a, ngv = a;
    if (r_lo < r_hi) { a = *(const u32x4*)(of + (size_t)r_lo * 512 + lane * 8); b = *(const u32x4*)(ob + (size_t)r_lo * 512 + lane * 8); g = *(const u32x4*)(proj + (size_t)r_lo * EVN + 2048 + lane * 8); }
    for (int t = r_lo; t < r_hi; ++t) {
        if (t + 1 < r_hi) { na = *(const u32x4*)(of + (size_t)(t + 1) * 512 + lane * 8); nb = *(const u32x4*)(ob + (size_t)(t + 1) * 512 + lane * 8); ngv = *(const u32x4*)(proj + (size_t)(t + 1) * EVN + 2048 + lane * 8); }
        float o[8], gg[8];
#pragma unroll
        for (int j = 0; j < 4; ++j) { o[2 * j] = bflo(a[j]) + bflo(b[j]); o[2 * j + 1] = bfhi(a[j]) + bfhi(b[j]); gg[2 * j] = bflo(g[j]); gg[2 * j + 1] = bfhi(g[j]); }
        float ss = 0.f;
#pragma unroll
        for (int j = 0; j < 8; ++j) ss += o[j] * o[j];
#pragma unroll
        for (int m = 8; m > 0; m >>= 1) ss += __shfl_xor(ss, m, 64);
        const float r = rsqrtf(ss * (1.0f / 128.0f) + EPSN);
        float v[8];
#pragma unroll
        for (int j = 0; j < 8; ++j) v[j] = o[j] * r * gn[j] * (gg[j] * sigmoidf_(gg[j]));
        u32x4 w; w.x = cvt_pk_bf16(v[0], v[1]); w.y = cvt_pk_bf16(v[2], v[3]); w.z = cvt_pk_bf16(v[4], v[5]); w.w = cvt_pk_bf16(v[6], v[7]);
        *(u32x4*)(A + (size_t)t * 1024 + 512 + lane * 8) = w;
        a = na; b = nb; g = ngv;
    }
}

__device__ __forceinline__ void sgu_item(const Params& p, unsigned char* shm, int item) {
#ifdef SKIP_SGU
    return;
#endif
    const int tid = otid(), lane = tid & 63, wid = tid >> 6, quad = lane >> 4;
    const int c = item >> 2, g = item & 3, t0 = c * 128;
    const bf16_t* proj = (const bf16_t*)(p.ws + WS_BIG + BIG_PROJ);
    bf16_t* A = (bf16_t*)(p.ws + WS_ABUF);
    float* MU = (float*)shm; float* RS = MU + 128;
    unsigned short* VNT = (unsigned short*)(shm + 1024);
    unsigned short* WSA = (unsigned short*)(shm + 1024 + 34816);
    {
        u32x4 v[16];
#pragma unroll
        for (int rr = 0; rr < 16; ++rr) v[rr] = *(const u32x4*)(proj + (size_t)(t0 + wid * 16 + rr) * EVN + 512 + lane * 8);
#pragma unroll
        for (int rr = 0; rr < 16; ++rr) {
            float s = 0.f, ss = 0.f;
#pragma unroll
            for (int j = 0; j < 4; ++j) { const float a = bflo(v[rr][j]), b = bfhi(v[rr][j]); s += a + b; ss += a * a + b * b; }
            s = wave_sum(s); ss = wave_sum(ss);
            if (lane == 0) { const float mu = s * (1.0f / 512.0f); const float var = fmaxf(ss * (1.0f / 512.0f) - mu * mu, 0.f); MU[wid * 16 + rr] = mu; RS[wid * 16 + rr] = rsqrtf(var + EPSN); }
        }
    }
    {
        const bf16_t* wsg = (const bf16_t*)(p.ws + WS_WSGU) + (size_t)g * 16384;
#pragma unroll
        for (int i = 0; i < 4; ++i) { const int e = tid + 512 * i, row = e >> 4, c8 = (e & 15) * 8; *(u32x4*)(WSA + row * 136 + c8) = *(const u32x4*)(wsg + row * 128 + c8); }
    }
    lds_barrier();
    {
        const int q = tid >> 2, d32 = (tid & 3) * 32;
        const float mu = MU[q], rs = RS[q];
        const bf16_t* src = proj + (size_t)(t0 + q) * EVN + 512 + g * 128 + d32;
        const float* lg = p.in[15] + g * 128 + d32; const float* lb = p.in[16] + g * 128 + d32;
#pragma unroll
        for (int i = 0; i < 4; ++i) {
            const u32x4 w = *(const u32x4*)(src + i * 8);
#pragma unroll
            for (int j = 0; j < 4; ++j) {
                const int d = d32 + i * 8 + 2 * j;
                const float a = (bflo(w[j]) - mu) * rs * lg[i * 8 + 2 * j] + lb[i * 8 + 2 * j];
                const float b = (bfhi(w[j]) - mu) * rs * lg[i * 8 + 2 * j + 1] + lb[i * 8 + 2 * j + 1];
                VNT[d * 136 + q] = f2bf(a); VNT[(d + 1) * 136 + q] = f2bf(b);
            }
        }
    }
    lds_barrier();
    {
        f32x4 acc[8];
#pragma unroll
        for (int dt = 0; dt < 8; ++dt) acc[dt] = (f32x4){0.f, 0.f, 0.f, 0.f};
#pragma unroll
        for (int ks = 0; ks < 4; ++ks) {
            const bf16x8 b = ldfrag(WSA, 136, wid * 16, ks * 32, lane);
#pragma unroll
            for (int dt = 0; dt < 8; ++dt) { const bf16x8 a = ldfrag(VNT, 136, dt * 16, ks * 32, lane); acc[dt] = MFMA16(a, b, acc[dt]); }
        }
        const int pp = wid * 16 + (lane & 15), t = t0 + pp;
        const float bsv = p.in[18][g * 128 + pp];
#pragma unroll
        for (int dt = 0; dt < 8; ++dt) {
            const int d = dt * 16 + quad * 4;
            const uint2 uw = *(const uint2*)(proj + (size_t)t * EVN + g * 128 + d);
            uint2 w; w.x = cvt_pk_bf16(bflo(uw.x) * (acc[dt][0] + bsv), bfhi(uw.x) * (acc[dt][1] + bsv)); w.y = cvt_pk_bf16(bflo(uw.y) * (acc[dt][2] + bsv), bfhi(uw.y) * (acc[dt][3] + bsv));
            *(uint2*)(A + (size_t)t * 1024 + g * 128 + d) = w;
        }
    }
    lds_barrier();
}

__device__ __forceinline__ float fexp(float x) { return __builtin_amdgcn_exp2f(x * 1.4426950408889634f); }
__device__ __forceinline__ float flog(float x) { return __builtin_amdgcn_logf(x) * 0.6931471805599453f; }
__device__ __forceinline__ void gla_item(const Params& p, unsigned char* shm, int item) {
    const int tid = otid(), lane = tid & 63, wid = tid >> 6, quad = lane >> 4, l15 = lane & 15;
#ifdef SKIP_GLAP
    if (item >= 128) return;
#endif
    int s, rem;
    if (item < 128) { s = 16 + (item >> 5); rem = item & 31; } else { s = (item - 128) >> 5; rem = (item - 128) & 31; }
    const int h = rem >> 3, dir = (rem >> 2) & 1, sl = rem & 3;
    const int ts = (s < 16) ? s * 256 : T_PROMPT + (s - 16) * 4096, L = (s < 16) ? 256 : 4096, nc = L >> 6;
    const bf16_t* proj = (const bf16_t*)(p.ws + WS_BIG + BIG_PROJ);
    bf16_t* O = (bf16_t*)(p.ws + WS_BIG + (dir ? BIG_OB : BIG_OF));
    unsigned short* QR = (unsigned short*)(shm + 0);
    unsigned short* KR = (unsigned short*)(shm + 8192);
    unsigned short* LR = (unsigned short*)(shm + 82944);
    float* LA = (float*)(shm + 18432);
    float* SEG = (float*)(shm + 34816);
    unsigned short* QE = (unsigned short*)(shm + 36864);
    unsigned short* KE = (unsigned short*)(shm + 46080);
    unsigned short* KDT = (unsigned short*)(shm + 55296);
    unsigned short* VT = (unsigned short*)(shm + 64512);
    unsigned short* ST = (unsigned short*)(shm + 69120);
    unsigned short* ATT = (unsigned short*)(shm + 73728);
    float* DEC = (float*)(shm + 88064);
    const int lrow = tid >> 3, lc8 = (tid & 7) * 8;
    u32x4 qreg, kreg, vreg = (u32x4){0, 0, 0, 0};
    auto issue = [&](int n) {
        const int t0 = dir ? (ts + L - 64 * (n + 1)) : (ts + 64 * n);
        const int tq = dir ? (t0 + 63 - lrow) : (t0 + lrow);
        qreg = *(const u32x4*)(proj + (size_t)tq * EVN + 1024 + h * 64 + lc8);
        kreg = *(const u32x4*)(proj + (size_t)tq * EVN + 1280 + h * 64 + lc8);
        if (tid < 256) { const int vr = tid >> 2; const int tv = dir ? (t0 + 63 - vr) : (t0 + vr); vreg = *(const u32x4*)(proj + (size_t)tv * EVN + 1536 + h * 128 + sl * 32 + (tid & 3) * 8); }
        else if (tid < 384) { const int e = tid - 256, r = e >> 1; const int tl = dir ? (t0 + 63 - r) : (t0 + r); vreg = *(const u32x4*)(proj + (size_t)tl * EVN + 2560 + dir * 16 + (e & 1) * 8); }
    };
    issue(0);
    const int gmt = (wid * 2) >> 2, gnt0 = (wid * 2) & 3;
    bf16x8 gwf[2]; float gbv[2];
#pragma unroll
    for (int tt = 0; tt < 2; ++tt) {
        const int dkc = h * 64 + (gnt0 + tt) * 16 + l15;
        float wv[8];
#pragma unroll
        for (int j = 0; j < 8; ++j) wv[j] = (quad < 2) ? p.in[19][(dir * 16 + quad * 8 + j) * 256 + dkc] : 0.f;
        u32x4 pw; pw.x = cvt_pk_bf16(wv[0], wv[1]); pw.y = cvt_pk_bf16(wv[2], wv[3]); pw.z = cvt_pk_bf16(wv[4], wv[5]); pw.w = cvt_pk_bf16(wv[6], wv[7]);
        gwf[tt] = __builtin_bit_cast(bf16x8, pw);
        gbv[tt] = p.in[20][dir * 256 + dkc];
    }
    { unsigned z0 = 0; asm volatile("" : "+v"(z0));
      if (tid < 128) *(u32x4*)(LR + (tid >> 1) * 40 + 16 + (tid & 1) * 8) = (u32x4){z0, z0, z0, z0}; }
    const int mt = wid >> 1, nt = wid & 1;
    f32x4 Sacc = (f32x4){0.f, 0.f, 0.f, 0.f};
    if (s >= 16) {
        const float* st = p.in[3] + ((size_t)(((s - 16) * 2 + dir) * 4 + h) * 64) * 128;
#pragma unroll
        for (int j = 0; j < 4; ++j) Sacc[j] = st[(mt * 16 + quad * 4 + j) * 128 + sl * 32 + nt * 16 + l15];
    }
    unsigned dbgc = 0;
    uint2 pend_w = make_uint2(0u, 0u); bf16_t* pend_ptr = nullptr;
    for (int n = 0; n < nc; ++n) {
        const int t0 = dir ? (ts + L - 64 * (n + 1)) : (ts + 64 * n);
        *(u32x4*)(QR + lrow * 64 + lc8) = qreg; *(u32x4*)(KR + lrow * 64 + lc8) = kreg;
        if (tid < 256) { const int vr = tid >> 2, d8 = (tid & 3) * 8;
#pragma unroll
            for (int j = 0; j < 4; ++j) { VT[(d8 + 2 * j) * 72 + vr] = (unsigned short)(vreg[j] & 0xffffu); VT[(d8 + 2 * j + 1) * 72 + vr] = (unsigned short)(vreg[j] >> 16); } }
        else if (tid < 384) { const int e = tid - 256; *(u32x4*)(LR + (e >> 1) * 40 + (e & 1) * 8) = vreg; }
        if (n > 0) *(uint2*)pend_ptr = pend_w;
        if (n + 1 < nc) issue(n + 1);
        lds_barrier();
        {
            const bf16x8 af = ldfrag(LR, 40, gmt * 16, 0, lane);
#pragma unroll
            for (int tt = 0; tt < 2; ++tt) {
                f32x4 zc = (f32x4){0.f, 0.f, 0.f, 0.f};
                zc = MFMA16(af, gwf[tt], zc);
#pragma unroll
                for (int j = 0; j < 4; ++j) {
                    const float z = zc[j] + gbv[tt];
                    LA[(gmt * 16 + quad * 4 + j) * 64 + (gnt0 + tt) * 16 + l15] = (fminf(z, 0.f) - flog(1.0f + fexp(-fabsf(z)))) * 0.0625f;
                }
            }
        }
        lds_barrier();
        const int dk = lane, seg = wid;
        float cs[8];
        {
            float run = 0.f;
#pragma unroll
            for (int i = 0; i < 8; ++i) { run += LA[(seg * 8 + i) * 64 + dk]; cs[i] = run; }
            SEG[seg * 64 + dk] = run;
        }
        lds_barrier();
        {
            float pre = 0.f, tot = 0.f;
#pragma unroll
            for (int s2 = 0; s2 < 8; ++s2) { const float v = SEG[s2 * 64 + dk]; if (s2 < seg) pre += v; tot += v; }
            float kd[8];
            const float etot = fexp(tot);
#pragma unroll
            for (int i = 0; i < 8; ++i) {
                const int row = seg * 8 + i;
                const float b = pre + cs[i];
                const float q = bf2f(QR[row * 64 + dk]) * 0.125f, k = bf2f(KR[row * 64 + dk]);
#ifdef DBG_GLA
                if (!(fabsf(b) < 80.f)) dbgc |= 4u;
                if (!(fabsf(q) < 1e4f) || !(fabsf(k) < 1e4f)) dbgc |= 8u;
#endif
                const float eb = fexp(b), ke = k * __builtin_amdgcn_rcpf(eb);
                QE[row * 72 + dk] = f2bf(q * eb);
                KE[row * 72 + dk] = f2bf(ke);
                kd[i] = ke * etot;
            }
            u32x4 w; w.x = cvt_pk_bf16(kd[0], kd[1]); w.y = cvt_pk_bf16(kd[2], kd[3]); w.z = cvt_pk_bf16(kd[4], kd[5]); w.w = cvt_pk_bf16(kd[6], kd[7]);
            *(u32x4*)(KDT + dk * 72 + seg * 8) = w;
            if (seg == 0) DEC[dk] = etot;
            uint2 sw; sw.x = cvt_pk_bf16(Sacc[0], Sacc[1]); sw.y = cvt_pk_bf16(Sacc[2], Sacc[3]);
            *(uint2*)(ST + (nt * 16 + l15) * 72 + mt * 16 + quad * 4) = sw;
        }
        lds_barrier();
#pragma unroll
        for (int tt = 0; tt < 2; ++tt) {
            const int idx = wid * 2 + tt, it = idx >> 2, jt = idx & 3;
            f32x4 acc = (f32x4){0.f, 0.f, 0.f, 0.f};
            if (jt <= it) {
#pragma unroll
                for (int ks = 0; ks < 2; ++ks) { const bf16x8 a = ldfrag(KE, 72, jt * 16, ks * 32, lane), b = ldfrag(QE, 72, it * 16, ks * 32, lane); acc = MFMA16(a, b, acc); }
            }
#ifdef DBG_GLA
            for (int j = 0; j < 4; ++j) if (!(fabsf(acc[j]) < 1e30f)) dbgc |= 16u;
#endif
            const int i = it * 16 + l15, j0 = jt * 16 + quad * 4;
            uint2 w; w.x = cvt_pk_bf16(i >= j0 ? acc[0] : 0.f, i >= j0 + 1 ? acc[1] : 0.f); w.y = cvt_pk_bf16(i >= j0 + 2 ? acc[2] : 0.f, i >= j0 + 3 ? acc[3] : 0.f);
            *(uint2*)(ATT + i * 72 + j0) = w;
        }
        lds_barrier();
        {
            f32x4 acc = (f32x4){0.f, 0.f, 0.f, 0.f};
#pragma unroll
            for (int ks = 0; ks < 2; ++ks) { const bf16x8 a = ldfrag(VT, 72, nt * 16, ks * 32, lane), b = ldfrag(ATT, 72, mt * 16, ks * 32, lane); acc = MFMA16(a, b, acc); }
#pragma unroll
            for (int ks = 0; ks < 2; ++ks) { const bf16x8 a = ldfrag(ST, 72, nt * 16, ks * 32, lane), b = ldfrag(QE, 72, mt * 16, ks * 32, lane); acc = MFMA16(a, b, acc); }
#ifdef DBG_GLA
            for (int j = 0; j < 4; ++j) if (!(fabsf(acc[j]) < 1e30f)) dbgc |= 32u;
#endif
            const int i = mt * 16 + l15; const int t = dir ? (t0 + 63 - i) : (t0 + i);
            uint2 w; w.x = cvt_pk_bf16(acc[0], acc[1]); w.y = cvt_pk_bf16(acc[2], acc[3]);
            pend_w = w; pend_ptr = O + (size_t)t * 512 + h * 128 + sl * 32 + nt * 16 + quad * 4;
        }
        {
#pragma unroll
            for (int j = 0; j < 4; ++j) Sacc[j] *= DEC[mt * 16 + quad * 4 + j];
#pragma unroll
            for (int ks = 0; ks < 2; ++ks) { const bf16x8 a = ldfrag(KDT, 72, mt * 16, ks * 32, lane), b = ldfrag(VT, 72, nt * 16, ks * 32, lane); Sacc = MFMA16(a, b, Sacc); }
        }
        lds_barrier();
    }
    *(uint2*)pend_ptr = pend_w;
    if (s < 16) {
        float* so = p.out + (size_t)T_TOK * 1024 + ((size_t)((s * 2 + dir) * 4 + h) * 64) * 128;
#pragma unroll
        for (int j = 0; j < 4; ++j) so[(mt * 16 + quad * 4 + j) * 128 + sl * 32 + nt * 16 + l15] = Sacc[j];
    }
}

__device__ __forceinline__ void phase_mix_even(const Params& p, unsigned char* shm) {
    constexpr int N_GLA = 640, N_ALL = 1280;
    if (gridDim.x == 256) {
        if (blockIdx.x < 128) gla_item(p, shm, blockIdx.x);
        else for (int it = 128 + (blockIdx.x - 128); it < N_ALL; it += 128) { if (it < N_GLA) gla_item(p, shm, it); else sgu_item(p, shm, it - N_GLA); }
    } else {
        for (int it = blockIdx.x; it < N_ALL; it += gridDim.x) { if (it < N_GLA) gla_item(p, shm, it); else sgu_item(p, shm, it - N_GLA); }
    }
}

template <int PASS>
__device__ __forceinline__ void phase_rg(const Params& p, unsigned char* shm) {
    const int tid = otid(), lane = tid & 63, wid = tid >> 6, quad = lane >> 4, l15 = lane & 15;
    const bf16_t* rgp = (const bf16_t*)(p.ws + WS_BIG + BIG_RGP);
    unsigned short* WG = (unsigned short*)(shm);
    float* XC = (float*)(shm + 36864);
    float* AF = (float*)(shm + 53248); float* BF = AF + 4096; float* AB = BF + 4096; float* BB = AB + 4096;
    unsigned short* XCB = (unsigned short*)(shm + 118784);
    unsigned short* XB = (unsigned short*)(shm + 128000);
    float2* SG = (float2*)(shm + 136576);
    const int row = tid >> 3, c8 = (tid & 7) * 8;
    const int jt = wid & 3, tp = wid >> 2;
    int cur_hb = -1;
    float sp[2], ba[2], bx[2], cbv[8], cwv[4][8];
    u32x4 xreg = (u32x4){0, 0, 0, 0}, xreg2 = (u32x4){0, 0, 0, 0}, greg = (u32x4){0, 0, 0, 0};
    auto issue = [&](int item) {
        const int c = item >> 4, hb = item & 15, t0 = c * 64;
        const int s_lo = (t0 < T_PROMPT) ? (t0 & ~255) : (T_PROMPT + ((t0 - T_PROMPT) & ~4095));
        const int s_hi = s_lo + ((t0 < T_PROMPT) ? 256 : 4096);
        const int tt = t0 - 2 + row;
        xreg = (u32x4){0, 0, 0, 0};
        if (tt >= s_lo && tt < s_hi) xreg = *(const u32x4*)(rgp + (size_t)tt * 2048 + hb * 64 + c8);
        if (tid < 24) {
            const int t2 = t0 + 62 + (tid >> 3);
            xreg2 = (u32x4){0, 0, 0, 0};
            if (t2 >= s_lo && t2 < s_hi) xreg2 = *(const u32x4*)(rgp + (size_t)t2 * 2048 + hb * 64 + c8);
        }
        if (PASS == 1) greg = *(const u32x4*)(rgp + (size_t)(t0 + row) * 2048 + 1024 + hb * 64 + c8);
    };
    u32x4 pend_w = (u32x4){0, 0, 0, 0}; bf16_t* pend_ptr = nullptr; float pend_a = 0.f, pend_b = 0.f; float* pend_s = nullptr;
    int item = blockIdx.x;
    if (item < 5120) issue(item);
    for (; item < 5120; item += gridDim.x) {
        const int c = item >> 4, hb = item & 15, t0 = c * 64;
        if (hb != cur_hb) {
            lds_barrier();
            cur_hb = hb;
            const bf16_t* wg = (const bf16_t*)(p.ws + WS_WRGG) + (size_t)hb * 256 * 64;
#pragma unroll
            for (int i = 0; i < 4; ++i) { const int e = tid + 512 * i, r = e >> 3, cc = (e & 7) * 8; *(u32x4*)(WG + r * 72 + cc) = *(const u32x4*)(wg + r * 64 + cc); }
            const int gch = hb * 64 + jt * 16 + l15;
#pragma unroll
            for (int d = 0; d < 2; ++d) {
                const float lam = p.in[29][d * 1024 + gch];
                sp[d] = 8.0f * (fmaxf(-lam, 0.f) + __logf(1.0f + __expf(-fabsf(lam))));
                ba[d] = p.in[26][d * 1024 + gch]; bx[d] = p.in[28][d * 1024 + gch];
            }
#pragma unroll
            for (int j = 0; j < 8; ++j) { cbv[j] = p.in[24][hb * 64 + c8 + j];
#pragma unroll
                for (int tap = 0; tap < 4; ++tap) cwv[tap][j] = p.in[23][tap * 1024 + hb * 64 + c8 + j]; }
        }
        *(u32x4*)(XB + row * 64 + c8) = xreg;
        if (tid < 24) *(u32x4*)(XB + (64 + (tid >> 3)) * 64 + c8) = xreg2;
        const u32x4 gg = greg;
        if (PASS == 0) { if (pend_s) { pend_s[0] = pend_a; pend_s[1024] = pend_b; } } else { if (pend_ptr) *(u32x4*)pend_ptr = pend_w; }
        if (item + (int)gridDim.x < 5120) issue(item + gridDim.x);
        lds_barrier();
        {
            float xc[8];
#pragma unroll
            for (int j = 0; j < 8; ++j) xc[j] = cbv[j];
#pragma unroll
            for (int tap = 0; tap < 4; ++tap) {
                const u32x4 v = *(const u32x4*)(XB + (row + tap) * 64 + c8);
#pragma unroll
                for (int j = 0; j < 4; ++j) { xc[2 * j] += cwv[tap][2 * j] * bflo(v[j]); xc[2 * j + 1] += cwv[tap][2 * j + 1] * bfhi(v[j]); }
            }
            *(f32x4*)(XC + row * 64 + c8) = (f32x4){xc[0], xc[1], xc[2], xc[3]};
            *(f32x4*)(XC + row * 64 + c8 + 4) = (f32x4){xc[4], xc[5], xc[6], xc[7]};
            u32x4 w; w.x = cvt_pk_bf16(xc[0], xc[1]); w.y = cvt_pk_bf16(xc[2], xc[3]); w.z = cvt_pk_bf16(xc[4], xc[5]); w.w = cvt_pk_bf16(xc[6], xc[7]);
            *(u32x4*)(XCB + row * 72 + c8) = w;
        }
        lds_barrier();
        {
            f32x4 acc[2][4];
#pragma unroll
            for (int a = 0; a < 2; ++a)
#pragma unroll
                for (int b = 0; b < 4; ++b) acc[a][b] = (f32x4){0.f, 0.f, 0.f, 0.f};
#pragma unroll
            for (int ks = 0; ks < 2; ++ks) {
                const bf16x8 a0 = ldfrag(XCB, 72, (2 * tp) * 16, ks * 32, lane), a1 = ldfrag(XCB, 72, (2 * tp + 1) * 16, ks * 32, lane);
#pragma unroll
                for (int mat = 0; mat < 4; ++mat) { const bf16x8 b = ldfrag(WG, 72, mat * 64 + jt * 16, ks * 32, lane); acc[0][mat] = MFMA16(a0, b, acc[0][mat]); acc[1][mat] = MFMA16(a1, b, acc[1][mat]); }
            }
            const int ch = jt * 16 + l15;
#pragma unroll
            for (int t2 = 0; t2 < 2; ++t2)
#pragma unroll
                for (int j = 0; j < 4; ++j) {
                    const int tok = (2 * tp + t2) * 16 + quad * 4 + j;
                    const float x = XC[tok * 64 + ch];
#pragma unroll
                    for (int d = 0; d < 2; ++d) {
                        const float e1 = fexp(-(acc[t2][2 * d][j] + ba[d])), e2 = fexp(-(acc[t2][2 * d + 1][j] + bx[d]));
                        const float p1 = 1.0f + e1, p2 = 1.0f + e2, inv = __builtin_amdgcn_rcpf(p1 * p2);
                        const float r = p2 * inv, ig = p1 * inv;
                        const float a = fexp(-r * sp[d]);
                        const float bt = __builtin_amdgcn_sqrtf(fmaxf(1.0f - a * a, 0.f)) * ig * x;
                        (d ? AB : AF)[tok * 64 + ch] = a; (d ? BB : BF)[tok * 64 + ch] = bt;
                    }
                }
        }
        lds_barrier();
        {
            const int ch = tid & 63, d = (tid >> 6) & 1, q = tid >> 7;
            const float* Ap = d ? AB : AF; float* Bp = d ? BB : BF;
            float av[16], bv[16];
#pragma unroll
            for (int i = 0; i < 16; ++i) { const int st = q * 16 + i, tok = d ? 63 - st : st; av[i] = Ap[tok * 64 + ch]; bv[i] = Bp[tok * 64 + ch]; }
            float A = 1.f, B = 0.f;
#pragma unroll
            for (int i = 0; i < 16; ++i) { B = av[i] * B + bv[i]; A *= av[i]; }
            SG[(q * 2 + d) * 64 + ch] = make_float2(A, B);
            lds_barrier();
            if (PASS == 0) {
                if (q == 0) {
                    float A2 = 1.f, B2 = 0.f;
#pragma unroll
                    for (int k = 0; k < 4; ++k) { const float2 sg = SG[(k * 2 + d) * 64 + ch]; B2 = sg.x * B2 + sg.y; A2 *= sg.x; }
                    pend_s = (float*)(p.ws + WS_BIG + BIG_RGSUM) + (size_t)(c * 2 + d) * 2048 + hb * 64 + ch; pend_a = A2; pend_b = B2;
                }
            } else {
                float hcur = ((const float*)(p.ws + WS_BIG + BIG_RGCAR))[(size_t)(c * 2 + d) * 1024 + hb * 64 + ch];
                for (int k = 0; k < q; ++k) { const float2 sg = SG[(k * 2 + d) * 64 + ch]; hcur = sg.x * hcur + sg.y; }
#pragma unroll
                for (int i = 0; i < 16; ++i) { const int st = q * 16 + i, tok = d ? 63 - st : st; hcur = av[i] * hcur + bv[i]; Bp[tok * 64 + ch] = hcur; }
            }
        }
        if (PASS == 1) {
            lds_barrier();
            {
                const int t = t0 + row;
                const f32x4 f0 = *(const f32x4*)(BF + row * 64 + c8), f1 = *(const f32x4*)(BF + row * 64 + c8 + 4);
                const f32x4 b0 = *(const f32x4*)(BB + row * 64 + c8), b1 = *(const f32x4*)(BB + row * 64 + c8 + 4);
                u32x4 w;
                w.x = cvt_pk_bf16((f0[0] + b0[0]) * bflo(gg[0]), (f0[1] + b0[1]) * bfhi(gg[0]));
                w.y = cvt_pk_bf16((f0[2] + b0[2]) * bflo(gg[1]), (f0[3] + b0[3]) * bfhi(gg[1]));
                w.z = cvt_pk_bf16((f1[0] + b1[0]) * bflo(gg[2]), (f1[1] + b1[1]) * bfhi(gg[2]));
                w.w = cvt_pk_bf16((f1[2] + b1[2]) * bflo(gg[3]), (f1[3] + b1[3]) * bfhi(gg[3]));
                pend_w = w; pend_ptr = (bf16_t*)(p.ws + WS_ABUF) + (size_t)t * 1024 + hb * 64 + c8;
            }
        }
    }
    if (PASS == 0) { if (pend_s) { pend_s[0] = pend_a; pend_s[1024] = pend_b; } } else { if (pend_ptr) *(u32x4*)pend_ptr = pend_w; }
    lds_barrier();
}

__device__ __forceinline__ void phase_rg_carry(const Params& p) {
    const int idx = blockIdx.x * 512 + otid();
    for (int e = idx; e < 20 * 2 * 1024; e += gridDim.x * 512) {
        const int s = e >> 11, d = (e >> 10) & 1, ch = e & 1023;
        const int nc = (s < 16) ? 4 : 64, cbase = (s < 16) ? s * 4 : 64 + (s - 16) * 64;
        const float* sum = (const float*)(p.ws + WS_BIG + BIG_RGSUM);
        float* car = (float*)(p.ws + WS_BIG + BIG_RGCAR);
        float h = (s < 16) ? 0.f : p.in[4][((s - 16) * 2 + d) * 1024 + ch];
        for (int n0 = 0; n0 < nc; n0 += 4) {
            float A[4], B[4];
#pragma unroll
            for (int j = 0; j < 4; ++j) { const int n = d ? (nc - 1 - (n0 + j)) : (n0 + j); const float* sp = sum + (size_t)((cbase + n) * 2 + d) * 2048 + ch; A[j] = sp[0]; B[j] = sp[1024]; }
#pragma unroll
            for (int j = 0; j < 4; ++j) { const int n = d ? (nc - 1 - (n0 + j)) : (n0 + j); car[(size_t)((cbase + n) * 2 + d) * 1024 + ch] = h; h = A[j] * h + B[j]; }
        }
        if (s < 16) p.out[(size_t)T_TOK * 1024 + 1048576 + (s * 2 + d) * 1024 + ch] = h;
    }
}

#define XB_TMO      128
#define XB_XCNT(j)  (256  + 64 * (j))
#define XB_XSUB(j)  (1280 + 64 * (j))
#define XB_XGEN(j)  (2304 + 64 * (j))
#define XB_TOP      3328
#define XB_TOPGEN   3392
#define XCD_BAR_WORDS 3456
#define XB_SPIN_CAP (1u << 18)
#define LAS __attribute__((address_space(3)))

__device__ __forceinline__ unsigned xb_ld(unsigned* p)              { return __hip_atomic_load(p, __ATOMIC_RELAXED, __HIP_MEMORY_SCOPE_AGENT); }
__device__ __forceinline__ unsigned xb_add(unsigned* p, unsigned v) { return __hip_atomic_fetch_add(p, v, __ATOMIC_RELAXED, __HIP_MEMORY_SCOPE_AGENT); }
__device__ __forceinline__ unsigned xb_xcc_id() { return (unsigned)__builtin_amdgcn_s_getreg((3 << 11) | 20) & 0xFu; }
#define XB_SPIN(cond, bar) do { unsigned _sp = 0; while (cond) { __builtin_amdgcn_s_sleep(1); \
    if ((++_sp & 255u) == 0u) { if (xb_ld(&(bar)[XB_TMO])) break; if (_sp > XB_SPIN_CAP) { atomicAdd(&(bar)[XB_TMO], 1u); break; } } } } while (0)

struct XcdBarrier {
    unsigned* bar; unsigned x;
    volatile LAS unsigned* st;
};

__device__ __forceinline__ XcdBarrier xcd_barrier_post(unsigned* bar, volatile LAS unsigned* st) {
    XcdBarrier b; b.bar = bar; b.x = xb_xcc_id(); b.st = st;
    if (threadIdx.x == 0) (void)xb_add(&bar[XB_XCNT(b.x)], 1u);
    return b;
}
__device__ __forceinline__ void xcd_barrier_complete(unsigned* bar, unsigned x, unsigned& nloc, unsigned& nx) {
    const unsigned G = gridDim.x * gridDim.y * gridDim.z;
    unsigned sum, cnt, mine, sp = 0u;
    for (;;) {
        sum = 0u; cnt = 0u; mine = 0u;
#pragma unroll
        for (unsigned j = 0; j < 16; ++j) { const unsigned c = xb_ld(&bar[XB_XCNT(j)]); sum += c; cnt += (c > 0u) ? 1u : 0u; mine = (j == x) ? c : mine; }
        if (sum == G) break;
        __builtin_amdgcn_s_sleep(1);
        if ((++sp & 255u) == 0u) { if (xb_ld(&bar[XB_TMO])) break; if (sp > XB_SPIN_CAP) { atomicAdd(&bar[XB_TMO], 1u); break; } }
    }
    nloc = mine > 0u ? mine : 1u; nx = cnt > 0u ? cnt : 1u;
}

__device__ __forceinline__ void xcd_barrier(const XcdBarrier& b) {
    asm volatile("s_waitcnt vmcnt(0)" ::: "memory");
    __syncthreads();
    if (threadIdx.x == 0) {
        unsigned* bar = b.bar;
        __builtin_amdgcn_s_waitcnt(0);
        unsigned nloc = b.st[0], nx = b.st[1];
        if (nloc == 0u) { xcd_barrier_complete(bar, b.x, nloc, nx); b.st[0] = nloc; b.st[1] = nx; }
        const unsigned old = xb_add(&bar[XB_XSUB(b.x)], 1u);
        const unsigned gen = old / nloc;
        if (old + 1u == (gen + 1u) * nloc) {
            __builtin_amdgcn_fence(__ATOMIC_RELEASE, "agent");
            asm volatile("s_waitcnt vmcnt(0)" ::: "memory");
            const unsigned og = xb_add(&bar[XB_TOP], 1u);
            const unsigned tg = og / nx;
            if (og + 1u == (tg + 1u) * nx) xb_add(&bar[XB_TOPGEN], 1u);
            else XB_SPIN(xb_ld(&bar[XB_TOPGEN]) == tg, bar);
            __builtin_amdgcn_fence(__ATOMIC_ACQUIRE, "agent");
            xb_add(&bar[XB_XGEN(b.x)], 1u);
            asm volatile("s_waitcnt vmcnt(0)" ::: "memory");
        } else {
            XB_SPIN(xb_ld(&bar[XB_XGEN(b.x)]) == gen, bar);
            __builtin_amdgcn_fence(__ATOMIC_ACQUIRE, "agent");
            asm volatile("s_waitcnt vmcnt(0)" ::: "memory");
        }
    }
    __syncthreads();
}

constexpr size_t WS_CNT = WS_BAR + 14336;
__device__ __forceinline__ void xcd_arrive(unsigned* xcnt, unsigned* gcnt, const XcdBarrier& xb) {
    asm volatile("s_waitcnt vmcnt(0)" ::: "memory");
    __syncthreads();
    if (threadIdx.x == 0) {
        const unsigned nloc = xb.st[0];
        const unsigned old = __hip_atomic_fetch_add(xcnt + xb.x, 1u, __ATOMIC_RELAXED, __HIP_MEMORY_SCOPE_AGENT);
        if (old + 1u == nloc) {
            __builtin_amdgcn_fence(__ATOMIC_RELEASE, "agent");
            asm volatile("s_waitcnt vmcnt(0)" ::: "memory");
            __hip_atomic_fetch_add(gcnt, nloc, __ATOMIC_RELAXED, __HIP_MEMORY_SCOPE_AGENT);
        }
    }
}
__device__ __forceinline__ void wg_wait(unsigned* cnt, unsigned need) {
    if (threadIdx.x == 0) {
        unsigned sp = 0;
        while (__hip_atomic_load(cnt, __ATOMIC_RELAXED, __HIP_MEMORY_SCOPE_AGENT) < need) { __builtin_amdgcn_s_sleep(2); if (++sp > (1u << 22)) break; }
        __builtin_amdgcn_fence(__ATOMIC_ACQUIRE, "agent");
        asm volatile("s_waitcnt vmcnt(0)" ::: "memory");
    }
    __syncthreads();
}

__device__ __forceinline__ void run_phase(const Params& p, unsigned char* shm, int ph, int dbg, const XcdBarrier& xb) {
    const float* MOD = (const float*)(p.ws + WS_MOD);
    const float* NG = p.in[8];
    bf16_t* ABUF = (bf16_t*)(p.ws + WS_ABUF);
    unsigned char* BIG = p.ws + WS_BIG;
    const bool is_gemm = (ph == 2) | (ph == 5) | (ph == 7) | (ph == 8) | (ph == 10) | (ph == 14) | (ph == 16) | (ph == 17);
    if (is_gemm) {
        EpiGen E; const bf16_t* A = ABUF; const bf16_t* Bt; int N, K = 1024;
        E.bias = nullptr;
        if (ph == 2) { E.mode = 0; E.O = BIG + BIG_PROJ; E.ldc = EVN; E.ncols = EVN; Bt = (const bf16_t*)(p.ws + WS_WEVIN); N = EVNP; }
        else if (ph == 5) { E.mode = 5; E.O = BIG + BIG_Y; E.ldc = 1024; E.ncols = 1024; Bt = (const bf16_t*)(p.ws + WS_WEVOUT); N = 1024; }
        else if (ph == 14) { E.mode = 5; E.O = BIG + BIG_Y; E.ldc = 1024; E.ncols = 1024; Bt = (const bf16_t*)(p.ws + WS_WRGOUT); N = 1024; }
        else if (ph == 10) { E.mode = 3; E.O = BIG + BIG_RGP; E.ldc = 2048; E.ncols = 2048; Bt = (const bf16_t*)(p.ws + WS_WRGIN); N = 2048; }
        else if (ph == 7 || ph == 16) { const int l = (ph == 16); E.mode = 1; E.O = BIG + BIG_H; E.ldc = 4096; E.ncols = 4096; E.bias = p.in[10] + l * 4096; Bt = (const bf16_t*)(p.ws + WS_WMLP1) + (size_t)l * 4096 * 1024; N = 4096; }
        else { const int l = (ph == 17); E.mode = 2; E.O = ABUF; E.ldc = 1024; E.ncols = 1024; E.bias = p.in[12] + l * 1024; A = (const bf16_t*)(BIG + BIG_H); Bt = (const bf16_t*)(p.ws + WS_WMLP2) + (size_t)l * 1024 * 4096; N = 1024; K = 4096; }
        if ((E.mode == 2 || E.mode == 5) && gridDim.x == 256) {
            unsigned* xcA = (unsigned*)(p.ws + WS_CNT) + 128 * (ph == 5 ? 0 : ph == 8 ? 1 : ph == 14 ? 2 : 3);
            unsigned* cntA = xcA + 64;
            const int nb = (E.mode == 2) ? 128 : 64;
            const int hsplit = (E.mode == 2) ? 12288 : 14336;
            run_gemm(shm, A, Bt, 16384, 1024, K, K, 256, (int)blockIdx.x, E);
            xcd_arrive(xcA, cntA, xb);
            if ((int)blockIdx.x < nb) {
                if (E.mode == 2) {
                    const int sp = blockIdx.x & 1;
                    EpiGen E2 = E;
                    E2.O = sp ? (void*)(p.ws + WS_SCR) : (void*)((bf16_t*)E.O + (size_t)16384 * 1024);
                    E2.bias = sp ? nullptr : E.bias;
                    run_gemm(shm, A + (size_t)16384 * 4096 + sp * 2048, Bt + sp * 2048, 4096, 1024, 2048, 4096, 64, (int)(blockIdx.x >> 1), E2);
                } else {
                    EpiGen E2 = E; E2.O = (void*)((bf16_t*)E.O + (size_t)16384 * 1024);
                    run_gemm(shm, A + (size_t)16384 * 1024, Bt, 4096, 1024, 1024, 1024, 64, (int)blockIdx.x, E2);
                }
            } else {
                wg_wait(cntA, 256u);
                const int w0 = nb * 8, nwv = (256 - nb) * 8;
                if (ph == 5) phase_row<2, true, true, true>(p, BIG + BIG_Y, NG + 1 * 1024, MOD + 2048, NG + 2 * 1024, MOD, 3072, 4096, false, 0, hsplit, w0, nwv);
                else if (ph == 8) phase_row<2, true>(p, ABUF, NG + 3 * 1024, MOD + 5120, NG + 4 * 1024, MOD + 5 * 6144, 0, 1024, true, 0, hsplit, w0, nwv);
                else if (ph == 14) phase_row<2, true>(p, BIG + BIG_Y, NG + 5 * 1024, MOD + 5 * 6144 + 2048, NG + 6 * 1024, MOD + 5 * 6144, 3072, 4096, false, 0, hsplit, w0, nwv);
                else phase_row<2, false>(p, ABUF, NG + 7 * 1024, MOD + 5 * 6144 + 5120, nullptr, nullptr, 0, 0, true, 0, hsplit, w0, nwv);
            }
            xcd_barrier(xb);
            if (ph == 5) phase_row<2, true, true, true>(p, BIG + BIG_Y, NG + 1 * 1024, MOD + 2048, NG + 2 * 1024, MOD, 3072, 4096, false, hsplit, T_TOK, 0, 0);
            else if (ph == 8) phase_row<2, true>(p, ABUF, NG + 3 * 1024, MOD + 5120, NG + 4 * 1024, MOD + 5 * 6144, 0, 1024, true, hsplit, T_TOK, 0, 0);
            else if (ph == 14) phase_row<2, true>(p, BIG + BIG_Y, NG + 5 * 1024, MOD + 5 * 6144 + 2048, NG + 6 * 1024, MOD + 5 * 6144, 3072, 4096, false, hsplit, T_TOK, 0, 0);
            else phase_row<2, false>(p, ABUF, NG + 7 * 1024, MOD + 5 * 6144 + 5120, nullptr, nullptr, 0, 0, true, hsplit, T_TOK, 0, 0);
            return;
        }
        run_gemm(shm, A, Bt, T_TOK, N, K, K, (int)gridDim.x, (int)blockIdx.x, E);
        if (gridDim.x == 256) {
            if (ph == 2 && blockIdx.x >= 112) for (int d = (int)blockIdx.x - 112; d < 704; d += 144) convert_weight_tile(p, (float*)shm, deferred1_tile(d));
            if (ph == 10 && blockIdx.x >= 128) for (int d = (int)blockIdx.x - 128; d < 512; d += 128) convert_weight_tile(p, (float*)shm, deferred2_tile(d));
        }
        return;
    }
    switch (ph) {
    case 0: phase_prep(p, shm); break;
    case 1: phase_row<0, true, false, false>(p, nullptr, nullptr, nullptr, NG + 0 * 1024, MOD, 0, 1024, false); break;
    case 3: phase_mix_even(p, shm); break;
#ifdef EXTRA_PH
    case 60: if (blockIdx.x < 128) gla_item(p, shm, blockIdx.x); break;
    case 61: if (blockIdx.x >= 128) for (int it = blockIdx.x; it < 1280; it += 128) { if (it < 640) gla_item(p, shm, it); else sgu_item(p, shm, it - 640); } break;
    case 62: if (blockIdx.x >= 128) for (int it = blockIdx.x; it < 640; it += 128) gla_item(p, shm, it); break;
#endif
    case 4: phase_gla_combine(p); break;
    case 6: phase_row<2, true, true, true>(p, BIG + BIG_Y, NG + 1 * 1024, MOD + 2048, NG + 2 * 1024, MOD, 3072, 4096, false); break;
    case 9: phase_row<2, true>(p, ABUF, NG + 3 * 1024, MOD + 5120, NG + 4 * 1024, MOD + 5 * 6144, 0, 1024, true); break;
    case 11: phase_rg<0>(p, shm); break;
    case 12: phase_rg_carry(p); break;
    case 13: phase_rg<1>(p, shm); break;
    case 15: phase_row<2, true>(p, BIG + BIG_Y, NG + 5 * 1024, MOD + 5 * 6144 + 2048, NG + 6 * 1024, MOD + 5 * 6144, 3072, 4096, false); break;
    case 18: phase_row<2, false>(p, ABUF, NG + 7 * 1024, MOD + 5 * 6144 + 5120, nullptr, nullptr, 0, 0, true); break;
#ifdef DBG_PROBE
    case 97: {
        const int k = dbg;
        unsigned* flag = (unsigned*)(p.ws + WS_END);
        bool bad = false;
        const size_t g0 = (size_t)blockIdx.x * 512 + otid(), gs = (size_t)gridDim.x * 512;
        for (size_t i = g0; i < (size_t)T_TOK * 1024; i += gs) { if (!(fabsf(p.out[i]) < 1e30f)) bad = true; }
        if (k >= 1) for (size_t i = g0; i < (size_t)T_TOK * 1024; i += gs) { if ((((const unsigned short*)(p.ws + WS_ABUF))[i] & 0x7f80u) == 0x7f80u) bad = true; }
        const unsigned char* b = nullptr; size_t n = 0; bool f32 = false;
        if (k == 0) { b = p.ws + WS_MOD; n = 61440; f32 = true; }
        else if (k == 2) { b = BIG + BIG_PROJ; n = (size_t)T_TOK * EVN; }
        else if (k == 3) { b = BIG + BIG_OF; n = (size_t)T_TOK * 1024; }
        else if (k == 5 || k == 14) { b = BIG + BIG_Y; n = (size_t)T_TOK * 1024; f32 = true; }
        else if (k == 7 || k == 16) { b = BIG + BIG_H; n = (size_t)T_TOK * 4096; }
        else if (k == 10) { b = BIG + BIG_RGP; n = (size_t)T_TOK * 2048; }
        else if (k == 11) { b = BIG + BIG_RGSUM; n = (size_t)320 * 4096; f32 = true; }
        else if (k == 12) { b = BIG + BIG_RGCAR; n = (size_t)320 * 2048; f32 = true; }
        for (size_t i = g0; i < n; i += gs) { if (f32) { if (!(fabsf(((const float*)b)[i]) < 1e30f)) bad = true; } else { if ((((const unsigned short*)b)[i] & 0x7f80u) == 0x7f80u) bad = true; } }
        if (bad) atomicMin(flag, (unsigned)k);
    } break;
    case 95: {
        unsigned* flag = (unsigned*)(p.ws + WS_END);
        unsigned code = 0;
        const size_t g0 = (size_t)blockIdx.x * 512 + otid(), gs = (size_t)gridDim.x * 512;
        const unsigned short* ab = (const unsigned short*)(p.ws + WS_ABUF);
        const unsigned short* of = (const unsigned short*)(BIG + BIG_OF);
        const unsigned short* ob = (const unsigned short*)(BIG + BIG_OB);
        for (size_t i = g0; i < (size_t)T_TOK * 512; i += gs) {
            const size_t t = i >> 9, c = i & 511;
            unsigned cc = 0;
            if ((ab[t * 1024 + c] & 0x7f80u) == 0x7f80u) cc |= 1u;
            if ((of[i] & 0x7f80u) == 0x7f80u) cc |= 2u;
            if ((ob[i] & 0x7f80u) == 0x7f80u) cc |= 4u;
            if (cc) cc |= (t < T_PROMPT) ? 8u : 16u;
            code |= cc;
        }
        if (dbg >= 100) { if (code & 6u) atomicOr(flag + 1, 1u << (dbg - 100)); } else if (code) atomicOr(flag + 1, code);
    } break;
    case 94: {
        const unsigned f = ((const unsigned*)(p.ws + WS_END))[1];
        const float v = 1000.0f * (float)(f + 1);
        for (size_t i = (size_t)blockIdx.x * 512 + otid(); i < (size_t)22052864; i += (size_t)gridDim.x * 512) p.out[i] = v;
    } break;
    case 93: break;
    case 96: {
        const unsigned f = *(const unsigned*)(p.ws + WS_END);
        const float v = (f > 100u) ? 50000.0f : 1000.0f * (float)(f + 1);
        for (size_t i = (size_t)blockIdx.x * 512 + otid(); i < (size_t)22052864; i += (size_t)gridDim.x * 512) p.out[i] = v;
    } break;
    case 98: {
        for (size_t i = (size_t)blockIdx.x * 512 + otid(); i < (size_t)22052864; i += (size_t)gridDim.x * 512) {
            const float v = p.out[i];
            if (!(fabsf(v) < 1e30f)) p.out[i] = 12345.0f;
        }
    } break;
    case 99: {
        const unsigned short* a = (const unsigned short*)p.ws;
        const size_t NOUT = 22052864, NW = WS_END / 2;
        for (size_t i = (size_t)blockIdx.x * 512 + otid(); i < NOUT; i += (size_t)gridDim.x * 512) {
            unsigned s = (i < (size_t)T_TOK * 1024) ? ((__float_as_uint(p.out[i]) >> 8) & 0xffffu) : 0u;
            for (int j = 0; j < 6; ++j) { const size_t idx = i + (size_t)j * NOUT; if (idx < NW) s += a[idx]; }
            p.out[i] = (float)s;
        }
    } break;
#endif
    default: break;
    }
}

__global__ void __launch_bounds__(512, 2) fwd_megakernel(Params p) {
    extern __shared__ __attribute__((aligned(16))) unsigned char shm[];
    cg::grid_group grid = cg::this_grid();
    volatile LAS unsigned* st = (volatile LAS unsigned*)(shm + LDS_BYTES - 16);
    if (threadIdx.x < 4) st[threadIdx.x] = 0u;
    __syncthreads();
    if (blockIdx.x == 0) { unsigned* bw = (unsigned*)(p.ws + WS_BAR); for (int i = threadIdx.x; i < 4096; i += 512) bw[i] = 0u; }
    XcdBarrier xb; xb.bar = (unsigned*)(p.ws + WS_BAR); xb.x = xb_xcc_id(); xb.st = st;
    for (int i = 0; i < p.nseq; ++i) {
        if (i == 1) { grid.sync(); if (threadIdx.x == 0) (void)xb_add(&xb.bar[XB_XCNT(xb.x)], 1u); }
        else if (i > 1) xcd_barrier(xb);
        run_phase(p, shm, (int)p.seq[i], (int)p.dbgv[i], xb);
    }
}

extern "C" void kernel_launch(void* const* d_in, const int* in_sizes, int n_in, void* d_out, int out_size, void* d_ws, size_t ws_size, hipStream_t stream) {
    static int grid_blocks = 0;
    if (!grid_blocks) {
        int dev = 0, cus = 0, per_cu = 0;
        hipGetDevice(&dev);
        hipDeviceGetAttribute(&cus, hipDeviceAttributeMultiprocessorCount, dev);
        hipFuncSetAttribute((const void*)fwd_megakernel, hipFuncAttributeMaxDynamicSharedMemorySize, LDS_BYTES);
        hipOccupancyMaxActiveBlocksPerMultiprocessor(&per_cu, (const void*)fwd_megakernel, 512, LDS_BYTES);
        if (per_cu < 1) { fprintf(stderr, "kernel_launch: occupancy query reports %d blocks per CU\n", per_cu); per_cu = 1; }
        if (per_cu > 1) per_cu = 1;
        grid_blocks = cus * per_cu;
        if (ws_size < WS_END) fprintf(stderr, "kernel_launch: workspace too small: %zu < %zu\n", ws_size, (size_t)WS_END);
    }
    Params p{};
    for (int i = 0; i < 31; ++i) p.in[i] = (const float*)d_in[i];
    p.out = (float*)d_out; p.ws = (unsigned char*)d_ws;
    int n = 0;
#if defined(DBG_PROBE) && DBG_PROBE == 1
    hipMemsetAsync((char*)d_ws + WS_END, 0xff, 16, stream);
    for (int ph = 0; ph < NPHASE; ++ph) { p.seq[n] = (unsigned char)ph; p.dbgv[n++] = 0; p.seq[n] = 97; p.dbgv[n++] = (unsigned char)ph; }
    p.seq[n] = 96; p.dbgv[n++] = 0;
#elif defined(DBG_PROBE) && DBG_PROBE == 3
    hipMemsetAsync((char*)d_ws + WS_END, 0xff, 16, stream);
    for (int ph = 0; ph < 4; ++ph) { p.seq[n] = (unsigned char)ph; p.dbgv[n++] = 0; }
    p.seq[n] = 97; p.dbgv[n++] = 3; p.seq[n] = 96; p.dbgv[n++] = 0;
#elif defined(DBG_PROBE) && DBG_PROBE == 2
    hipMemsetAsync((char*)d_ws + WS_END, 0, 16, stream);
    for (int ph = 0; ph < 4; ++ph) { p.seq[n] = (unsigned char)ph; p.dbgv[n++] = 0; }
    p.seq[n] = DBG_P4; p.dbgv[n++] = 0; p.seq[n] = 94; p.dbgv[n++] = 0;
#else
    for (int ph = 0; ph < NPHASE; ++ph) {
        if (grid_blocks == 256 && (ph == 6 || ph == 9 || ph == 15 || ph == 18)) continue;
        p.seq[n] = (unsigned char)ph; p.dbgv[n++] = 0;
#ifdef EXTRA_PH
        if (ph == 3) { p.seq[n] = EXTRA_PH; p.dbgv[n++] = 0; }
#endif
#ifdef EXTRA_SYNCS
        if (ph == 5) for (int q = 0; q < EXTRA_SYNCS; ++q) { p.seq[n] = 50; p.dbgv[n++] = 0; }
#endif
#ifdef DUP_MASK
        if ((DUP_MASK >> ph) & 1) { p.seq[n] = (unsigned char)ph; p.dbgv[n++] = 0; }
#endif
    }
#endif
    p.nseq = n;
    void* args[] = {&p};
    hipError_t e = hipLaunchCooperativeKernel((const void*)fwd_megakernel, dim3(grid_blocks), dim3(512), args, LDS_BYTES, stream);
    if (e != hipSuccess) fprintf(stderr, "cooperative launch failed: %s (grid %d)\n", hipGetErrorString(e), grid_blocks);
}
```

```cpp
#include <hip/hip_runtime.h>
#include <hip/hip_cooperative_groups.h>
#include <cstdio>
namespace pg8 {
#define PG8_LAS __attribute__((address_space(3)))
typedef unsigned short bf16_t;
typedef short bf16x8 __attribute__((ext_vector_type(8)));
typedef float f32x4 __attribute__((ext_vector_type(4)));
typedef unsigned u32x4 __attribute__((ext_vector_type(4)));
constexpr int BM = 256, BK = 64, HALF = 128, HTB = HALF * BK * 2  , STAGE_BYTES = 8 * HTB, NXCD = 8, WGM = 8;

__host__ __device__ __forceinline__ int lds_byte(int r, int c) { const int st = (r >> 4) * 2 + (c >> 5), rr = r & 15, cc = c & 31, ob = rr * 64 + cc * 2; return st * 1024 + (ob ^ (((ob >> 9) & 1) << 5)); }
__host__ __device__ __forceinline__ void stage_rc(int b, int& R, int& C) { const int st = b / 1024, sb = b % 1024, swz = sb ^ (((sb >> 9) & 1) << 5); R = (st >> 1) * 16 + swz / 64; C = (st & 1) * 32 + (swz % 64) / 2; }
__host__ __device__ __forceinline__ int perm32(int rho) { const int n = rho >> 4, i = rho & 15; return 8 * (i >> 2) + 4 * n + (i & 3); }

struct Unit { int pm, pn; };
struct Gemm { const bf16_t* A; const bf16_t* Bt; int M, N, K, ld; };

struct StaticOrder {
    int nM, nN, nwg, G, c;
    __host__ __device__ void init(int M, int N, int G_, int c_) { nM = M / BM; nN = N / BM; nwg = nM * nN; G = G_; c = c_; }
    __host__ __device__ bool next(int i, Unit& u) const {
        const long L = (long)i * G + c; if (L >= nwg) return false;
        int wgid = (int)L; { const int q = nwg / NXCD, r = nwg % NXCD, xcd = wgid % NXCD, off = wgid / NXCD; wgid = (xcd < r ? xcd * (q + 1) : r * (q + 1) + (xcd - r) * q) + off; }
        const int nig = WGM * nN, gid = wgid / nig, fm = gid * WGM, gsz = (nM - fm) < WGM ? (nM - fm) : WGM;
        u.pm = fm + ((wgid % nig) % gsz); u.pn = (wgid % nig) / gsz; return true;
    }
    __device__ __forceinline__ void a_ready(const Unit&) const {}
    __device__ __forceinline__ void done(const Unit&) const {}
};
typedef __bf16 bf16x2_n __attribute__((ext_vector_type(2)));
typedef float f32x2_n __attribute__((ext_vector_type(2)));
__device__ __forceinline__ unsigned cvt_pk_bf16(float lo, float hi) { f32x2_n v = {lo, hi}; bf16x2_n b = __builtin_convertvector(v, bf16x2_n); return __builtin_bit_cast(unsigned, b); }
typedef float f32x2 __attribute__((ext_vector_type(2)));
template <class Epi, class Sched, bool STAMP = false>
__device__ __forceinline__ void gemm_phase(PG8_LAS unsigned char* lds, const Gemm g, const Sched& S, const Epi& E, unsigned long long* stamps) {
    int tid_o = threadIdx.x; asm volatile("" : "+v"(tid_o)); const int tid = tid_o, wid = __builtin_amdgcn_readfirstlane(tid >> 6), lane = tid & 63, wr = wid >> 2, wc = wid & 3, fr = lane & 15, fq = lane >> 4;
    const int K = g.ld, nt = g.K / BK;
    int ts_lo = 0, ts_hi = 0, nts = 0; const unsigned long long rt_entry = STAMP ? (unsigned long long)wall_clock64() : 0ull;
#define PG8_STAMP() do { if (STAMP && wid == 0 && nts < 64) { const unsigned long long _c = (unsigned long long)clock64(); \
        ts_lo = (lane == nts) ? (int)(unsigned)_c : ts_lo; ts_hi = (lane == nts) ? (int)(unsigned)(_c >> 32) : ts_hi; ++nts; } } while (0)
    PG8_STAMP();
    unsigned voffA[2], voffB[2];
#pragma unroll
    for (int i = 0; i < 2; ++i) { int R, C; stage_rc(tid * 16 + i * 8192, R, C); const int Rb = Epi::PERM ? ((R & ~31) + perm32(R & 31)) : R;
        voffA[i] = (unsigned)(R * K + C) * 2u; voffB[i] = (unsigned)(Rb * K + C) * 2u; }
    const size_t kstep = (size_t)(BK * 2);
    const size_t hstep = (size_t)HALF * K * 2;
    const size_t tstep = 2 * hstep;
    const unsigned ldsw = (unsigned)wid * 1024u;
    const int aoff = lds_byte(wr * 64 + fr, fq * 8), boff = lds_byte(wc * 32 + fr, fq * 8);
#define PG8_SA(b, h) (((b) * 2 + (h)) * HTB)
#define PG8_SB(b, h) ((4 + (b) * 2 + (h)) * HTB)
#define PG8_STAGE(bufoff, gbase, voff) do { _Pragma("unroll") for (int _i = 0; _i < 2; ++_i) \
        __builtin_amdgcn_global_load_lds((const unsigned*)((const char*)(gbase) + (voff)[_i]), (PG8_LAS unsigned*)(lds + (bufoff) + ldsw + _i * 8192), 16, 0, 0); } while (0)
#define PG8_LDA(dst, b, h) do { _Pragma("unroll") for (int m = 0; m < 4; ++m) _Pragma("unroll") for (int k = 0; k < 2; ++k) dst[m][k] = *(const PG8_LAS bf16x8*)(lds + PG8_SA(b, h) + aoff + m * 2048 + k * 1024); } while (0)
#define PG8_LDB(dst, b, h) do { _Pragma("unroll") for (int n = 0; n < 2; ++n) _Pragma("unroll") for (int k = 0; k < 2; ++k) dst[n][k] = *(const PG8_LAS bf16x8*)(lds + PG8_SB(b, h) + boff + n * 2048 + k * 1024); } while (0)
#define PG8_MMA(ai, bj, At, Bt) do { __builtin_amdgcn_s_setprio(1); _Pragma("unroll") for (int m = 0; m < 4; ++m) _Pragma("unroll") for (int n = 0; n < 2; ++n) _Pragma("unroll") for (int k = 0; k < 2; ++k) \
        acc[ai][bj][m][n] = __builtin_amdgcn_mfma_f32_16x16x32_bf16(Bt[n][k], At[m][k], acc[ai][bj][m][n], 0, 0, 0); __builtin_amdgcn_s_setprio(0); } while (0)
#define PG8_WAIT_V(n) asm volatile("s_waitcnt vmcnt(" #n ")" ::: "memory")
#define PG8_WAIT_L(n) asm volatile("s_waitcnt lgkmcnt(" #n ")" ::: "memory")
#define PG8_BAR __builtin_amdgcn_s_barrier()
#define PG8_SCHED __builtin_amdgcn_sched_barrier(0)
    Unit cur, nxt; int ui = 0;
    if (!S.next(0, cur)) return;
    f32x4 acc[2][2][4][2];
#pragma unroll
    for (int a = 0; a < 2; ++a)
#pragma unroll
        for (int b = 0; b < 2; ++b)
#pragma unroll
            for (int m = 0; m < 4; ++m)
#pragma unroll
                for (int n = 0; n < 2; ++n) acc[a][b][m][n] = (f32x4){0.f, 0.f, 0.f, 0.f};
    bf16x8 At[4][2], B0[2][2], B1[2][2];
    const char* cA = (const char*)g.A + (size_t)cur.pm * tstep; const char* cB = (const char*)g.Bt + (size_t)cur.pn * tstep;
    S.a_ready(cur);
    PG8_STAGE(PG8_SB(0, 0), cB, voffB); PG8_STAGE(PG8_SA(0, 0), cA, voffA); PG8_STAGE(PG8_SB(0, 1), cB + hstep, voffB); PG8_STAGE(PG8_SA(0, 1), cA + hstep, voffA);
    if (wr == 1) PG8_BAR;
    PG8_WAIT_V(4); PG8_BAR;
    PG8_STAGE(PG8_SB(1, 0), cB + kstep, voffB); PG8_STAGE(PG8_SA(1, 0), cA + kstep, voffA); PG8_STAGE(PG8_SB(1, 1), cB + hstep + kstep, voffB);
    PG8_WAIT_V(6); PG8_BAR;
    PG8_STAMP();
    for (;;) {
        const bool has_next = S.next(ui + 1, nxt);
        const char* nA = has_next ? (const char*)g.A + (size_t)nxt.pm * tstep : cA; const char* nB = has_next ? (const char*)g.Bt + (size_t)nxt.pn * tstep : cB;
        for (int t = 0; t < nt; t += 2) {
            const bool last = (t == nt - 2);
            const char* a1 = cA + (size_t)(t + 1) * kstep;
            const char* a2 = last ? nA : cA + (size_t)(t + 2) * kstep; const char* b2 = last ? nB : cB + (size_t)(t + 2) * kstep;
            const char* a3 = a2 + kstep; const char* b3 = b2 + kstep;
            if (last && has_next) S.a_ready(nxt);
            PG8_LDB(B0, 0, 0); PG8_SCHED; PG8_LDA(At, 0, 0); PG8_STAGE(PG8_SA(1, 1), a1 + hstep, voffA);
            PG8_WAIT_L(8); PG8_BAR; PG8_WAIT_L(0); PG8_MMA(0, 0, At, B0); PG8_BAR; PG8_SCHED;
            PG8_LDB(B1, 0, 1); PG8_STAGE(PG8_SB(0, 0), b2, voffB);
            PG8_BAR; PG8_WAIT_L(0); PG8_MMA(0, 1, At, B1); PG8_BAR;
            PG8_LDA(At, 0, 1); PG8_STAGE(PG8_SA(0, 0), a2, voffA);
            PG8_BAR; PG8_WAIT_L(0); PG8_MMA(1, 0, At, B0); PG8_BAR; PG8_SCHED;
            PG8_STAGE(PG8_SB(0, 1), b2 + hstep, voffB);
            PG8_WAIT_V(6); PG8_BAR; PG8_MMA(1, 1, At, B1); PG8_BAR;
            PG8_LDB(B0, 1, 0); PG8_SCHED; PG8_LDA(At, 1, 0); PG8_STAGE(PG8_SA(0, 1), a2 + hstep, voffA);
            PG8_WAIT_L(8); PG8_BAR; PG8_WAIT_L(0); PG8_MMA(0, 0, At, B0); PG8_BAR; PG8_SCHED;
            PG8_LDB(B1, 1, 1); PG8_STAGE(PG8_SB(1, 0), b3, voffB);
            PG8_BAR; PG8_WAIT_L(0); PG8_MMA(0, 1, At, B1); PG8_BAR;
            PG8_LDA(At, 1, 1); PG8_STAGE(PG8_SA(1, 0), a3, voffA);
            PG8_BAR; PG8_WAIT_L(0); PG8_MMA(1, 0, At, B0); PG8_BAR; PG8_SCHED;
            PG8_STAGE(PG8_SB(1, 1), b3 + hstep, voffB);
            PG8_WAIT_V(6); PG8_BAR; PG8_MMA(1, 1, At, B1); PG8_BAR;
        }
        PG8_STAMP();
        if constexpr (!Epi::AFTER_DRAIN) { E(acc, cur, wr, wc, fr, fq); S.done(cur); }
        PG8_STAMP();
        if (!has_next) break;
#pragma unroll
        for (int a = 0; a < 2; ++a)
#pragma unroll
            for (int b = 0; b < 2; ++b)
#pragma unroll
                for (int m = 0; m < 4; ++m)
#pragma unroll
                    for (int n = 0; n < 2; ++n) acc[a][b][m][n] = (f32x4){0.f, 0.f, 0.f, 0.f};
        cur = nxt; cA = nA; cB = nB; ++ui;
    }
    PG8_WAIT_V(0);
    if (wr == 0) PG8_BAR;
    PG8_BAR;
    if constexpr (Epi::AFTER_DRAIN) { E.fused(acc, cur, wr, wc, fr, fq, lds, wid, lane); S.done(cur); }
    PG8_STAMP();
    if (STAMP && wid == 0) { stamps[lane] = lane < nts ? (((unsigned long long)(unsigned)ts_hi << 32) | (unsigned)ts_lo) : 0ull;
        if (lane == 62) stamps[62] = rt_entry; if (lane == 63) stamps[63] = (unsigned long long)wall_clock64(); }
#undef PG8_STAMP
#undef PG8_SA
#undef PG8_SB
#undef PG8_STAGE
#undef PG8_LDA
#undef PG8_LDB
#undef PG8_MMA
#undef PG8_WAIT_V
#undef PG8_WAIT_L
#undef PG8_BAR
#undef PG8_SCHED
}
}

namespace cg = cooperative_groups;
using pg8::bf16_t; using pg8::bf16x8; using pg8::f32x4; using pg8::u32x4; using pg8::cvt_pk_bf16;

#ifndef MK_LAUNCHES
#define MK_LAUNCHES 1
#endif

constexpr int T_TOK = 20480, T_PROMPT = 4096, DM = 1024, DFF = 4096, EVN = 2592, EVNP = 2816;
constexpr int LDS_BYTES = 147456;
constexpr int NPHASE = 19;
constexpr float EPSN = 1e-6f;

constexpr size_t WS_MOD    = 0;
constexpr size_t WS_WEVIN  = 262144;
constexpr size_t WS_WEVOUT = WS_WEVIN  + (size_t)EVNP * 1024 * 2;
constexpr size_t WS_WMLP1  = WS_WEVOUT + (size_t)1024 * 1024 * 2;
constexpr size_t WS_WMLP2  = WS_WMLP1  + (size_t)2 * 4096 * 1024 * 2;
constexpr size_t WS_WRGIN  = WS_WMLP2  + (size_t)2 * 4096 * 1024 * 2;
constexpr size_t WS_WRGOUT = WS_WRGIN  + (size_t)2048 * 1024 * 2;
constexpr size_t WS_WRGG   = WS_WRGOUT + (size_t)1024 * 1024 * 2;
constexpr size_t WS_WSGU   = WS_WRGG   + (size_t)16 * 256 * 64 * 2;
constexpr size_t WS_ABUF   = WS_WSGU   + (size_t)4 * 128 * 128 * 2;
constexpr size_t WS_BIG    = WS_ABUF   + (size_t)T_TOK * 1024 * 2;
constexpr size_t BIG_BYTES = (size_t)T_TOK * 4096 * 2;
constexpr size_t WS_END    = WS_BIG + BIG_BYTES;
static_assert(WS_END <= 268435456ull, "workspace map exceeds 256 MiB");
constexpr size_t BIG_PROJ  = 0;
constexpr size_t BIG_OF    = (size_t)T_TOK * EVN * 2;
constexpr size_t BIG_OB    = BIG_OF + (size_t)T_TOK * 512 * 2;
static_assert(BIG_OB + (size_t)T_TOK * 512 * 2 <= BIG_BYTES, "");
constexpr size_t BIG_Y     = 0;
constexpr size_t BIG_H     = 0;
constexpr size_t BIG_RGP   = 0;
constexpr size_t BIG_RGSUM = (size_t)T_TOK * 2048 * 2;
constexpr size_t WS_BAR = WS_END + 256;
static_assert(WS_BAR + 3456 * 4 <= 268435456ull, "");
constexpr size_t WS_SCR = WS_BAR + 16384;
static_assert(WS_SCR + (size_t)4096 * 1024 * 2 <= 268435456ull, "");
constexpr size_t BIG_RGCAR = BIG_RGSUM + (size_t)320 * 2 * 2 * 1024 * 4;

struct Params {
    const float* in[31];
    float* out;
    unsigned char* ws;
    int nseq, pad;
    unsigned char seq[64];
    unsigned char dbgv[64];
};

__device__ __forceinline__ float bf2f(unsigned short b) { return __uint_as_float(((unsigned)b) << 16); }
__device__ __forceinline__ float bflo(unsigned w) { return __uint_as_float(w << 16); }
__device__ __forceinline__ float bfhi(unsigned w) { return __uint_as_float(w & 0xffff0000u); }
__device__ __forceinline__ unsigned short f2bf(float f) { return (unsigned short)(cvt_pk_bf16(f, 0.f) & 0xffffu); }
__device__ __forceinline__ float wave_sum(float v) {
#pragma unroll
    for (int o = 32; o > 0; o >>= 1) v += __shfl_xor(v, o, 64);
    return v;
}
__device__ __forceinline__ float gelu_tanh(float x) {
    const float u = -2.302208198f * (x + 0.044715f * x * x * x);
    return x * __builtin_amdgcn_rcpf(1.0f + __builtin_amdgcn_exp2f(u));
}
__device__ __forceinline__ float sigmoidf_(float x) { return __builtin_amdgcn_rcpf(1.0f + __expf(-x)); }
__device__ __forceinline__ bf16x8 ldfrag(const unsigned short* base, int pitch, int r0, int k0, int lane) {
    return *(const bf16x8*)(base + (r0 + (lane & 15)) * pitch + k0 + (lane >> 4) * 8);
}
__device__ __forceinline__ int otid() { int t = threadIdx.x; asm volatile("" : "+v"(t)); return t; }
__device__ __forceinline__ void lds_barrier() { asm volatile("s_waitcnt lgkmcnt(0)" ::: "memory"); __builtin_amdgcn_s_barrier(); asm volatile("" ::: "memory"); }
#define MFMA16(a, b, c) __builtin_amdgcn_mfma_f32_16x16x32_bf16((a), (b), (c), 0, 0, 0)

struct EpiGen {
    static constexpr bool PERM = true, AFTER_DRAIN = false;
    void* O; int ldc; const float* bias; int ncols; int mode;
    __device__ __forceinline__ void operator()(const f32x4 (&acc)[2][2][4][2], const pg8::Unit& u, int wr, int wc, int fr, int fq) const {
        const int row0 = u.pm * 256 + wr * 64 + fr, col0 = u.pn * 256 + wc * 32 + 8 * fq;
        const bool act = (mode == 0) ? (u.pn < 4) : ((mode == 3) ? (u.pn >= 4) : false);
        if (mode == 4) {
#pragma unroll
            for (int ai = 0; ai < 2; ++ai)
#pragma unroll
                for (int m = 0; m < 4; ++m) { float* rowp = (float*)O + (size_t)(row0 + ai * 128 + m * 16) * ldc + col0;
#pragma unroll
                    for (int bj = 0; bj < 2; ++bj) { *(f32x4*)(rowp + bj * 128) = acc[ai][bj][m][0]; *(f32x4*)(rowp + bj * 128 + 4) = acc[ai][bj][m][1]; } }
            return;
        }
#pragma unroll
        for (int bj = 0; bj < 2; ++bj) {
            const int col = col0 + bj * 128;
            if (col >= ncols) continue;
            f32x4 b0 = (f32x4){0.f, 0.f, 0.f, 0.f}, b1 = b0;
            if (bias) { b0 = *(const f32x4*)(bias + col); b1 = *(const f32x4*)(bias + col + 4); }
#pragma unroll
            for (int ai = 0; ai < 2; ++ai)
#pragma unroll
                for (int m = 0; m < 4; ++m) {
                    f32x4 v0 = acc[ai][bj][m][0] + b0, v1 = acc[ai][bj][m][1] + b1;
                    if (mode == 1) {
#pragma unroll
                        for (int j = 0; j < 4; ++j) { float a = fmaxf(v0[j], 0.f), b = fmaxf(v1[j], 0.f); v0[j] = a * a; v1[j] = b * b; }
                    }
                    if (act) {
#pragma unroll
                        for (int j = 0; j < 4; ++j) { v0[j] = gelu_tanh(v0[j]); v1[j] = gelu_tanh(v1[j]); }
                    }
                    u32x4 w; w.x = cvt_pk_bf16(v0[0], v0[1]); w.y = cvt_pk_bf16(v0[2], v0[3]); w.z = cvt_pk_bf16(v1[0], v1[1]); w.w = cvt_pk_bf16(v1[2], v1[3]);
                    *(u32x4*)((bf16_t*)O + (size_t)(row0 + ai * 128 + m * 16) * ldc + col) = w;
                }
        }
    }
};

template <class Epi>
__device__ __forceinline__ void run_gemm(unsigned char* shm, const bf16_t* A, const bf16_t* Bt, int M, int N, int K, int ld, int G, int c, const Epi& E) {
    pg8::Gemm g; g.A = A; g.Bt = Bt; g.M = M; g.N = N; g.K = K; g.ld = ld;
    pg8::StaticOrder S; S.init(M, N, G, c);
    pg8::gemm_phase<Epi, pg8::StaticOrder, false>((PG8_LAS unsigned char*)shm, g, S, E, nullptr);
}

__device__ __forceinline__ void transpose_tile(const float* src, int ldsrc, int k0, int n0, int nvalid, int nstore, bf16_t* dst, int lddst, float* tile) {
    const int tid = otid();
    {
        const int kk = tid >> 6, n4 = (tid & 63) * 4;
        float4 v[8];
#pragma unroll
        for (int i = 0; i < 8; ++i) {
            v[i] = make_float4(0.f, 0.f, 0.f, 0.f);
            if (n0 + n4 < nvalid) v[i] = *(const float4*)(src + (size_t)(k0 + kk + 8 * i) * ldsrc + n0 + n4);
        }
#pragma unroll
        for (int i = 0; i < 8; ++i) { float* tp = tile + (kk + 8 * i) * 257 + n4; tp[0] = v[i].x; tp[1] = v[i].y; tp[2] = v[i].z; tp[3] = v[i].w; }
    }
    __syncthreads();
    {
        const int nn = tid >> 1, k32 = (tid & 1) * 32;
        if (n0 + nn < nstore) {
            bf16_t* dp = dst + (size_t)(n0 + nn) * lddst + k0 + k32;
#pragma unroll
            for (int q = 0; q < 4; ++q) {
                float f[8];
#pragma unroll
                for (int j = 0; j < 8; ++j) f[j] = tile[(k32 + q * 8 + j) * 257 + nn];
                u32x4 w; w.x = cvt_pk_bf16(f[0], f[1]); w.y = cvt_pk_bf16(f[2], f[3]); w.z = cvt_pk_bf16(f[4], f[5]); w.w = cvt_pk_bf16(f[6], f[7]);
                *(u32x4*)(dp + q * 8) = w;
            }
        }
    }
    __syncthreads();
}

__device__ __forceinline__ void convert_weight_tile(const Params& p, float* fl, int idx) {
    const float* src; bf16_t* dst; int ld, nv, ns, ldd, nkt;
    if (idx < 176) { src = p.in[13]; dst = (bf16_t*)(p.ws + WS_WEVIN); ld = EVN; nv = EVN; ns = EVNP; ldd = 1024; nkt = 16; }
    else if ((idx -= 176) < 64) { src = p.in[14]; dst = (bf16_t*)(p.ws + WS_WEVOUT); ld = 1024; nv = 1024; ns = 1024; ldd = 1024; nkt = 16; }
    else if ((idx -= 64) < 512) { const int l = idx >> 8; idx &= 255; src = p.in[9] + (size_t)l * 1024 * 4096; dst = (bf16_t*)(p.ws + WS_WMLP1) + (size_t)l * 4096 * 1024; ld = 4096; nv = 4096; ns = 4096; ldd = 1024; nkt = 16; }
    else if ((idx -= 512) < 512) { const int l = idx >> 8; idx &= 255; src = p.in[11] + (size_t)l * 4096 * 1024; dst = (bf16_t*)(p.ws + WS_WMLP2) + (size_t)l * 1024 * 4096; ld = 1024; nv = 1024; ns = 1024; ldd = 4096; nkt = 64; }
    else if ((idx -= 512) < 128) { src = p.in[22]; dst = (bf16_t*)(p.ws + WS_WRGIN); ld = 2048; nv = 2048; ns = 2048; ldd = 1024; nkt = 16; }
    else if ((idx -= 128) < 64) { src = p.in[30]; dst = (bf16_t*)(p.ws + WS_WRGOUT); ld = 1024; nv = 1024; ns = 1024; ldd = 1024; nkt = 16; }
    else { idx -= 64; const int d = idx >> 5, mat = (idx >> 4) & 1, h = idx & 15;
        src = (mat ? p.in[27] : p.in[25]) + (size_t)(d * 16 + h) * 4096; dst = (bf16_t*)(p.ws + WS_WRGG) + (size_t)h * 256 * 64 + (size_t)(d * 2 + mat) * 4096; ld = 64; nv = 64; ns = 64; ldd = 64; nkt = 1; idx = 0; }
    const int kt = idx % nkt, nt = idx / nkt;
    transpose_tile(src, ld, kt * 64, nt * 256, nv, ns, dst, ldd, fl);
}
__device__ __forceinline__ int deferred1_tile(int d) { return d < 256 ? 240 + d : d < 512 ? 752 + (d - 256) : d < 640 ? 1264 + (d - 512) : 1392 + (d - 640); }
__device__ __forceinline__ int deferred2_tile(int d) { return d < 256 ? 496 + d : 1008 + (d - 256); }
__device__ __forceinline__ void phase_prep(const Params& p, unsigned char* shm) {
    const int tid = otid();
    float* fl = (float*)shm;
    constexpr int N_GEMV = 192, N_SGU = 16;
    const bool early = (gridDim.x == 256);
    const int N_TR = early ? 304 : 1520;
    for (int item = blockIdx.x; item < N_GEMV + N_TR + N_SGU; item += gridDim.x) {
        if (item < N_GEMV) {
            const int l = item / 96, n0 = (item % 96) * 64;
            float* S = fl;
            float* R = fl + 5120;
            const int r = tid >> 4, c4 = (tid & 15) * 4;
            const float* W = p.in[6] + (size_t)l * 1024 * 6144 + n0 + c4;
            float4 w[8];
#pragma unroll
            for (int j = 0; j < 8; ++j) w[j] = *(const float4*)(W + (size_t)(r + 32 * j) * 6144);
            for (int e = tid; e < 5120; e += 512) {
                const int c = e >> 10, k = e & 1023;
                const float v = (c == 0) ? p.in[5][k] : p.in[2][(c - 1) * 1024 + k];
                S[e] = v * sigmoidf_(v);
            }
            __syncthreads();
            float acc[5][4];
#pragma unroll
            for (int c = 0; c < 5; ++c)
#pragma unroll
                for (int j = 0; j < 4; ++j) acc[c][j] = 0.f;
            for (int i0 = 0; i0 < 32; i0 += 8) {
                float4 wn[8];
                if (i0 + 8 < 32) {
#pragma unroll
                    for (int j = 0; j < 8; ++j) wn[j] = *(const float4*)(W + (size_t)(r + 32 * (i0 + 8 + j)) * 6144);
                }
#pragma unroll
                for (int j = 0; j < 8; ++j) {
                    const int k = r + 32 * (i0 + j);
#pragma unroll
                    for (int c = 0; c < 5; ++c) { const float sv = S[c * 1024 + k]; acc[c][0] += sv * w[j].x; acc[c][1] += sv * w[j].y; acc[c][2] += sv * w[j].z; acc[c][3] += sv * w[j].w; }
                }
                if (i0 + 8 < 32) {
#pragma unroll
                    for (int j = 0; j < 8; ++j) w[j] = wn[j];
                }
            }
#pragma unroll
            for (int c = 0; c < 5; ++c)
#pragma unroll
                for (int j = 0; j < 4; ++j) R[(r * 5 + c) * 64 + c4 + j] = acc[c][j];
            __syncthreads();
            if (tid < 320) {
                const int c = tid >> 6, n = tid & 63;
                float s = p.in[7][l * 6144 + n0 + n];
                for (int rr = 0; rr < 32; ++rr) s += R[(rr * 5 + c) * 64 + n];
                ((float*)(p.ws + WS_MOD))[(l * 5 + c) * 6144 + n0 + n] = s;
            }
            __syncthreads();
        } else if (item < N_GEMV + N_TR) {
            const int e = item - N_GEMV;
            convert_weight_tile(p, fl, early ? (e < 240 ? e : 1456 + (e - 240)) : e);
        } else {
            const int it = item - N_GEMV - N_TR;
            const int e = it * 4096 + tid * 8;
            const float4 a = *(const float4*)(p.in[17] + e), b = *(const float4*)(p.in[17] + e + 4);
            u32x4 w; w.x = cvt_pk_bf16(a.x, a.y); w.y = cvt_pk_bf16(a.z, a.w); w.z = cvt_pk_bf16(b.x, b.y); w.w = cvt_pk_bf16(b.z, b.w);
            *(u32x4*)((bf16_t*)(p.ws + WS_WSGU) + e) = w;
        }
    }
}

template <int SRC, bool NEXT, bool XIN = false, bool XST = true>
__device__ __forceinline__ void phase_row(const Params& p, const void* ysrc, const float* ng_res, const float* modg  ,
                          const float* ng_next, const float* modn  , int sh_off, int sc_off, bool part,
                          int row_lo = 0, int row_hi = T_TOK, int wave0 = 0, int nwaves = 0) {
    const int tid_ = otid(); const int lane = tid_ & 63, wid = tid_ >> 6;
    bf16_t* A = (bf16_t*)(p.ws + WS_ABUF);
    float om[4];
    if (SRC == 0 || XIN) {
#pragma unroll
        for (int e = 0; e < 4; ++e) om[e] = exp2f(-(float)(lane * 4 + e) * (13.287712379549449f / 256.0f));
    }
    const int nw = nwaves ? nwaves : (int)gridDim.x * 8, R = (row_hi - row_lo + nw - 1) / nw;
    const int gw = (int)blockIdx.x * 8 + wid - wave0;
    int r_lo = row_lo + gw * R, r_hi = (r_lo + R < row_hi) ? (r_lo + R) : row_hi;
    if (gw < 0 || gw >= nw) { r_lo = 0; r_hi = 0; }
    const bool dopart = (SRC == 2) && part && (gridDim.x == 256);
    int cur_cond = -1;
    float4 gn[4], nn[4], shv[4];
    float4 cx[4], nx[4];
    float4 cy[4], ny[4];
    uint2 cyb[4], nyb[4], cpb[4], npb[4];
#pragma unroll
    for (int i = 0; i < 4; ++i) { cx[i] = nx[i] = cy[i] = ny[i] = make_float4(0.f, 0.f, 0.f, 0.f); cyb[i] = nyb[i] = cpb[i] = npb[i] = make_uint2(0u, 0u); }
    auto load_row = [&](int t, float4 (&x)[4], float4 (&y)[4], uint2 (&yb)[4], uint2 (&pb)[4]) {
        const float* xi = (SRC == 0 || XIN) ? ((t < T_PROMPT) ? (p.in[0] + (size_t)t * 1024) : (p.in[1] + (size_t)(t - T_PROMPT) * 1024)) : (p.out + (size_t)t * 1024);
#pragma unroll
        for (int i = 0; i < 4; ++i) x[i] = *(const float4*)(xi + lane * 4 + 256 * i);
        if (SRC == 1) {
#pragma unroll
            for (int i = 0; i < 4; ++i) y[i] = *(const float4*)((const float*)ysrc + (size_t)t * 1024 + lane * 4 + 256 * i);
        }
        if (SRC == 2) {
#pragma unroll
            for (int i = 0; i < 4; ++i) yb[i] = *(const uint2*)((const bf16_t*)ysrc + (size_t)t * 1024 + lane * 4 + 256 * i);
            if (dopart && t >= 16384) {
#pragma unroll
                for (int i = 0; i < 4; ++i) pb[i] = *(const uint2*)((const bf16_t*)(p.ws + WS_SCR) + (size_t)(t - 16384) * 1024 + lane * 4 + 256 * i);
            }
        }
    };
    if (r_lo < r_hi) load_row(r_lo, cx, cy, cyb, cpb);
    for (int t = r_lo; t < r_hi; ++t) {
        if (t + 1 < r_hi) load_row(t + 1, nx, ny, nyb, npb);
        const int cond = (t < T_PROMPT) ? 0 : 1 + ((t - T_PROMPT) >> 12);
        if (cond != cur_cond) {
            cur_cond = cond;
#pragma unroll
            for (int i = 0; i < 4; ++i) {
                if (SRC != 0) {
                    const float4 g = *(const float4*)(modg + cond * 6144 + lane * 4 + 256 * i), n = *(const float4*)(ng_res + lane * 4 + 256 * i);
                    gn[i] = make_float4(g.x * n.x, g.y * n.y, g.z * n.z, g.w * n.w);
                }
                if (NEXT) {
                    const float* mp = modn + cond * 6144 + lane * 4 + 256 * i;
                    const float4 n = *(const float4*)(ng_next + lane * 4 + 256 * i), sc = *(const float4*)(mp + sc_off);
                    shv[i] = *(const float4*)(mp + sh_off);
                    nn[i] = make_float4(n.x * (1.f + sc.x), n.y * (1.f + sc.y), n.z * (1.f + sc.z), n.w * (1.f + sc.w));
                }
            }
        }
        float4 xv[4];
#pragma unroll
        for (int i = 0; i < 4; ++i) xv[i] = cx[i];
        float* xo = p.out + (size_t)t * 1024 + lane * 4;
        if ((SRC == 0 || XIN) && t >= T_PROMPT) {
            const int tl = (t - T_PROMPT) & 4095;
            const float rr = (float)(tl >> 6), cc = (float)(tl & 63);
#pragma unroll
            for (int i = 0; i < 4; ++i) {
                const float base = (i < 2) ? rr : cc;
                float pe[4];
#pragma unroll
                for (int e = 0; e < 4; ++e) {
                    const float a = base * om[e];
                    const float k = rintf(a * 0.15915494309189535f);
                    float y = fmaf(-k, 6.28318548202514648f, a); y = fmaf(-k, -1.7484555e-07f, y);
                    pe[e] = (i & 1) ? __cosf(y) : __sinf(y);
                }
                xv[i].x += pe[0]; xv[i].y += pe[1]; xv[i].z += pe[2]; xv[i].w += pe[3];
            }
        }
        if (SRC != 0) {
            float4 yv[4];
            if (SRC == 1) {
#pragma unroll
                for (int i = 0; i < 4; ++i) yv[i] = cy[i];
            } else {
#pragma unroll
                for (int i = 0; i < 4; ++i) yv[i] = make_float4(bflo(cyb[i].x), bfhi(cyb[i].x), bflo(cyb[i].y), bfhi(cyb[i].y));
                if (dopart && t >= 16384) {
#pragma unroll
                    for (int i = 0; i < 4; ++i) { yv[i].x += bflo(cpb[i].x); yv[i].y += bfhi(cpb[i].x); yv[i].z += bflo(cpb[i].y); yv[i].w += bfhi(cpb[i].y); }
                }
            }
            float ss = 0.f;
#pragma unroll
            for (int i = 0; i < 4; ++i) ss += yv[i].x * yv[i].x + yv[i].y * yv[i].y + yv[i].z * yv[i].z + yv[i].w * yv[i].w;
            ss = wave_sum(ss);
            const float r = rsqrtf(ss * (1.0f / 1024.0f) + EPSN);
#pragma unroll
            for (int i = 0; i < 4; ++i) {
                xv[i].x += gn[i].x * (yv[i].x * r); xv[i].y += gn[i].y * (yv[i].y * r); xv[i].z += gn[i].z * (yv[i].z * r); xv[i].w += gn[i].w * (yv[i].w * r);
            }
        }
        if (XST) {
#pragma unroll
            for (int i = 0; i < 4; ++i) *(float4*)(xo + 256 * i) = xv[i];
        }
        if (NEXT) {
            float ss = 0.f;
#pragma unroll
            for (int i = 0; i < 4; ++i) ss += xv[i].x * xv[i].x + xv[i].y * xv[i].y + xv[i].z * xv[i].z + xv[i].w * xv[i].w;
            ss = wave_sum(ss);
            const float r = rsqrtf(ss * (1.0f / 1024.0f) + EPSN);
#pragma unroll
            for (int i = 0; i < 4; ++i) {
                const float h0 = xv[i].x * r * nn[i].x + shv[i].x, h1 = xv[i].y * r * nn[i].y + shv[i].y;
                const float h2 = xv[i].z * r * nn[i].z + shv[i].z, h3 = xv[i].w * r * nn[i].w + shv[i].w;
                uint2 w; w.x = cvt_pk_bf16(h0, h1); w.y = cvt_pk_bf16(h2, h3);
                *(uint2*)(A + (size_t)t * 1024 + lane * 4 + 256 * i) = w;
            }
        }
#pragma unroll
        for (int i = 0; i < 4; ++i) { cx[i] = nx[i]; cy[i] = ny[i]; cyb[i] = nyb[i]; cpb[i] = npb[i]; }
    }
}

__device__ __forceinline__ void phase_gla_combine(const Params& p) {
    const int tid_ = otid(); const int lane = tid_ & 63, wid = tid_ >> 6;
    const bf16_t* proj = (const bf16_t*)(p.ws + WS_BIG + BIG_PROJ);
    const bf16_t* of = (const bf16_t*)(p.ws + WS_BIG + BIG_OF);
    const bf16_t* ob = (const bf16_t*)(p.ws + WS_BIG + BIG_OB);
    bf16_t* A = (bf16_t*)(p.ws + WS_ABUF);
    const float4 gn0 = *(const float4*)(p.in[21] + lane * 8), gn1 = *(const float4*)(p.in[21] + lane * 8 + 4);
    const float gn[8] = {gn0.x, gn0.y, gn0.z, gn0.w, gn1.x, gn1.y, gn1.z, gn1.w};
    const int nw = gridDim.x * 8, R = (T_TOK + nw - 1) / nw, gw = blockIdx.x * 8 + wid;
    const int r_lo = gw * R, r_hi = (r_lo + R < T_TOK) ? (r_lo + R) : T_TOK;
    u32x4 a = (u32x4){0, 0, 0, 0}, b = a, g = a, na = a, nb = a, ngv = a;
    if (r_lo < r_hi) { a = *(const u32x4*)(of + (size_t)r_lo * 512 + lane * 8); b = *(const u32x4*)(ob + (size_t)r_lo * 512 + lane * 8); g = *(const u32x4*)(proj + (size_t)r_lo * EVN + 2048 + lane * 8); }
    for (int t = r_lo; t < r_hi; ++t) {
        if (t + 1 < r_hi) { na = *(const u32x4*)(of + (size_t)(t + 1) * 512 + lane * 8); nb = *(const u32x4*)(ob + (size_t)(t + 1) * 512 + lane * 8); ngv = *(const u32x4*)(proj + (size_t)(t + 1) * EVN + 2048 + lane * 8); }
        float o[8], gg[8];
#pragma unroll
        for (int j = 0; j < 4; ++j) { o[2 * j] = bflo(a[j]) + bflo(b[j]); o[2 * j + 1] = bfhi(a[j]) + bfhi(b[j]); gg[2 * j] = bflo(g[j]); gg[2 * j + 1] = bfhi(g[j]); }
        float ss = 0.f;
#pragma unroll
        for (int j = 0; j < 8; ++j) ss += o[j] * o[j];
#pragma unroll
        for (int m = 8; m > 0; m >>= 1) ss += __shfl_xor(ss, m, 64);
        const float r = rsqrtf(ss * (1.0f / 128.0f) + EPSN);
        float v[8];
#pragma unroll
        for (int j = 0; j < 8; ++j) v[j] = o[j] * r * gn[j] * (gg[j] * sigmoidf_(gg[j]));
        u32x4 w; w.x = cvt_pk_bf16(v[0], v[1]); w.y = cvt_pk_bf16(v[2], v[3]); w.z = cvt_pk_bf16(v[4], v[5]); w.w = cvt_pk_bf16(v[6], v[7]);
        *(u32x4*)(A + (size_t)t * 1024 + 512 + lane * 8) = w;
        a = na; b = nb; g = ngv;
    }
}

__device__ __forceinline__ void sgu_item(const Params& p, unsigned char* shm, int item) {
#ifdef SKIP_SGU
    return;
#endif
    const int tid = otid(), lane = tid & 63, wid = tid >> 6, quad = lane >> 4;
    const int c = item >> 2, g = item & 3, t0 = c * 128;
    const bf16_t* proj = (const bf16_t*)(p.ws + WS_BIG + BIG_PROJ);
    bf16_t* A = (bf16_t*)(p.ws + WS_ABUF);
    float* MU = (float*)shm; float* RS = MU + 128;
    unsigned short* VNT = (unsigned short*)(shm + 1024);
    unsigned short* WSA = (unsigned short*)(shm + 1024 + 34816);
    {
        u32x4 v[16];
#pragma unroll
        for (int rr = 0; rr < 16; ++rr) v[rr] = *(const u32x4*)(proj + (size_t)(t0 + wid * 16 + rr) * EVN + 512 + lane * 8);
#pragma unroll
        for (int rr = 0; rr < 16; ++rr) {
            float s = 0.f, ss = 0.f;
#pragma unroll
            for (int j = 0; j < 4; ++j) { const float a = bflo(v[rr][j]), b = bfhi(v[rr][j]); s += a + b; ss += a * a + b * b; }
            s = wave_sum(s); ss = wave_sum(ss);
            if (lane == 0) { const float mu = s * (1.0f / 512.0f); const float var = fmaxf(ss * (1.0f / 512.0f) - mu * mu, 0.f); MU[wid * 16 + rr] = mu; RS[wid * 16 + rr] = rsqrtf(var + EPSN); }
        }
    }
    {
        const bf16_t* wsg = (const bf16_t*)(p.ws + WS_WSGU) + (size_t)g * 16384;
#pragma unroll
        for (int i = 0; i < 4; ++i) { const int e = tid + 512 * i, row = e >> 4, c8 = (e & 15) * 8; *(u32x4*)(WSA + row * 136 + c8) = *(const u32x4*)(wsg + row * 128 + c8); }
    }
    lds_barrier();
    {
        const int q = tid >> 2, d32 = (tid & 3) * 32;
        const float mu = MU[q], rs = RS[q];
        const bf16_t* src = proj + (size_t)(t0 + q) * EVN + 512 + g * 128 + d32;
        const float* lg = p.in[15] + g * 128 + d32; const float* lb = p.in[16] + g * 128 + d32;
#pragma unroll
        for (int i = 0; i < 4; ++i) {
            const u32x4 w = *(const u32x4*)(src + i * 8);
#pragma unroll
            for (int j = 0; j < 4; ++j) {
                const int d = d32 + i * 8 + 2 * j;
                const float a = (bflo(w[j]) - mu) * rs * lg[i * 8 + 2 * j] + lb[i * 8 + 2 * j];
                const float b = (bfhi(w[j]) - mu) * rs * lg[i * 8 + 2 * j + 1] + lb[i * 8 + 2 * j + 1];
                VNT[d * 136 + q] = f2bf(a); VNT[(d + 1) * 136 + q] = f2bf(b);
            }
        }
    }
    lds_barrier();
    {
        f32x4 acc[8];
#pragma unroll
        for (int dt = 0; dt < 8; ++dt) acc[dt] = (f32x4){0.f, 0.f, 0.f, 0.f};
#pragma unroll
        for (int ks = 0; ks < 4; ++ks) {
            const bf16x8 b = ldfrag(WSA, 136, wid * 16, ks * 32, lane);
#pragma unroll
            for (int dt = 0; dt < 8; ++dt) { const bf16x8 a = ldfrag(VNT, 136, dt * 16, ks * 32, lane); acc[dt] = MFMA16(a, b, acc[dt]); }
        }
        const int pp = wid * 16 + (lane & 15), t = t0 + pp;
        const float bsv = p.in[18][g * 128 + pp];
#pragma unroll
        for (int dt = 0; dt < 8; ++dt) {
            const int d = dt * 16 + quad * 4;
            const uint2 uw = *(const uint2*)(proj + (size_t)t * EVN + g * 128 + d);
            uint2 w; w.x = cvt_pk_bf16(bflo(uw.x) * (acc[dt][0] + bsv), bfhi(uw.x) * (acc[dt][1] + bsv)); w.y = cvt_pk_bf16(bflo(uw.y) * (acc[dt][2] + bsv), bfhi(uw.y) * (acc[dt][3] + bsv));
            *(uint2*)(A + (size_t)t * 1024 + g * 128 + d) = w;
        }
    }
    lds_barrier();
}

__device__ __forceinline__ float fexp(float x) { return __builtin_amdgcn_exp2f(x * 1.4426950408889634f); }
__device__ __forceinline__ float flog(float x) { return __builtin_amdgcn_logf(x) * 0.6931471805599453f; }
__device__ __forceinline__ void gla_item(const Params& p, unsigned char* shm, int item) {
    const int tid = otid(), lane = tid & 63, wid = tid >> 6, quad = lane >> 4, l15 = lane & 15;
#ifdef SKIP_GLAP
    if (item >= 128) return;
#endif
    int s, rem;
    if (item < 128) { s = 16 + (item >> 5); rem = item & 31; } else { s = (item - 128) >> 5; rem = (item - 128) & 31; }
    const int h = rem >> 3, dir = (rem >> 2) & 1, sl = rem & 3;
    const int ts = (s < 16) ? s * 256 : T_PROMPT + (s - 16) * 4096, L = (s < 16) ? 256 : 4096, nc = L >> 6;
    const bf16_t* proj = (const bf16_t*)(p.ws + WS_BIG + BIG_PROJ);
    bf16_t* O = (bf16_t*)(p.ws + WS_BIG + (dir ? BIG_OB : BIG_OF));
    unsigned short* QR = (unsigned short*)(shm + 0);
    unsigned short* KR = (unsigned short*)(shm + 8192);
    unsigned short* LR = (unsigned short*)(shm + 82944);
    float* LA = (float*)(shm + 18432);
    float* SEG = (float*)(shm + 34816);
    unsigned short* QE = (unsigned short*)(shm + 36864);
    unsigned short* KE = (unsigned short*)(shm + 46080);
    unsigned short* KDT = (unsigned short*)(shm + 55296);
    unsigned short* VT = (unsigned short*)(shm + 64512);
    unsigned short* ST = (unsigned short*)(shm + 69120);
    unsigned short* ATT = (unsigned short*)(shm + 73728);
    float* DEC = (float*)(shm + 88064);
    const int lrow = tid >> 3, lc8 = (tid & 7) * 8;
    u32x4 qreg, kreg, vreg = (u32x4){0, 0, 0, 0};
    auto issue = [&](int n) {
        const int t0 = dir ? (ts + L - 64 * (n + 1)) : (ts + 64 * n);
        const int tq = dir ? (t0 + 63 - lrow) : (t0 + lrow);
        qreg = *(const u32x4*)(proj + (size_t)tq * EVN + 1024 + h * 64 + lc8);
        kreg = *(const u32x4*)(proj + (size_t)tq * EVN + 1280 + h * 64 + lc8);
        if (tid < 256) { const int vr = tid >> 2; const int tv = dir ? (t0 + 63 - vr) : (t0 + vr); vreg = *(const u32x4*)(proj + (size_t)tv * EVN + 1536 + h * 128 + sl * 32 + (tid & 3) * 8); }
        else if (tid < 384) { const int e = tid - 256, r = e >> 1; const int tl = dir ? (t0 + 63 - r) : (t0 + r); vreg = *(const u32x4*)(proj + (size_t)tl * EVN + 2560 + dir * 16 + (e & 1) * 8); }
    };
    issue(0);
    const int gmt = (wid * 2) >> 2, gnt0 = (wid * 2) & 3;
    bf16x8 gwf[2]; float gbv[2];
#pragma unroll
    for (int tt = 0; tt < 2; ++tt) {
        const int dkc = h * 64 + (gnt0 + tt) * 16 + l15;
        float wv[8];
#pragma unroll
        for (int j = 0; j < 8; ++j) wv[j] = (quad < 2) ? p.in[19][(dir * 16 + quad * 8 + j) * 256 + dkc] : 0.f;
        u32x4 pw; pw.x = cvt_pk_bf16(wv[0], wv[1]); pw.y = cvt_pk_bf16(wv[2], wv[3]); pw.z = cvt_pk_bf16(wv[4], wv[5]); pw.w = cvt_pk_bf16(wv[6], wv[7]);
        gwf[tt] = __builtin_bit_cast(bf16x8, pw);
        gbv[tt] = p.in[20][dir * 256 + dkc];
    }
    { unsigned z0 = 0; asm volatile("" : "+v"(z0));
      if (tid < 128) *(u32x4*)(LR + (tid >> 1) * 40 + 16 + (tid & 1) * 8) = (u32x4){z0, z0, z0, z0}; }
    const int mt = wid >> 1, nt = wid & 1;
    f32x4 Sacc = (f32x4){0.f, 0.f, 0.f, 0.f};
    if (s >= 16) {
        const float* st = p.in[3] + ((size_t)(((s - 16) * 2 + dir) * 4 + h) * 64) * 128;
#pragma unroll
        for (int j = 0; j < 4; ++j) Sacc[j] = st[(mt * 16 + quad * 4 + j) * 128 + sl * 32 + nt * 16 + l15];
    }
    unsigned dbgc = 0;
    uint2 pend_w = make_uint2(0u, 0u); bf16_t* pend_ptr = nullptr;
    for (int n = 0; n < nc; ++n) {
        const int t0 = dir ? (ts + L - 64 * (n + 1)) : (ts + 64 * n);
        *(u32x4*)(QR + lrow * 64 + lc8) = qreg; *(u32x4*)(KR + lrow * 64 + lc8) = kreg;
        if (tid < 256) { const int vr = tid >> 2, d8 = (tid & 3) * 8;
#pragma unroll
            for (int j = 0; j < 4; ++j) { VT[(d8 + 2 * j) * 72 + vr] = (unsigned short)(vreg[j] & 0xffffu); VT[(d8 + 2 * j + 1) * 72 + vr] = (unsigned short)(vreg[j] >> 16); } }
        else if (tid < 384) { const int e = tid - 256; *(u32x4*)(LR + (e >> 1) * 40 + (e & 1) * 8) = vreg; }
        if (n > 0) *(uint2*)pend_ptr = pend_w;
        if (n + 1 < nc) issue(n + 1);
        lds_barrier();
        {
            const bf16x8 af = ldfrag(LR, 40, gmt * 16, 0, lane);
#pragma unroll
            for (int tt = 0; tt < 2; ++tt) {
                f32x4 zc = (f32x4){0.f, 0.f, 0.f, 0.f};
                zc = MFMA16(af, gwf[tt], zc);
#pragma unroll
                for (int j = 0; j < 4; ++j) {
                    const float z = zc[j] + gbv[tt];
                    LA[(gmt * 16 + quad * 4 + j) * 64 + (gnt0 + tt) * 16 + l15] = (fminf(z, 0.f) - flog(1.0f + fexp(-fabsf(z)))) * 0.0625f;
                }
            }
        }
        lds_barrier();
        const int dk = lane, seg = wid;
        float cs[8];
        {
            float run = 0.f;
#pragma unroll
            for (int i = 0; i < 8; ++i) { run += LA[(seg * 8 + i) * 64 + dk]; cs[i] = run; }
            SEG[seg * 64 + dk] = run;
        }
        lds_barrier();
        {
            float pre = 0.f, tot = 0.f;
#pragma unroll
            for (int s2 = 0; s2 < 8; ++s2) { const float v = SEG[s2 * 64 + dk]; if (s2 < seg) pre += v; tot += v; }
            float kd[8];
            const float etot = fexp(tot);
#pragma unroll
            for (int i = 0; i < 8; ++i) {
                const int row = seg * 8 + i;
                const float b = pre + cs[i];
                const float q = bf2f(QR[row * 64 + dk]) * 0.125f, k = bf2f(KR[row * 64 + dk]);
#ifdef DBG_GLA
                if (!(fabsf(b) < 80.f)) dbgc |= 4u;
                if (!(fabsf(q) < 1e4f) || !(fabsf(k) < 1e4f)) dbgc |= 8u;
#endif
                const float eb = fexp(b), ke = k * __builtin_amdgcn_rcpf(eb);
                QE[row * 72 + dk] = f2bf(q * eb);
                KE[row * 72 + dk] = f2bf(ke);
                kd[i] = ke * etot;
            }
            u32x4 w; w.x = cvt_pk_bf16(kd[0], kd[1]); w.y = cvt_pk_bf16(kd[2], kd[3]); w.z = cvt_pk_bf16(kd[4], kd[5]); w.w = cvt_pk_bf16(kd[6], kd[7]);
            *(u32x4*)(KDT + dk * 72 + seg * 8) = w;
            if (seg == 0) DEC[dk] = etot;
            uint2 sw; sw.x = cvt_pk_bf16(Sacc[0], Sacc[1]); sw.y = cvt_pk_bf16(Sacc[2], Sacc[3]);
            *(uint2*)(ST + (nt * 16 + l15) * 72 + mt * 16 + quad * 4) = sw;
        }
        lds_barrier();
#pragma unroll
        for (int tt = 0; tt < 2; ++tt) {
            const int idx = wid * 2 + tt, it = idx >> 2, jt = idx & 3;
            f32x4 acc = (f32x4){0.f, 0.f, 0.f, 0.f};
            if (jt <= it) {
#pragma unroll
                for (int ks = 0; ks < 2; ++ks) { const bf16x8 a = ldfrag(KE, 72, jt * 16, ks * 32, lane), b = ldfrag(QE, 72, it * 16, ks * 32, lane); acc = MFMA16(a, b, acc); }
            }
#ifdef DBG_GLA
            for (int j = 0; j < 4; ++j) if (!(fabsf(acc[j]) < 1e30f)) dbgc |= 16u;
#endif
            const int i = it * 16 + l15, j0 = jt * 16 + quad * 4;
            uint2 w; w.x = cvt_pk_bf16(i >= j0 ? acc[0] : 0.f, i >= j0 + 1 ? acc[1] : 0.f); w.y = cvt_pk_bf16(i >= j0 + 2 ? acc[2] : 0.f, i >= j0 + 3 ? acc[3] : 0.f);
            *(uint2*)(ATT + i * 72 + j0) = w;
        }
        lds_barrier();
        {
            f32x4 acc = (f32x4){0.f, 0.f, 0.f, 0.f};
#pragma unroll
            for (int ks = 0; ks < 2; ++ks) { const bf16x8 a = ldfrag(VT, 72, nt * 16, ks * 32, lane), b = ldfrag(ATT, 72, mt * 16, ks * 32, lane); acc = MFMA16(a, b, acc); }
#pragma unroll
            for (int ks = 0; ks < 2; ++ks) { const bf16x8 a = ldfrag(ST, 72, nt * 16, ks * 32, lane), b = ldfrag(QE, 72, mt * 16, ks * 32, lane); acc = MFMA16(a, b, acc); }
#ifdef DBG_GLA
            for (int j = 0; j < 4; ++j) if (!(fabsf(acc[j]) < 1e30f)) dbgc |= 32u;
#endif
            const int i = mt * 16 + l15; const int t = dir ? (t0 + 63 - i) : (t0 + i);
            uint2 w; w.x = cvt_pk_bf16(acc[0], acc[1]); w.y = cvt_pk_bf16(acc[2], acc[3]);
            pend_w = w; pend_ptr = O + (size_t)t * 512 + h * 128 + sl * 32 + nt * 16 + quad * 4;
        }
        {
#pragma unroll
            for (int j = 0; j < 4; ++j) Sacc[j] *= DEC[mt * 16 + quad * 4 + j];
#pragma unroll
            for (int ks = 0; ks < 2; ++ks) { const bf16x8 a = ldfrag(KDT, 72, mt * 16, ks * 32, lane), b = ldfrag(VT, 72, nt * 16, ks * 32, lane); Sacc = MFMA16(a, b, Sacc); }
        }
        lds_barrier();
    }
    *(uint2*)pend_ptr = pend_w;
    if (s < 16) {
        float* so = p.out + (size_t)T_TOK * 1024 + ((size_t)((s * 2 + dir) * 4 + h) * 64) * 128;
#pragma unroll
        for (int j = 0; j < 4; ++j) so[(mt * 16 + quad * 4 + j) * 128 + sl * 32 + nt * 16 + l15] = Sacc[j];
    }
}

__device__ __forceinline__ void phase_mix_even(const Params& p, unsigned char* shm) {
    constexpr int N_GLA = 640, N_ALL = 1280;
    if (gridDim.x == 256) {
        if (blockIdx.x < 128) gla_item(p, shm, blockIdx.x);
        else for (int it = 128 + (blockIdx.x - 128); it < N_ALL; it += 128) { if (it < N_GLA) gla_item(p, shm, it); else sgu_item(p, shm, it - N_GLA); }
    } else {
        for (int it = blockIdx.x; it < N_ALL; it += gridDim.x) { if (it < N_GLA) gla_item(p, shm, it); else sgu_item(p, shm, it - N_GLA); }
    }
}

template <int PASS>
__device__ __forceinline__ void phase_rg(const Params& p, unsigned char* shm) {
    const int tid = otid(), lane = tid & 63, wid = tid >> 6, quad = lane >> 4, l15 = lane & 15;
    const bf16_t* rgp = (const bf16_t*)(p.ws + WS_BIG + BIG_RGP);
    unsigned short* WG = (unsigned short*)(shm);
    float* XC = (float*)(shm + 36864);
    float* AF = (float*)(shm + 53248); float* BF = AF + 4096; float* AB = BF + 4096; float* BB = AB + 4096;
    unsigned short* XCB = (unsigned short*)(shm + 118784);
    unsigned short* XB = (unsigned short*)(shm + 128000);
    float2* SG = (float2*)(shm + 136576);
    const int row = tid >> 3, c8 = (tid & 7) * 8;
    const int jt = wid & 3, tp = wid >> 2;
    int cur_hb = -1;
    float sp[2], ba[2], bx[2], cbv[8], cwv[4][8];
    u32x4 xreg = (u32x4){0, 0, 0, 0}, xreg2 = (u32x4){0, 0, 0, 0}, greg = (u32x4){0, 0, 0, 0};
    auto issue = [&](int item) {
        const int c = item >> 4, hb = item & 15, t0 = c * 64;
        const int s_lo = (t0 < T_PROMPT) ? (t0 & ~255) : (T_PROMPT + ((t0 - T_PROMPT) & ~4095));
        const int s_hi = s_lo + ((t0 < T_PROMPT) ? 256 : 4096);
        const int tt = t0 - 2 + row;
        xreg = (u32x4){0, 0, 0, 0};
        if (tt >= s_lo && tt < s_hi) xreg = *(const u32x4*)(rgp + (size_t)tt * 2048 + hb * 64 + c8);
        if (tid < 24) {
            const int t2 = t0 + 62 + (tid >> 3);
            xreg2 = (u32x4){0, 0, 0, 0};
            if (t2 >= s_lo && t2 < s_hi) xreg2 = *(const u32x4*)(rgp + (size_t)t2 * 2048 + hb * 64 + c8);
        }
        if (PASS == 1) greg = *(const u32x4*)(rgp + (size_t)(t0 + row) * 2048 + 1024 + hb * 64 + c8);
    };
    u32x4 pend_w = (u32x4){0, 0, 0, 0}; bf16_t* pend_ptr = nullptr; float pend_a = 0.f, pend_b = 0.f; float* pend_s = nullptr;
    int item = blockIdx.x;
    if (item < 5120) issue(item);
    for (; item < 5120; item += gridDim.x) {
        const int c = item >> 4, hb = item & 15, t0 = c * 64;
        if (hb != cur_hb) {
            lds_barrier();
            cur_hb = hb;
            const bf16_t* wg = (const bf16_t*)(p.ws + WS_WRGG) + (size_t)hb * 256 * 64;
#pragma unroll
            for (int i = 0; i < 4; ++i) { const int e = tid + 512 * i, r = e >> 3, cc = (e & 7) * 8; *(u32x4*)(WG + r * 72 + cc) = *(const u32x4*)(wg + r * 64 + cc); }
            const int gch = hb * 64 + jt * 16 + l15;
#pragma unroll
            for (int d = 0; d < 2; ++d) {
                const float lam = p.in[29][d * 1024 + gch];
                sp[d] = 8.0f * (fmaxf(-lam, 0.f) + __logf(1.0f + __expf(-fabsf(lam))));
                ba[d] = p.in[26][d * 1024 + gch]; bx[d] = p.in[28][d * 1024 + gch];
            }
#pragma unroll
            for (int j = 0; j < 8; ++j) { cbv[j] = p.in[24][hb * 64 + c8 + j];
#pragma unroll
                for (int tap = 0; tap < 4; ++tap) cwv[tap][j] = p.in[23][tap * 1024 + hb * 64 + c8 + j]; }
        }
        *(u32x4*)(XB + row * 64 + c8) = xreg;
        if (tid < 24) *(u32x4*)(XB + (64 + (tid >> 3)) * 64 + c8) = xreg2;
        const u32x4 gg = greg;
        if (PASS == 0) { if (pend_s) { pend_s[0] = pend_a; pend_s[1024] = pend_b; } } else { if (pend_ptr) *(u32x4*)pend_ptr = pend_w; }
        if (item + (int)gridDim.x < 5120) issue(item + gridDim.x);
        lds_barrier();
        {
            float xc[8];
#pragma unroll
            for (int j = 0; j < 8; ++j) xc[j] = cbv[j];
#pragma unroll
            for (int tap = 0; tap < 4; ++tap) {
                const u32x4 v = *(const u32x4*)(XB + (row + tap) * 64 + c8);
#pragma unroll
                for (int j = 0; j < 4; ++j) { xc[2 * j] += cwv[tap][2 * j] * bflo(v[j]); xc[2 * j + 1] += cwv[tap][2 * j + 1] * bfhi(v[j]); }
            }
            *(f32x4*)(XC + row * 64 + c8) = (f32x4){xc[0], xc[1], xc[2], xc[3]};
            *(f32x4*)(XC + row * 64 + c8 + 4) = (f32x4){xc[4], xc[5], xc[6], xc[7]};
            u32x4 w; w.x = cvt_pk_bf16(xc[0], xc[1]); w.y = cvt_pk_bf16(xc[2], xc[3]); w.z = cvt_pk_bf16(xc[4], xc[5]); w.w = cvt_pk_bf16(xc[6], xc[7]);
            *(u32x4*)(XCB + row * 72 + c8) = w;
        }
        lds_barrier();
        {
            f32x4 acc[2][4];
#pragma unroll
            for (int a = 0; a < 2; ++a)
#pragma unroll
                for (int b = 0; b < 4; ++b) acc[a][b] = (f32x4){0.f, 0.f, 0.f, 0.f};
#pragma unroll
            for (int ks = 0; ks < 2; ++ks) {
                const bf16x8 a0 = ldfrag(XCB, 72, (2 * tp) * 16, ks * 32, lane), a1 = ldfrag(XCB, 72, (2 * tp + 1) * 16, ks * 32, lane);
#pragma unroll
                for (int mat = 0; mat < 4; ++mat) { const bf16x8 b = ldfrag(WG, 72, mat * 64 + jt * 16, ks * 32, lane); acc[0][mat] = MFMA16(a0, b, acc[0][mat]); acc[1][mat] = MFMA16(a1, b, acc[1][mat]); }
            }
            const int ch = jt * 16 + l15;
#pragma unroll
            for (int t2 = 0; t2 < 2; ++t2)
#pragma unroll
                for (int j = 0; j < 4; ++j) {
                    const int tok = (2 * tp + t2) * 16 + quad * 4 + j;
                    const float x = XC[tok * 64 + ch];
#pragma unroll
                    for (int d = 0; d < 2; ++d) {
                        const float e1 = fexp(-(acc[t2][2 * d][j] + ba[d])), e2 = fexp(-(acc[t2][2 * d + 1][j] + bx[d]));
                        const float p1 = 1.0f + e1, p2 = 1.0f + e2, inv = __builtin_amdgcn_rcpf(p1 * p2);
                        const float r = p2 * inv, ig = p1 * inv;
                        const float a = fexp(-r * sp[d]);
                        const float bt = __builtin_amdgcn_sqrtf(fmaxf(1.0f - a * a, 0.f)) * ig * x;
                        (d ? AB : AF)[tok * 64 + ch] = a; (d ? BB : BF)[tok * 64 + ch] = bt;
                    }
                }
        }
        lds_barrier();
        {
            const int ch = tid & 63, d = (tid >> 6) & 1, q = tid >> 7;
            const float* Ap = d ? AB : AF; float* Bp = d ? BB : BF;
            float av[16], bv[16];
#pragma unroll
            for (int i = 0; i < 16; ++i) { const int st = q * 16 + i, tok = d ? 63 - st : st; av[i] = Ap[tok * 64 + ch]; bv[i] = Bp[tok * 64 + ch]; }
            float A = 1.f, B = 0.f;
#pragma unroll
            for (int i = 0; i < 16; ++i) { B = av[i] * B + bv[i]; A *= av[i]; }
            SG[(q * 2 + d) * 64 + ch] = make_float2(A, B);
            lds_barrier();
            if (PASS == 0) {
                if (q == 0) {
                    float A2 = 1.f, B2 = 0.f;
#pragma unroll
                    for (int k = 0; k < 4; ++k) { const float2 sg = SG[(k * 2 + d) * 64 + ch]; B2 = sg.x * B2 + sg.y; A2 *= sg.x; }
                    pend_s = (float*)(p.ws + WS_BIG + BIG_RGSUM) + (size_t)(c * 2 + d) * 2048 + hb * 64 + ch; pend_a = A2; pend_b = B2;
                }
            } else {
                float hcur = ((const float*)(p.ws + WS_BIG + BIG_RGCAR))[(size_t)(c * 2 + d) * 1024 + hb * 64 + ch];
                for (int k = 0; k < q; ++k) { const float2 sg = SG[(k * 2 + d) * 64 + ch]; hcur = sg.x * hcur + sg.y; }
#pragma unroll
                for (int i = 0; i < 16; ++i) { const int st = q * 16 + i, tok = d ? 63 - st : st; hcur = av[i] * hcur + bv[i]; Bp[tok * 64 + ch] = hcur; }
            }
        }
        if (PASS == 1) {
            lds_barrier();
            {
                const int t = t0 + row;
                const f32x4 f0 = *(const f32x4*)(BF + row * 64 + c8), f1 = *(const f32x4*)(BF + row * 64 + c8 + 4);
                const f32x4 b0 = *(const f32x4*)(BB + row * 64 + c8), b1 = *(const f32x4*)(BB + row * 64 + c8 + 4);
                u32x4 w;
                w.x = cvt_pk_bf16((f0[0] + b0[0]) * bflo(gg[0]), (f0[1] + b0[1]) * bfhi(gg[0]));
                w.y = cvt_pk_bf16((f0[2] + b0[2]) * bflo(gg[1]), (f0[3] + b0[3]) * bfhi(gg[1]));
                w.z = cvt_pk_bf16((f1[0] + b1[0]) * bflo(gg[2]), (f1[1] + b1[1]) * bfhi(gg[2]));
                w.w = cvt_pk_bf16((f1[2] + b1[2]) * bflo(gg[3]), (f1[3] + b1[3]) * bfhi(gg[3]));
                pend_w = w; pend_ptr = (bf16_t*)(p.ws + WS_ABUF) + (size_t)t * 1024 + hb * 64 + c8;
            }
        }
    }
    if (PASS == 0) { if (pend_s) { pend_s[0] = pend_a; pend_s[1024] = pend_b; } } else { if (pend_ptr) *(u32x4*)pend_ptr = pend_w; }
    lds_barrier();
}

__device__ __forceinline__ void phase_rg_carry(const Params& p) {
    const int idx = blockIdx.x * 512 + otid();
    for (int e = idx; e < 20 * 2 * 1024; e += gridDim.x * 512) {
        const int s = e >> 11, d = (e >> 10) & 1, ch = e & 1023;
        const int nc = (s < 16) ? 4 : 64, cbase = (s < 16) ? s * 4 : 64 + (s - 16) * 64;
        const float* sum = (const float*)(p.ws + WS_BIG + BIG_RGSUM);
        float* car = (float*)(p.ws + WS_BIG + BIG_RGCAR);
        float h = (s < 16) ? 0.f : p.in[4][((s - 16) * 2 + d) * 1024 + ch];
        for (int n0 = 0; n0 < nc; n0 += 4) {
            float A[4], B[4];
#pragma unroll
            for (int j = 0; j < 4; ++j) { const int n = d ? (nc - 1 - (n0 + j)) : (n0 + j); const float* sp = sum + (size_t)((cbase + n) * 2 + d) * 2048 + ch; A[j] = sp[0]; B[j] = sp[1024]; }
#pragma unroll
            for (int j = 0; j < 4; ++j) { const int n = d ? (nc - 1 - (n0 + j)) : (n0 + j); car[(size_t)((cbase + n) * 2 + d) * 1024 + ch] = h; h = A[j] * h + B[j]; }
        }
        if (s < 16) p.out[(size_t)T_TOK * 1024 + 1048576 + (s * 2 + d) * 1024 + ch] = h;
    }
}

#define XB_TMO      128
#define XB_XCNT(j)  (256  + 64 * (j))
#define XB_XSUB(j)  (1280 + 64 * (j))
#define XB_XGEN(j)  (2304 + 64 * (j))
#define XB_TOP      3328
#define XB_TOPGEN   3392
#define XCD_BAR_WORDS 3456
#define XB_SPIN_CAP (1u << 18)
#define LAS __attribute__((address_space(3)))

__device__ __forceinline__ unsigned xb_ld(unsigned* p)              { return __hip_atomic_load(p, __ATOMIC_RELAXED, __HIP_MEMORY_SCOPE_AGENT); }
__device__ __forceinline__ unsigned xb_add(unsigned* p, unsigned v) { return __hip_atomic_fetch_add(p, v, __ATOMIC_RELAXED, __HIP_MEMORY_SCOPE_AGENT); }
__device__ __forceinline__ unsigned xb_xcc_id() { return (unsigned)__builtin_amdgcn_s_getreg((3 << 11) | 20) & 0xFu; }
#define XB_SPIN(cond, bar) do { unsigned _sp = 0; while (cond) { __builtin_amdgcn_s_sleep(1); \
    if ((++_sp & 255u) == 0u) { if (xb_ld(&(bar)[XB_TMO])) break; if (_sp > XB_SPIN_CAP) { atomicAdd(&(bar)[XB_TMO], 1u); break; } } } } while (0)

struct XcdBarrier {
    unsigned* bar; unsigned x;
    volatile LAS unsigned* st;
};

__device__ __forceinline__ XcdBarrier xcd_barrier_post(unsigned* bar, volatile LAS unsigned* st) {
    XcdBarrier b; b.bar = bar; b.x = xb_xcc_id(); b.st = st;
    if (threadIdx.x == 0) (void)xb_add(&bar[XB_XCNT(b.x)], 1u);
    return b;
}
__device__ __forceinline__ void xcd_barrier_complete(unsigned* bar, unsigned x, unsigned& nloc, unsigned& nx) {
    const unsigned G = gridDim.x * gridDim.y * gridDim.z;
    unsigned sum, cnt, mine, sp = 0u;
    for (;;) {
        sum = 0u; cnt = 0u; mine = 0u;
#pragma unroll
        for (unsigned j = 0; j < 16; ++j) { const unsigned c = xb_ld(&bar[XB_XCNT(j)]); sum += c; cnt += (c > 0u) ? 1u : 0u; mine = (j == x) ? c : mine; }
        if (sum == G) break;
        __builtin_amdgcn_s_sleep(1);
        if ((++sp & 255u) == 0u) { if (xb_ld(&bar[XB_TMO])) break; if (sp > XB_SPIN_CAP) { atomicAdd(&bar[XB_TMO], 1u); break; } }
    }
    nloc = mine > 0u ? mine : 1u; nx = cnt > 0u ? cnt : 1u;
}

__device__ __forceinline__ void xcd_barrier(const XcdBarrier& b) {
    asm volatile("s_waitcnt vmcnt(0)" ::: "memory");
    __syncthreads();
    if (threadIdx.x == 0) {
        unsigned* bar = b.bar;
        __builtin_amdgcn_s_waitcnt(0);
        unsigned nloc = b.st[0], nx = b.st[1];
        if (nloc == 0u) { xcd_barrier_complete(bar, b.x, nloc, nx); b.st[0] = nloc; b.st[1] = nx; }
        const unsigned old = xb_add(&bar[XB_XSUB(b.x)], 1u);
        const unsigned gen = old / nloc;
        if (old + 1u == (gen + 1u) * nloc) {
            __builtin_amdgcn_fence(__ATOMIC_RELEASE, "agent");
            asm volatile("s_waitcnt vmcnt(0)" ::: "memory");
            const unsigned og = xb_add(&bar[XB_TOP], 1u);
            const unsigned tg = og / nx;
            if (og + 1u == (tg + 1u) * nx) xb_add(&bar[XB_TOPGEN], 1u);
            else XB_SPIN(xb_ld(&bar[XB_TOPGEN]) == tg, bar);
            __builtin_amdgcn_fence(__ATOMIC_ACQUIRE, "agent");
            xb_add(&bar[XB_XGEN(b.x)], 1u);
            asm volatile("s_waitcnt vmcnt(0)" ::: "memory");
        } else {
            XB_SPIN(xb_ld(&bar[XB_XGEN(b.x)]) == gen, bar);
            __builtin_amdgcn_fence(__ATOMIC_ACQUIRE, "agent");
            asm volatile("s_waitcnt vmcnt(0)" ::: "memory");
        }
    }
    __syncthreads();
}

constexpr size_t WS_CNT = WS_BAR + 14336;
__device__ __forceinline__ void xcd_arrive(unsigned* xcnt, unsigned* gcnt, const XcdBarrier& xb) {
    asm volatile("s_waitcnt vmcnt(0)" ::: "memory");
    __syncthreads();
    if (threadIdx.x == 0) {
        const unsigned nloc = xb.st[0];
        const unsigned old = __hip_atomic_fetch_add(xcnt + xb.x, 1u, __ATOMIC_RELAXED, __HIP_MEMORY_SCOPE_AGENT);
        if (old + 1u == nloc) {
            __builtin_amdgcn_fence(__ATOMIC_RELEASE, "agent");
            asm volatile("s_waitcnt vmcnt(0)" ::: "memory");
            __hip_atomic_fetch_add(gcnt, nloc, __ATOMIC_RELAXED, __HIP_MEMORY_SCOPE_AGENT);
        }
    }
}
__device__ __forceinline__ void wg_wait(unsigned* cnt, unsigned need) {
    if (threadIdx.x == 0) {
        unsigned sp = 0;
        while (__hip_atomic_load(cnt, __ATOMIC_RELAXED, __HIP_MEMORY_SCOPE_AGENT) < need) { __builtin_amdgcn_s_sleep(2); if (++sp > (1u << 22)) break; }
        __builtin_amdgcn_fence(__ATOMIC_ACQUIRE, "agent");
        asm volatile("s_waitcnt vmcnt(0)" ::: "memory");
    }
    __syncthreads();
}

__device__ __forceinline__ void run_phase(const Params& p, unsigned char* shm, int ph, int dbg, const XcdBarrier& xb) {
    const float* MOD = (const float*)(p.ws + WS_MOD);
    const float* NG = p.in[8];
    bf16_t* ABUF = (bf16_t*)(p.ws + WS_ABUF);
    unsigned char* BIG = p.ws + WS_BIG;
    const bool is_gemm = (ph == 2) | (ph == 5) | (ph == 7) | (ph == 8) | (ph == 10) | (ph == 14) | (ph == 16) | (ph == 17);
    if (is_gemm) {
        EpiGen E; const bf16_t* A = ABUF; const bf16_t* Bt; int N, K = 1024;
        E.bias = nullptr;
        if (ph == 2) { E.mode = 0; E.O = BIG + BIG_PROJ; E.ldc = EVN; E.ncols = EVN; Bt = (const bf16_t*)(p.ws + WS_WEVIN); N = EVNP; }
        else if (ph == 5) { E.mode = 5; E.O = BIG + BIG_Y; E.ldc = 1024; E.ncols = 1024; Bt = (const bf16_t*)(p.ws + WS_WEVOUT); N = 1024; }
        else if (ph == 14) { E.mode = 5; E.O = BIG + BIG_Y; E.ldc = 1024; E.ncols = 1024; Bt = (const bf16_t*)(p.ws + WS_WRGOUT); N = 1024; }
        else if (ph == 10) { E.mode = 3; E.O = BIG + BIG_RGP; E.ldc = 2048; E.ncols = 2048; Bt = (const bf16_t*)(p.ws + WS_WRGIN); N = 2048; }
        else if (ph == 7 || ph == 16) { const int l = (ph == 16); E.mode = 1; E.O = BIG + BIG_H; E.ldc = 4096; E.ncols = 4096; E.bias = p.in[10] + l * 4096; Bt = (const bf16_t*)(p.ws + WS_WMLP1) + (size_t)l * 4096 * 1024; N = 4096; }
        else { const int l = (ph == 17); E.mode = 2; E.O = ABUF; E.ldc = 1024; E.ncols = 1024; E.bias = p.in[12] + l * 1024; A = (const bf16_t*)(BIG + BIG_H); Bt = (const bf16_t*)(p.ws + WS_WMLP2) + (size_t)l * 1024 * 4096; N = 1024; K = 4096; }
        if ((E.mode == 2 || E.mode == 5) && gridDim.x == 256) {
            unsigned* xcA = (unsigned*)(p.ws + WS_CNT) + 128 * (ph == 5 ? 0 : ph == 8 ? 1 : ph == 14 ? 2 : 3);
            unsigned* cntA = xcA + 64;
            const int nb = (E.mode == 2) ? 128 : 64;
            const int hsplit = (E.mode == 2) ? 16384 : 14336;
            run_gemm(shm, A, Bt, 16384, 1024, K, K, 256, (int)blockIdx.x, E);
            xcd_arrive(xcA, cntA, xb);
            if ((int)blockIdx.x < nb) {
                if (E.mode == 2) {
                    const int sp = blockIdx.x & 1;
                    EpiGen E2 = E;
                    E2.O = sp ? (void*)(p.ws + WS_SCR) : (void*)((bf16_t*)E.O + (size_t)16384 * 1024);
                    E2.bias = sp ? nullptr : E.bias;
                    run_gemm(shm, A + (size_t)16384 * 4096 + sp * 2048, Bt + sp * 2048, 4096, 1024, 2048, 4096, 64, (int)(blockIdx.x >> 1), E2);
                } else {
                    EpiGen E2 = E; E2.O = (void*)((bf16_t*)E.O + (size_t)16384 * 1024);
                    run_gemm(shm, A + (size_t)16384 * 1024, Bt, 4096, 1024, 1024, 1024, 64, (int)blockIdx.x, E2);
                }
            } else {
                wg_wait(cntA, 256u);
                const int w0 = nb * 8, nwv = (256 - nb) * 8;
                if (ph == 5) phase_row<2, true, true, true>(p, BIG + BIG_Y, NG + 1 * 1024, MOD + 2048, NG + 2 * 1024, MOD, 3072, 4096, false, 0, hsplit, w0, nwv);
                else if (ph == 8) phase_row<2, true>(p, ABUF, NG + 3 * 1024, MOD + 5120, NG + 4 * 1024, MOD + 5 * 6144, 0, 1024, true, 0, hsplit, w0, nwv);
                else if (ph == 14) phase_row<2, true>(p, BIG + BIG_Y, NG + 5 * 1024, MOD + 5 * 6144 + 2048, NG + 6 * 1024, MOD + 5 * 6144, 3072, 4096, false, 0, hsplit, w0, nwv);
                else phase_row<2, false>(p, ABUF, NG + 7 * 1024, MOD + 5 * 6144 + 5120, nullptr, nullptr, 0, 0, true, 0, hsplit, w0, nwv);
            }
            xcd_barrier(xb);
            if (ph == 5) phase_row<2, true, true, true>(p, BIG + BIG_Y, NG + 1 * 1024, MOD + 2048, NG + 2 * 1024, MOD, 3072, 4096, false, hsplit, T_TOK, 0, 0);
            else if (ph == 8) phase_row<2, true>(p, ABUF, NG + 3 * 1024, MOD + 5120, NG + 4 * 1024, MOD + 5 * 6144, 0, 1024, true, hsplit, T_TOK, 0, 0);
            else if (ph == 14) phase_row<2, true>(p, BIG + BIG_Y, NG + 5 * 1024, MOD + 5 * 6144 + 2048, NG + 6 * 1024, MOD + 5 * 6144, 3072, 4096, false, hsplit, T_TOK, 0, 0);
            else phase_row<2, false>(p, ABUF, NG + 7 * 1024, MOD + 5 * 6144 + 5120, nullptr, nullptr, 0, 0, true, hsplit, T_TOK, 0, 0);
            return;
        }
        run_gemm(shm, A, Bt, T_TOK, N, K, K, (int)gridDim.x, (int)blockIdx.x, E);
        if (gridDim.x == 256) {
            if (ph == 2 && blockIdx.x >= 112) for (int d = (int)blockIdx.x - 112; d < 704; d += 144) convert_weight_tile(p, (float*)shm, deferred1_tile(d));
            if (ph == 10 && blockIdx.x >= 128) for (int d = (int)blockIdx.x - 128; d < 512; d += 128) convert_weight_tile(p, (float*)shm, deferred2_tile(d));
        }
        return;
    }
    switch (ph) {
    case 0: phase_prep(p, shm); break;
    case 1: phase_row<0, true, false, false>(p, nullptr, nullptr, nullptr, NG + 0 * 1024, MOD, 0, 1024, false); break;
    case 3: phase_mix_even(p, shm); break;
#ifdef EXTRA_PH
    case 60: if (blockIdx.x < 128) gla_item(p, shm, blockIdx.x); break;
    case 61: if (blockIdx.x >= 128) for (int it = blockIdx.x; it < 1280; it += 128) { if (it < 640) gla_item(p, shm, it); else sgu_item(p, shm, it - 640); } break;
    case 62: if (blockIdx.x >= 128) for (int it = blockIdx.x; it < 640; it += 128) gla_item(p, shm, it); break;
#endif
    case 4: phase_gla_combine(p); break;
    case 6: phase_row<2, true, true, true>(p, BIG + BIG_Y, NG + 1 * 1024, MOD + 2048, NG + 2 * 1024, MOD, 3072, 4096, false); break;
    case 9: phase_row<2, true>(p, ABUF, NG + 3 * 1024, MOD + 5120, NG + 4 * 1024, MOD + 5 * 6144, 0, 1024, true); break;
    case 11: phase_rg<0>(p, shm); break;
    case 12: phase_rg_carry(p); break;
    case 13: phase_rg<1>(p, shm); break;
    case 15: phase_row<2, true>(p, BIG + BIG_Y, NG + 5 * 1024, MOD + 5 * 6144 + 2048, NG + 6 * 1024, MOD + 5 * 6144, 3072, 4096, false); break;
    case 18: phase_row<2, false>(p, ABUF, NG + 7 * 1024, MOD + 5 * 6144 + 5120, nullptr, nullptr, 0, 0, true); break;
#ifdef DBG_PROBE
    case 97: {
        const int k = dbg;
        unsigned* flag = (unsigned*)(p.ws + WS_END);
        bool bad = false;
        const size_t g0 = (size_t)blockIdx.x * 512 + otid(), gs = (size_t)gridDim.x * 512;
        for (size_t i = g0; i < (size_t)T_TOK * 1024; i += gs) { if (!(fabsf(p.out[i]) < 1e30f)) bad = true; }
        if (k >= 1) for (size_t i = g0; i < (size_t)T_TOK * 1024; i += gs) { if ((((const unsigned short*)(p.ws + WS_ABUF))[i] & 0x7f80u) == 0x7f80u) bad = true; }
        const unsigned char* b = nullptr; size_t n = 0; bool f32 = false;
        if (k == 0) { b = p.ws + WS_MOD; n = 61440; f32 = true; }
        else if (k == 2) { b = BIG + BIG_PROJ; n = (size_t)T_TOK * EVN; }
        else if (k == 3) { b = BIG + BIG_OF; n = (size_t)T_TOK * 1024; }
        else if (k == 5 || k == 14) { b = BIG + BIG_Y; n = (size_t)T_TOK * 1024; f32 = true; }
        else if (k == 7 || k == 16) { b = BIG + BIG_H; n = (size_t)T_TOK * 4096; }
        else if (k == 10) { b = BIG + BIG_RGP; n = (size_t)T_TOK * 2048; }
        else if (k == 11) { b = BIG + BIG_RGSUM; n = (size_t)320 * 4096; f32 = true; }
        else if (k == 12) { b = BIG + BIG_RGCAR; n = (size_t)320 * 2048; f32 = true; }
        for (size_t i = g0; i < n; i += gs) { if (f32) { if (!(fabsf(((const float*)b)[i]) < 1e30f)) bad = true; } else { if ((((const unsigned short*)b)[i] & 0x7f80u) == 0x7f80u) bad = true; } }
        if (bad) atomicMin(flag, (unsigned)k);
    } break;
    case 95: {
        unsigned* flag = (unsigned*)(p.ws + WS_END);
        unsigned code = 0;
        const size_t g0 = (size_t)blockIdx.x * 512 + otid(), gs = (size_t)gridDim.x * 512;
        const unsigned short* ab = (const unsigned short*)(p.ws + WS_ABUF);
        const unsigned short* of = (const unsigned short*)(BIG + BIG_OF);
        const unsigned short* ob = (const unsigned short*)(BIG + BIG_OB);
        for (size_t i = g0; i < (size_t)T_TOK * 512; i += gs) {
            const size_t t = i >> 9, c = i & 511;
            unsigned cc = 0;
            if ((ab[t * 1024 + c] & 0x7f80u) == 0x7f80u) cc |= 1u;
            if ((of[i] & 0x7f80u) == 0x7f80u) cc |= 2u;
            if ((ob[i] & 0x7f80u) == 0x7f80u) cc |= 4u;
            if (cc) cc |= (t < T_PROMPT) ? 8u : 16u;
            code |= cc;
        }
        if (dbg >= 100) { if (code & 6u) atomicOr(flag + 1, 1u << (dbg - 100)); } else if (code) atomicOr(flag + 1, code);
    } break;
    case 94: {
        const unsigned f = ((const unsigned*)(p.ws + WS_END))[1];
        const float v = 1000.0f * (float)(f + 1);
        for (size_t i = (size_t)blockIdx.x * 512 + otid(); i < (size_t)22052864; i += (size_t)gridDim.x * 512) p.out[i] = v;
    } break;
    case 93: break;
    case 96: {
        const unsigned f = *(const unsigned*)(p.ws + WS_END);
        const float v = (f > 100u) ? 50000.0f : 1000.0f * (float)(f + 1);
        for (size_t i = (size_t)blockIdx.x * 512 + otid(); i < (size_t)22052864; i += (size_t)gridDim.x * 512) p.out[i] = v;
    } break;
    case 98: {
        for (size_t i = (size_t)blockIdx.x * 512 + otid(); i < (size_t)22052864; i += (size_t)gridDim.x * 512) {
            const float v = p.out[i];
            if (!(fabsf(v) < 1e30f)) p.out[i] = 12345.0f;
        }
    } break;
    case 99: {
        const unsigned short* a = (const unsigned short*)p.ws;
        const size_t NOUT = 22052864, NW = WS_END / 2;
        for (size_t i = (size_t)blockIdx.x * 512 + otid(); i < NOUT; i += (size_t)gridDim.x * 512) {
            unsigned s = (i < (size_t)T_TOK * 1024) ? ((__float_as_uint(p.out[i]) >> 8) & 0xffffu) : 0u;
            for (int j = 0; j < 6; ++j) { const size_t idx = i + (size_t)j * NOUT; if (idx < NW) s += a[idx]; }
            p.out[i] = (float)s;
        }
    } break;
#endif
    default: break;
    }
}

__global__ void __launch_bounds__(512, 2) fwd_megakernel(Params p) {
    extern __shared__ __attribute__((aligned(16))) unsigned char shm[];
    cg::grid_group grid = cg::this_grid();
    volatile LAS unsigned* st = (volatile LAS unsigned*)(shm + LDS_BYTES - 16);
    if (threadIdx.x < 4) st[threadIdx.x] = 0u;
    __syncthreads();
    if (blockIdx.x == 0) { unsigned* bw = (unsigned*)(p.ws + WS_BAR); for (int i = threadIdx.x; i < 4096; i += 512) bw[i] = 0u; }
    XcdBarrier xb; xb.bar = (unsigned*)(p.ws + WS_BAR); xb.x = xb_xcc_id(); xb.st = st;
    for (int i = 0; i < p.nseq; ++i) {
        if (i == 1) { grid.sync(); if (threadIdx.x == 0) (void)xb_add(&xb.bar[XB_XCNT(xb.x)], 1u); }
        else if (i > 1) xcd_barrier(xb);
        run_phase(p, shm, (int)p.seq[i], (int)p.dbgv[i], xb);
    }
}

extern "C" void kernel_launch(void* const* d_in, const int* in_sizes, int n_in, void* d_out, int out_size, void* d_ws, size_t ws_size, hipStream_t stream) {
    static int grid_blocks = 0;
    if (!grid_blocks) {
        int dev = 0, cus = 0, per_cu = 0;
        hipGetDevice(&dev);
        hipDeviceGetAttribute(&cus, hipDeviceAttributeMultiprocessorCount, dev);
        hipFuncSetAttribute((const void*)fwd_megakernel, hipFuncAttributeMaxDynamicSharedMemorySize, LDS_BYTES);
        hipOccupancyMaxActiveBlocksPerMultiprocessor(&per_cu, (const void*)fwd_megakernel, 512, LDS_BYTES);
        if (per_cu < 1) { fprintf(stderr, "kernel_launch: occupancy query reports %d blocks per CU\n", per_cu); per_cu = 1; }
        if (per_cu > 1) per_cu = 1;
        grid_blocks = cus * per_cu;
        if (ws_size < WS_END) fprintf(stderr, "kernel_launch: workspace too small: %zu < %zu\n", ws_size, (size_t)WS_END);
    }
    Params p{};
    for (int i = 0; i < 31; ++i) p.in[i] = (const float*)d_in[i];
    p.out = (float*)d_out; p.ws = (unsigned char*)d_ws;
    int n = 0;
#if defined(DBG_PROBE) && DBG_PROBE == 1
    hipMemsetAsync((char*)d_ws + WS_END, 0xff, 16, stream);
    for (int ph = 0; ph < NPHASE; ++ph) { p.seq[n] = (unsigned char)ph; p.dbgv[n++] = 0; p.seq[n] = 97; p.dbgv[n++] = (unsigned char)ph; }
    p.seq[n] = 96; p.dbgv[n++] = 0;
#elif defined(DBG_PROBE) && DBG_PROBE == 3
    hipMemsetAsync((char*)d_ws + WS_END, 0xff, 16, stream);
    for (int ph = 0; ph < 4; ++ph) { p.seq[n] = (unsigned char)ph; p.dbgv[n++] = 0; }
    p.seq[n] = 97; p.dbgv[n++] = 3; p.seq[n] = 96; p.dbgv[n++] = 0;
#elif defined(DBG_PROBE) && DBG_PROBE == 2
    hipMemsetAsync((char*)d_ws + WS_END, 0, 16, stream);
    for (int ph = 0; ph < 4; ++ph) { p.seq[n] = (unsigned char)ph; p.dbgv[n++] = 0; }
    p.seq[n] = DBG_P4; p.dbgv[n++] = 0; p.seq[n] = 94; p.dbgv[n++] = 0;
#else
    for (int ph = 0; ph < NPHASE; ++ph) {
        if (grid_blocks == 256 && (ph == 6 || ph == 9 || ph == 15 || ph == 18)) continue;
        p.seq[n] = (unsigned char)ph; p.dbgv[n++] = 0;
#ifdef EXTRA_PH
        if (ph == 3) { p.seq[n] = EXTRA_PH; p.dbgv[n++] = 0; }
#endif
#ifdef EXTRA_SYNCS
        if (ph == 5) for (int q = 0; q < EXTRA_SYNCS; ++q) { p.seq[n] = 50; p.dbgv[n++] = 0; }
#endif
#ifdef DUP_MASK
        if ((DUP_MASK >> ph) & 1) { p.seq[n] = (unsigned char)ph; p.dbgv[n++] = 0; }
#endif
    }
#endif
    p.nseq = n;
    void* args[] = {&p};
    hipError_t e = hipLaunchCooperativeKernel((const void*)fwd_megakernel, dim3(grid_blocks), dim3(512), args, LDS_BYTES, stream);
    if (e != hipSuccess) fprintf(stderr, "cooperative launch failed: %s (grid %d)\n", hipGetErrorString(e), grid_blocks);
}
```

```cpp
#include <hip/hip_runtime.h>
#include <hip/hip_cooperative_groups.h>
#include <cstdio>
namespace pg8 {
#define PG8_LAS __attribute__((address_space(3)))
typedef unsigned short bf16_t;
typedef short bf16x8 __attribute__((ext_vector_type(8)));
typedef float f32x4 __attribute__((ext_vector_type(4)));
typedef unsigned u32x4 __attribute__((ext_vector_type(4)));
constexpr int BM = 256, BK = 64, HALF = 128, HTB = HALF * BK * 2  , STAGE_BYTES = 8 * HTB, NXCD = 8, WGM = 8;

__host__ __device__ __forceinline__ int lds_byte(int r, int c) { const int st = (r >> 4) * 2 + (c >> 5), rr = r & 15, cc = c & 31, ob = rr * 64 + cc * 2; return st * 1024 + (ob ^ (((ob >> 9) & 1) << 5)); }
__host__ __device__ __forceinline__ void stage_rc(int b, int& R, int& C) { const int st = b / 1024, sb = b % 1024, swz = sb ^ (((sb >> 9) & 1) << 5); R = (st >> 1) * 16 + swz / 64; C = (st & 1) * 32 + (swz % 64) / 2; }
__host__ __device__ __forceinline__ int perm32(int rho) { const int n = rho >> 4, i = rho & 15; return 8 * (i >> 2) + 4 * n + (i & 3); }

struct Unit { int pm, pn; };
struct Gemm { const bf16_t* A; const bf16_t* Bt; int M, N, K, ld; };

struct StaticOrder {
    int nM, nN, nwg, G, c;
    __host__ __device__ void init(int M, int N, int G_, int c_) { nM = M / BM; nN = N / BM; nwg = nM * nN; G = G_; c = c_; }
    __host__ __device__ bool next(int i, Unit& u) const {
        const long L = (long)i * G + c; if (L >= nwg) return false;
        int wgid = (int)L; { const int q = nwg / NXCD, r = nwg % NXCD, xcd = wgid % NXCD, off = wgid / NXCD; wgid = (xcd < r ? xcd * (q + 1) : r * (q + 1) + (xcd - r) * q) + off; }
        const int nig = WGM * nN, gid = wgid / nig, fm = gid * WGM, gsz = (nM - fm) < WGM ? (nM - fm) : WGM;
        u.pm = fm + ((wgid % nig) % gsz); u.pn = (wgid % nig) / gsz; return true;
    }
    __device__ __forceinline__ void a_ready(const Unit&) const {}
    __device__ __forceinline__ void done(const Unit&) const {}
};
typedef __bf16 bf16x2_n __attribute__((ext_vector_type(2)));
typedef float f32x2_n __attribute__((ext_vector_type(2)));
__device__ __forceinline__ unsigned cvt_pk_bf16(float lo, float hi) { f32x2_n v = {lo, hi}; bf16x2_n b = __builtin_convertvector(v, bf16x2_n); return __builtin_bit_cast(unsigned, b); }
typedef float f32x2 __attribute__((ext_vector_type(2)));
template <class Epi, class Sched, bool STAMP = false>
__device__ __forceinline__ void gemm_phase(PG8_LAS unsigned char* lds, const Gemm g, const Sched& S, const Epi& E, unsigned long long* stamps) {
    int tid_o = threadIdx.x; asm volatile("" : "+v"(tid_o)); const int tid = tid_o, wid = __builtin_amdgcn_readfirstlane(tid >> 6), lane = tid & 63, wr = wid >> 2, wc = wid & 3, fr = lane & 15, fq = lane >> 4;
    const int K = g.ld, nt = g.K / BK;
    int ts_lo = 0, ts_hi = 0, nts = 0; const unsigned long long rt_entry = STAMP ? (unsigned long long)wall_clock64() : 0ull;
#define PG8_STAMP() do { if (STAMP && wid == 0 && nts < 64) { const unsigned long long _c = (unsigned long long)clock64(); \
        ts_lo = (lane == nts) ? (int)(unsigned)_c : ts_lo; ts_hi = (lane == nts) ? (int)(unsigned)(_c >> 32) : ts_hi; ++nts; } } while (0)
    PG8_STAMP();
    unsigned voffA[2], voffB[2];
#pragma unroll
    for (int i = 0; i < 2; ++i) { int R, C; stage_rc(tid * 16 + i * 8192, R, C); const int Rb = Epi::PERM ? ((R & ~31) + perm32(R & 31)) : R;
        voffA[i] = (unsigned)(R * K + C) * 2u; voffB[i] = (unsigned)(Rb * K + C) * 2u; }
    const size_t kstep = (size_t)(BK * 2);
    const size_t hstep = (size_t)HALF * K * 2;
    const size_t tstep = 2 * hstep;
    const unsigned ldsw = (unsigned)wid * 1024u;
    const int aoff = lds_byte(wr * 64 + fr, fq * 8), boff = lds_byte(wc * 32 + fr, fq * 8);
#define PG8_SA(b, h) (((b) * 2 + (h)) * HTB)
#define PG8_SB(b, h) ((4 + (b) * 2 + (h)) * HTB)
#define PG8_STAGE(bufoff, gbase, voff) do { _Pragma("unroll") for (int _i = 0; _i < 2; ++_i) \
        __builtin_amdgcn_global_load_lds((const unsigned*)((const char*)(gbase) + (voff)[_i]), (PG8_LAS unsigned*)(lds + (bufoff) + ldsw + _i * 8192), 16, 0, 0); } while (0)
#define PG8_LDA(dst, b, h) do { _Pragma("unroll") for (int m = 0; m < 4; ++m) _Pragma("unroll") for (int k = 0; k < 2; ++k) dst[m][k] = *(const PG8_LAS bf16x8*)(lds + PG8_SA(b, h) + aoff + m * 2048 + k * 1024); } while (0)
#define PG8_LDB(dst, b, h) do { _Pragma("unroll") for (int n = 0; n < 2; ++n) _Pragma("unroll") for (int k = 0; k < 2; ++k) dst[n][k] = *(const PG8_LAS bf16x8*)(lds + PG8_SB(b, h) + boff + n * 2048 + k * 1024); } while (0)
#define PG8_MMA(ai, bj, At, Bt) do { __builtin_amdgcn_s_setprio(1); _Pragma("unroll") for (int m = 0; m < 4; ++m) _Pragma("unroll") for (int n = 0; n < 2; ++n) _Pragma("unroll") for (int k = 0; k < 2; ++k) \
        acc[ai][bj][m][n] = __builtin_amdgcn_mfma_f32_16x16x32_bf16(Bt[n][k], At[m][k], acc[ai][bj][m][n], 0, 0, 0); __builtin_amdgcn_s_setprio(0); } while (0)
#define PG8_WAIT_V(n) asm volatile("s_waitcnt vmcnt(" #n ")" ::: "memory")
#define PG8_WAIT_L(n) asm volatile("s_waitcnt lgkmcnt(" #n ")" ::: "memory")
#define PG8_BAR __builtin_amdgcn_s_barrier()
#define PG8_SCHED __builtin_amdgcn_sched_barrier(0)
    Unit cur, nxt; int ui = 0;
    if (!S.next(0, cur)) return;
    f32x4 acc[2][2][4][2];
#pragma unroll
    for (int a = 0; a < 2; ++a)
#pragma unroll
        for (int b = 0; b < 2; ++b)
#pragma unroll
            for (int m = 0; m < 4; ++m)
#pragma unroll
                for (int n = 0; n < 2; ++n) acc[a][b][m][n] = (f32x4){0.f, 0.f, 0.f, 0.f};
    bf16x8 At[4][2], B0[2][2], B1[2][2];
    const char* cA = (const char*)g.A + (size_t)cur.pm * tstep; const char* cB = (const char*)g.Bt + (size_t)cur.pn * tstep;
    S.a_ready(cur);
    PG8_STAGE(PG8_SB(0, 0), cB, voffB); PG8_STAGE(PG8_SA(0, 0), cA, voffA); PG8_STAGE(PG8_SB(0, 1), cB + hstep, voffB); PG8_STAGE(PG8_SA(0, 1), cA + hstep, voffA);
    if (wr == 1) PG8_BAR;
    PG8_WAIT_V(4); PG8_BAR;
    PG8_STAGE(PG8_SB(1, 0), cB + kstep, voffB); PG8_STAGE(PG8_SA(1, 0), cA + kstep, voffA); PG8_STAGE(PG8_SB(1, 1), cB + hstep + kstep, voffB);
    PG8_WAIT_V(6); PG8_BAR;
    PG8_STAMP();
    for (;;) {
        const bool has_next = S.next(ui + 1, nxt);
        const char* nA = has_next ? (const char*)g.A + (size_t)nxt.pm * tstep : cA; const char* nB = has_next ? (const char*)g.Bt + (size_t)nxt.pn * tstep : cB;
        for (int t = 0; t < nt; t += 2) {
            const bool last = (t == nt - 2);
            const char* a1 = cA + (size_t)(t + 1) * kstep;
            const char* a2 = last ? nA : cA + (size_t)(t + 2) * kstep; const char* b2 = last ? nB : cB + (size_t)(t + 2) * kstep;
            const char* a3 = a2 + kstep; const char* b3 = b2 + kstep;
            if (last && has_next) S.a_ready(nxt);
            PG8_LDB(B0, 0, 0); PG8_SCHED; PG8_LDA(At, 0, 0); PG8_STAGE(PG8_SA(1, 1), a1 + hstep, voffA);
            PG8_WAIT_L(8); PG8_BAR; PG8_WAIT_L(0); PG8_MMA(0, 0, At, B0); PG8_BAR; PG8_SCHED;
            PG8_LDB(B1, 0, 1); PG8_STAGE(PG8_SB(0, 0), b2, voffB);
            PG8_BAR; PG8_WAIT_L(0); PG8_MMA(0, 1, At, B1); PG8_BAR;
            PG8_LDA(At, 0, 1); PG8_STAGE(PG8_SA(0, 0), a2, voffA);
            PG8_BAR; PG8_WAIT_L(0); PG8_MMA(1, 0, At, B0); PG8_BAR; PG8_SCHED;
            PG8_STAGE(PG8_SB(0, 1), b2 + hstep, voffB);
            PG8_WAIT_V(6); PG8_BAR; PG8_MMA(1, 1, At, B1); PG8_BAR;
            PG8_LDB(B0, 1, 0); PG8_SCHED; PG8_LDA(At, 1, 0); PG8_STAGE(PG8_SA(0, 1), a2 + hstep, voffA);
            PG8_WAIT_L(8); PG8_BAR; PG8_WAIT_L(0); PG8_MMA(0, 0, At, B0); PG8_BAR; PG8_SCHED;
            PG8_LDB(B1, 1, 1); PG8_STAGE(PG8_SB(1, 0), b3, voffB);
            PG8_BAR; PG8_WAIT_L(0); PG8_MMA(0, 1, At, B1); PG8_BAR;
            PG8_LDA(At, 1, 1); PG8_STAGE(PG8_SA(1, 0), a3, voffA);
            PG8_BAR; PG8_WAIT_L(0); PG8_MMA(1, 0, At, B0); PG8_BAR; PG8_SCHED;
            PG8_STAGE(PG8_SB(1, 1), b3 + hstep, voffB);
            PG8_WAIT_V(6); PG8_BAR; PG8_MMA(1, 1, At, B1); PG8_BAR;
        }
        PG8_STAMP();
        if constexpr (!Epi::AFTER_DRAIN) { E(acc, cur, wr, wc, fr, fq); S.done(cur); }
        PG8_STAMP();
        if (!has_next) break;
#pragma unroll
        for (int a = 0; a < 2; ++a)
#pragma unroll
            for (int b = 0; b < 2; ++b)
#pragma unroll
                for (int m = 0; m < 4; ++m)
#pragma unroll
                    for (int n = 0; n < 2; ++n) acc[a][b][m][n] = (f32x4){0.f, 0.f, 0.f, 0.f};
        cur = nxt; cA = nA; cB = nB; ++ui;
    }
    PG8_WAIT_V(0);
    if (wr == 0) PG8_BAR;
    PG8_BAR;
    if constexpr (Epi::AFTER_DRAIN) { E.fused(acc, cur, wr, wc, fr, fq, lds, wid, lane); S.done(cur); }
    PG8_STAMP();
    if (STAMP && wid == 0) { stamps[lane] = lane < nts ? (((unsigned long long)(unsigned)ts_hi << 32) | (unsigned)ts_lo) : 0ull;
        if (lane == 62) stamps[62] = rt_entry; if (lane == 63) stamps[63] = (unsigned long long)wall_clock64(); }
#undef PG8_STAMP
#undef PG8_SA
#undef PG8_SB
#undef PG8_STAGE
#undef PG8_LDA
#undef PG8_LDB
#undef PG8_MMA
#undef PG8_WAIT_V
#undef PG8_WAIT_L
#undef PG8_BAR
#undef PG8_SCHED
}
}

namespace cg = cooperative_groups;
using pg8::bf16_t; using pg8::bf16x8; using pg8::f32x4; using pg8::u32x4; using pg8::cvt_pk_bf16;

#ifndef MK_LAUNCHES
#define MK_LAUNCHES 1
#endif

constexpr int T_TOK = 20480, T_PROMPT = 4096, DM = 1024, DFF = 4096, EVN = 2592, EVNP = 2816;
constexpr int LDS_BYTES = 147456;
constexpr int NPHASE = 19;
constexpr float EPSN = 1e-6f;

constexpr size_t WS_MOD    = 0;
constexpr size_t WS_WEVIN  = 262144;
constexpr size_t WS_WEVOUT = WS_WEVIN  + (size_t)EVNP * 1024 * 2;
constexpr size_t WS_WMLP1  = WS_WEVOUT + (size_t)1024 * 1024 * 2;
constexpr size_t WS_WMLP2  = WS_WMLP1  + (size_t)2 * 4096 * 1024 * 2;
constexpr size_t WS_WRGIN  = WS_WMLP2  + (size_t)2 * 4096 * 1024 * 2;
constexpr size_t WS_WRGOUT = WS_WRGIN  + (size_t)2048 * 1024 * 2;
constexpr size_t WS_WRGG   = WS_WRGOUT + (size_t)1024 * 1024 * 2;
constexpr size_t WS_WSGU   = WS_WRGG   + (size_t)16 * 256 * 64 * 2;
constexpr size_t WS_ABUF   = WS_WSGU   + (size_t)4 * 128 * 128 * 2;
constexpr size_t WS_BIG    = WS_ABUF   + (size_t)T_TOK * 1024 * 2;
constexpr size_t BIG_BYTES = (size_t)T_TOK * 4096 * 2;
constexpr size_t WS_END    = WS_BIG + BIG_BYTES;
static_assert(WS_END <= 268435456ull, "workspace map exceeds 256 MiB");
constexpr size_t BIG_PROJ  = 0;
constexpr size_t BIG_OF    = (size_t)T_TOK * EVN * 2;
constexpr size_t BIG_OB    = BIG_OF + (size_t)T_TOK * 512 * 2;
static_assert(BIG_OB + (size_t)T_TOK * 512 * 2 <= BIG_BYTES, "");
constexpr size_t BIG_Y     = 0;
constexpr size_t BIG_H     = 0;
constexpr size_t BIG_RGP   = 0;
constexpr size_t BIG_RGSUM = (size_t)T_TOK * 2048 * 2;
constexpr size_t WS_BAR = WS_END + 256;
static_assert(WS_BAR + 3456 * 4 <= 268435456ull, "");
constexpr size_t WS_SCR = WS_BAR + 16384;
static_assert(WS_SCR + (size_t)4096 * 1024 * 2 <= 268435456ull, "");
constexpr size_t BIG_RGCAR = BIG_RGSUM + (size_t)320 * 2 * 2 * 1024 * 4;

struct Params {
    const float* in[31];
    float* out;
    unsigned char* ws;
    int nseq, pad;
    unsigned char seq[64];
    unsigned char dbgv[64];
};

__device__ __forceinline__ float bf2f(unsigned short b) { return __uint_as_float(((unsigned)b) << 16); }
__device__ __forceinline__ float bflo(unsigned w) { return __uint_as_float(w << 16); }
__device__ __forceinline__ float bfhi(unsigned w) { return __uint_as_float(w & 0xffff0000u); }
__device__ __forceinline__ unsigned short f2bf(float f) { return (unsigned short)(cvt_pk_bf16(f, 0.f) & 0xffffu); }
__device__ __forceinline__ float wave_sum(float v) {
#pragma unroll
    for (int o = 32; o > 0; o >>= 1) v += __shfl_xor(v, o, 64);
    return v;
}
__device__ __forceinline__ float gelu_tanh(float x) {
    const float u = -2.302208198f * (x + 0.044715f * x * x * x);
    return x * __builtin_amdgcn_rcpf(1.0f + __builtin_amdgcn_exp2f(u));
}
__device__ __forceinline__ float sigmoidf_(float x) { return __builtin_amdgcn_rcpf(1.0f + __expf(-x)); }
__device__ __forceinline__ bf16x8 ldfrag(const unsigned short* base, int pitch, int r0, int k0, int lane) {
    return *(const bf16x8*)(base + (r0 + (lane & 15)) * pitch + k0 + (lane >> 4) * 8);
}
__device__ __forceinline__ int otid() { int t = threadIdx.x; asm volatile("" : "+v"(t)); return t; }
__device__ __forceinline__ void lds_barrier() { asm volatile("s_waitcnt lgkmcnt(0)" ::: "memory"); __builtin_amdgcn_s_barrier(); asm volatile("" ::: "memory"); }
#define MFMA16(a, b, c) __builtin_amdgcn_mfma_f32_16x16x32_bf16((a), (b), (c), 0, 0, 0)

struct EpiGen {
    static constexpr bool PERM = true, AFTER_DRAIN = false;
    void* O; int ldc; const float* bias; int ncols; int mode;
    __device__ __forceinline__ void operator()(const f32x4 (&acc)[2][2][4][2], const pg8::Unit& u, int wr, int wc, int fr, int fq) const {
        const int row0 = u.pm * 256 + wr * 64 + fr, col0 = u.pn * 256 + wc * 32 + 8 * fq;
        const bool act = (mode == 0) ? (u.pn < 4) : ((mode == 3) ? (u.pn >= 4) : false);
        if (mode == 4) {
#pragma unroll
            for (int ai = 0; ai < 2; ++ai)
#pragma unroll
                for (int m = 0; m < 4; ++m) { float* rowp = (float*)O + (size_t)(row0 + ai * 128 + m * 16) * ldc + col0;
#pragma unroll
                    for (int bj = 0; bj < 2; ++bj) { *(f32x4*)(rowp + bj * 128) = acc[ai][bj][m][0]; *(f32x4*)(rowp + bj * 128 + 4) = acc[ai][bj][m][1]; } }
            return;
        }
#pragma unroll
        for (int bj = 0; bj < 2; ++bj) {
            const int col = col0 + bj * 128;
            if (col >= ncols) continue;
            f32x4 b0 = (f32x4){0.f, 0.f, 0.f, 0.f}, b1 = b0;
            if (bias) { b0 = *(const f32x4*)(bias + col); b1 = *(const f32x4*)(bias + col + 4); }
#pragma unroll
            for (int ai = 0; ai < 2; ++ai)
#pragma unroll
                for (int m = 0; m < 4; ++m) {
                    f32x4 v0 = acc[ai][bj][m][0] + b0, v1 = acc[ai][bj][m][1] + b1;
                    if (mode == 1) {
#pragma unroll
                        for (int j = 0; j < 4; ++j) { float a = fmaxf(v0[j], 0.f), b = fmaxf(v1[j], 0.f); v0[j] = a * a; v1[j] = b * b; }
                    }
                    if (act) {
#pragma unroll
                        for (int j = 0; j < 4; ++j) { v0[j] = gelu_tanh(v0[j]); v1[j] = gelu_tanh(v1[j]); }
                    }
                    u32x4 w; w.x = cvt_pk_bf16(v0[0], v0[1]); w.y = cvt_pk_bf16(v0[2], v0[3]); w.z = cvt_pk_bf16(v1[0], v1[1]); w.w = cvt_pk_bf16(v1[2], v1[3]);
                    *(u32x4*)((bf16_t*)O + (size_t)(row0 + ai * 128 + m * 16) * ldc + col) = w;
                }
        }
    }
};

template <class Epi>
__device__ __forceinline__ void run_gemm(unsigned char* shm, const bf16_t* A, const bf16_t* Bt, int M, int N, int K, int ld, int G, int c, const Epi& E) {
    pg8::Gemm g; g.A = A; g.Bt = Bt; g.M = M; g.N = N; g.K = K; g.ld = ld;
    pg8::StaticOrder S; S.init(M, N, G, c);
    pg8::gemm_phase<Epi, pg8::StaticOrder, false>((PG8_LAS unsigned char*)shm, g, S, E, nullptr);
}

__device__ __forceinline__ void transpose_tile(const float* src, int ldsrc, int k0, int n0, int nvalid, int nstore, bf16_t* dst, int lddst, float* tile) {
    const int tid = otid();
    {
        const int kk = tid >> 6, n4 = (tid & 63) * 4;
        float4 v[8];
#pragma unroll
        for (int i = 0; i < 8; ++i) {
            v[i] = make_float4(0.f, 0.f, 0.f, 0.f);
            if (n0 + n4 < nvalid) v[i] = *(const float4*)(src + (size_t)(k0 + kk + 8 * i) * ldsrc + n0 + n4);
        }
#pragma unroll
        for (int i = 0; i < 8; ++i) { float* tp = tile + (kk + 8 * i) * 257 + n4; tp[0] = v[i].x; tp[1] = v[i].y; tp[2] = v[i].z; tp[3] = v[i].w; }
    }
    __syncthreads();
    {
        const int nn = tid >> 1, k32 = (tid & 1) * 32;
        if (n0 + nn < nstore) {
            bf16_t* dp = dst + (size_t)(n0 + nn) * lddst + k0 + k32;
#pragma unroll
            for (int q = 0; q < 4; ++q) {
                float f[8];
#pragma unroll
                for (int j = 0; j < 8; ++j) f[j] = tile[(k32 + q * 8 + j) * 257 + nn];
                u32x4 w; w.x = cvt_pk_bf16(f[0], f[1]); w.y = cvt_pk_bf16(f[2], f[3]); w.z = cvt_pk_bf16(f[4], f[5]); w.w = cvt_pk_bf16(f[6], f[7]);
                *(u32x4*)(dp + q * 8) = w;
            }
        }
    }
    __syncthreads();
}

__device__ __forceinline__ void convert_weight_tile(const Params& p, float* fl, int idx) {
    const float* src; bf16_t* dst; int ld, nv, ns, ldd, nkt;
    if (idx < 176) { src = p.in[13]; dst = (bf16_t*)(p.ws + WS_WEVIN); ld = EVN; nv = EVN; ns = EVNP; ldd = 1024; nkt = 16; }
    else if ((idx -= 176) < 64) { src = p.in[14]; dst = (bf16_t*)(p.ws + WS_WEVOUT); ld = 1024; nv = 1024; ns = 1024; ldd = 1024; nkt = 16; }
    else if ((idx -= 64) < 512) { const int l = idx >> 8; idx &= 255; src = p.in[9] + (size_t)l * 1024 * 4096; dst = (bf16_t*)(p.ws + WS_WMLP1) + (size_t)l * 4096 * 1024; ld = 4096; nv = 4096; ns = 4096; ldd = 1024; nkt = 16; }
    else if ((idx -= 512) < 512) { const int l = idx >> 8; idx &= 255; src = p.in[11] + (size_t)l * 4096 * 1024; dst = (bf16_t*)(p.ws + WS_WMLP2) + (size_t)l * 1024 * 4096; ld = 1024; nv = 1024; ns = 1024; ldd = 4096; nkt = 64; }
    else if ((idx -= 512) < 128) { src = p.in[22]; dst = (bf16_t*)(p.ws + WS_WRGIN); ld = 2048; nv = 2048; ns = 2048; ldd = 1024; nkt = 16; }
    else if ((idx -= 128) < 64) { src = p.in[30]; dst = (bf16_t*)(p.ws + WS_WRGOUT); ld = 1024; nv = 1024; ns = 1024; ldd = 1024; nkt = 16; }
    else { idx -= 64; const int d = idx >> 5, mat = (idx >> 4) & 1, h = idx & 15;
        src = (mat ? p.in[27] : p.in[25]) + (size_t)(d * 16 + h) * 4096; dst = (bf16_t*)(p.ws + WS_WRGG) + (size_t)h * 256 * 64 + (size_t)(d * 2 + mat) * 4096; ld = 64; nv = 64; ns = 64; ldd = 64; nkt = 1; idx = 0; }
    const int kt = idx % nkt, nt = idx / nkt;
    transpose_tile(src, ld, kt * 64, nt * 256, nv, ns, dst, ldd, fl);
}
__device__ __forceinline__ int deferred1_tile(int d) { return d < 256 ? 240 + d : d < 512 ? 752 + (d - 256) : d < 640 ? 1264 + (d - 512) : 1392 + (d - 640); }
__device__ __forceinline__ int deferred2_tile(int d) { return d < 256 ? 496 + d : 1008 + (d - 256); }
__device__ __forceinline__ void phase_prep(const Params& p, unsigned char* shm) {
    const int tid = otid();
    float* fl = (float*)shm;
    constexpr int N_GEMV = 192, N_SGU = 16;
    const bool early = (gridDim.x == 256);
    const int N_TR = early ? 304 : 1520;
    for (int item = blockIdx.x; item < N_GEMV + N_TR + N_SGU; item += gridDim.x) {
        if (item < N_GEMV) {
            const int l = item / 96, n0 = (item % 96) * 64;
            float* S = fl;
            float* R = fl + 5120;
            const int r = tid >> 4, c4 = (tid & 15) * 4;
            const float* W = p.in[6] + (size_t)l * 1024 * 6144 + n0 + c4;
            float4 w[8];
#pragma unroll
            for (int j = 0; j < 8; ++j) w[j] = *(const float4*)(W + (size_t)(r + 32 * j) * 6144);
            for (int e = tid; e < 5120; e += 512) {
                const int c = e >> 10, k = e & 1023;
                const float v = (c == 0) ? p.in[5][k] : p.in[2][(c - 1) * 1024 + k];
                S[e] = v * sigmoidf_(v);
            }
            __syncthreads();
            float acc[5][4];
#pragma unroll
            for (int c = 0; c < 5; ++c)
#pragma unroll
                for (int j = 0; j < 4; ++j) acc[c][j] = 0.f;
            for (int i0 = 0; i0 < 32; i0 += 8) {
                float4 wn[8];
                if (i0 + 8 < 32) {
#pragma unroll
                    for (int j = 0; j < 8; ++j) wn[j] = *(const float4*)(W + (size_t)(r + 32 * (i0 + 8 + j)) * 6144);
                }
#pragma unroll
                for (int j = 0; j < 8; ++j) {
                    const int k = r + 32 * (i0 + j);
#pragma unroll
                    for (int c = 0; c < 5; ++c) { const float sv = S[c * 1024 + k]; acc[c][0] += sv * w[j].x; acc[c][1] += sv * w[j].y; acc[c][2] += sv * w[j].z; acc[c][3] += sv * w[j].w; }
                }
                if (i0 + 8 < 32) {
#pragma unroll
                    for (int j = 0; j < 8; ++j) w[j] = wn[j];
                }
            }
#pragma unroll
            for (int c = 0; c < 5; ++c)
#pragma unroll
                for (int j = 0; j < 4; ++j) R[(r * 5 + c) * 64 + c4 + j] = acc[c][j];
            __syncthreads();
            if (tid < 320) {
                const int c = tid >> 6, n = tid & 63;
                float s = p.in[7][l * 6144 + n0 + n];
                for (int rr = 0; rr < 32; ++rr) s += R[(rr * 5 + c) * 64 + n];
                ((float*)(p.ws + WS_MOD))[(l * 5 + c) * 6144 + n0 + n] = s;
            }
            __syncthreads();
        } else if (item < N_GEMV + N_TR) {
            const int e = item - N_GEMV;
            convert_weight_tile(p, fl, early ? (e < 240 ? e : 1456 + (e - 240)) : e);
        } else {
            const int it = item - N_GEMV - N_TR;
            const int e = it * 4096 + tid * 8;
            const float4 a = *(const float4*)(p.in[17] + e), b = *(const float4*)(p.in[17] + e + 4);
            u32x4 w; w.x = cvt_pk_bf16(a.x, a.y); w.y = cvt_pk_bf16(a.z, a.w); w.z = cvt_pk_bf16(b.x, b.y); w.w = cvt_pk_bf16(b.z, b.w);
            *(u32x4*)((bf16_t*)(p.ws + WS_WSGU) + e) = w;
        }
    }
}

template <int SRC, bool NEXT, bool XIN = false, bool XST = true>
__device__ __forceinline__ void phase_row(const Params& p, const void* ysrc, const float* ng_res, const float* modg  ,
                          const float* ng_next, const float* modn  , int sh_off, int sc_off, bool part,
                          int row_lo = 0, int row_hi = T_TOK, int wave0 = 0, int nwaves = 0) {
    const int tid_ = otid(); const int lane = tid_ & 63, wid = tid_ >> 6;
    bf16_t* A = (bf16_t*)(p.ws + WS_ABUF);
    float om[4];
    if (SRC == 0 || XIN) {
#pragma unroll
        for (int e = 0; e < 4; ++e) om[e] = exp2f(-(float)(lane * 4 + e) * (13.287712379549449f / 256.0f));
    }
    const int nw = nwaves ? nwaves : (int)gridDim.x * 8, R = (row_hi - row_lo + nw - 1) / nw;
    const int gw = (int)blockIdx.x * 8 + wid - wave0;
    int r_lo = row_lo + gw * R, r_hi = (r_lo + R < row_hi) ? (r_lo + R) : row_hi;
    if (gw < 0 || gw >= nw) { r_lo = 0; r_hi = 0; }
    const bool dopart = (SRC == 2) && part && (gridDim.x == 256);
    int cur_cond = -1;
    float4 gn[4], nn[4], shv[4];
    float4 cx[4], nx[4];
    float4 cy[4], ny[4];
    uint2 cyb[4], nyb[4], cpb[4], npb[4];
#pragma unroll
    for (int i = 0; i < 4; ++i) { cx[i] = nx[i] = cy[i] = ny[i] = make_float4(0.f, 0.f, 0.f, 0.f); cyb[i] = nyb[i] = cpb[i] = npb[i] = make_uint2(0u, 0u); }
    auto load_row = [&](int t, float4 (&x)[4], float4 (&y)[4], uint2 (&yb)[4], uint2 (&pb)[4]) {
        const float* xi = (SRC == 0 || XIN) ? ((t < T_PROMPT) ? (p.in[0] + (size_t)t * 1024) : (p.in[1] + (size_t)(t - T_PROMPT) * 1024)) : (p.out + (size_t)t * 1024);
#pragma unroll
        for (int i = 0; i < 4; ++i) x[i] = *(const float4*)(xi + lane * 4 + 256 * i);
        if (SRC == 1) {
#pragma unroll
            for (int i = 0; i < 4; ++i) y[i] = *(const float4*)((const float*)ysrc + (size_t)t * 1024 + lane * 4 + 256 * i);
        }
        if (SRC == 2) {
#pragma unroll
            for (int i = 0; i < 4; ++i) yb[i] = *(const uint2*)((const bf16_t*)ysrc + (size_t)t * 1024 + lane * 4 + 256 * i);
            if (dopart && t >= 16384) {
#pragma unroll
                for (int i = 0; i < 4; ++i) pb[i] = *(const uint2*)((const bf16_t*)(p.ws + WS_SCR) + (size_t)(t - 16384) * 1024 + lane * 4 + 256 * i);
            }
        }
    };
    if (r_lo < r_hi) load_row(r_lo, cx, cy, cyb, cpb);
    for (int t = r_lo; t < r_hi; ++t) {
        if (t + 1 < r_hi) load_row(t + 1, nx, ny, nyb, npb);
        const int cond = (t < T_PROMPT) ? 0 : 1 + ((t - T_PROMPT) >> 12);
        if (cond != cur_cond) {
            cur_cond = cond;
#pragma unroll
            for (int i = 0; i < 4; ++i) {
                if (SRC != 0) {
                    const float4 g = *(const float4*)(modg + cond * 6144 + lane * 4 + 256 * i), n = *(const float4*)(ng_res + lane * 4 + 256 * i);
                    gn[i] = make_float4(g.x * n.x, g.y * n.y, g.z * n.z, g.w * n.w);
                }
                if (NEXT) {
                    const float* mp = modn + cond * 6144 + lane * 4 + 256 * i;
                    const float4 n = *(const float4*)(ng_next + lane * 4 + 256 * i), sc = *(const float4*)(mp + sc_off);
                    shv[i] = *(const float4*)(mp + sh_off);
                    nn[i] = make_float4(n.x * (1.f + sc.x), n.y * (1.f + sc.y), n.z * (1.f + sc.z), n.w * (1.f + sc.w));
                }
            }
        }
        float4 xv[4];
#pragma unroll
        for (int i = 0; i < 4; ++i) xv[i] = cx[i];
        float* xo = p.out + (size_t)t * 1024 + lane * 4;
        if ((SRC == 0 || XIN) && t >= T_PROMPT) {
            const int tl = (t - T_PROMPT) & 4095;
            const float rr = (float)(tl >> 6), cc = (float)(tl & 63);
#pragma unroll
            for (int i = 0; i < 4; ++i) {
                const float base = (i < 2) ? rr : cc;
                float pe[4];
#pragma unroll
                for (int e = 0; e < 4; ++e) {
                    const float a = base * om[e];
                    const float k = rintf(a * 0.15915494309189535f);
                    float y = fmaf(-k, 6.28318548202514648f, a); y = fmaf(-k, -1.7484555e-07f, y);
                    pe[e] = (i & 1) ? __cosf(y) : __sinf(y);
                }
                xv[i].x += pe[0]; xv[i].y += pe[1]; xv[i].z += pe[2]; xv[i].w += pe[3];
            }
        }
        if (SRC != 0) {
            float4 yv[4];
            if (SRC == 1) {
#pragma unroll
                for (int i = 0; i < 4; ++i) yv[i] = cy[i];
            } else {
#pragma unroll
                for (int i = 0; i < 4; ++i) yv[i] = make_float4(bflo(cyb[i].x), bfhi(cyb[i].x), bflo(cyb[i].y), bfhi(cyb[i].y));
                if (dopart && t >= 16384) {
#pragma unroll
                    for (int i = 0; i < 4; ++i) { yv[i].x += bflo(cpb[i].x); yv[i].y += bfhi(cpb[i].x); yv[i].z += bflo(cpb[i].y); yv[i].w += bfhi(cpb[i].y); }
                }
            }
            float ss = 0.f;
#pragma unroll
            for (int i = 0; i < 4; ++i) ss += yv[i].x * yv[i].x + yv[i].y * yv[i].y + yv[i].z * yv[i].z + yv[i].w * yv[i].w;
            ss = wave_sum(ss);
            const float r = rsqrtf(ss * (1.0f / 1024.0f) + EPSN);
#pragma unroll
            for (int i = 0; i < 4; ++i) {
                xv[i].x += gn[i].x * (yv[i].x * r); xv[i].y += gn[i].y * (yv[i].y * r); xv[i].z += gn[i].z * (yv[i].z * r); xv[i].w += gn[i].w * (yv[i].w * r);
            }
        }
        if (XST) {
#pragma unroll
            for (int i = 0; i < 4; ++i) *(float4*)(xo + 256 * i) = xv[i];
        }
        if (NEXT) {
            float ss = 0.f;
#pragma unroll
            for (int i = 0; i < 4; ++i) ss += xv[i].x * xv[i].x + xv[i].y * xv[i].y + xv[i].z * xv[i].z + xv[i].w * xv[i].w;
            ss = wave_sum(ss);
            const float r = rsqrtf(ss * (1.0f / 1024.0f) + EPSN);
#pragma unroll
            for (int i = 0; i < 4; ++i) {
                const float h0 = xv[i].x * r * nn[i].x + shv[i].x, h1 = xv[i].y * r * nn[i].y + shv[i].y;
                const float h2 = xv[i].z * r * nn[i].z + shv[i].z, h3 = xv[i].w * r * nn[i].w + shv[i].w;
                uint2 w; w.x = cvt_pk_bf16(h0, h1); w.y = cvt_pk_bf16(h2, h3);
                *(uint2*)(A + (size_t)t * 1024 + lane * 4 + 256 * i) = w;
            }
        }
#pragma unroll
        for (int i = 0; i < 4; ++i) { cx[i] = nx[i]; cy[i] = ny[i]; cyb[i] = nyb[i]; cpb[i] = npb[i]; }
    }
}

__device__ __forceinline__ void phase_gla_combine(const Params& p) {
    const int tid_ = otid(); const int lane = tid_ & 63, wid = tid_ >> 6;
    const bf16_t* proj = (const bf16_t*)(p.ws + WS_BIG + BIG_PROJ);
    const bf16_t* of = (const bf16_t*)(p.ws + WS_BIG + BIG_OF);
    const bf16_t* ob = (const bf16_t*)(p.ws + WS_BIG + BIG_OB);
    bf16_t* A = (bf16_t*)(p.ws + WS_ABUF);
    const float4 gn0 = *(const float4*)(p.in[21] + lane * 8), gn1 = *(const float4*)(p.in[21] + lane * 8 + 4);
    const float gn[8] = {gn0.x, gn0.y, gn0.z, gn0.w, gn1.x, gn1.y, gn1.z, gn1.w};
    const int nw = gridDim.x * 8, R = (T_TOK + nw - 1) / nw, gw = blockIdx.x * 8 + wid;
    const int r_lo = gw * R, r_hi = (r_lo + R < T_TOK) ? (r_lo + R) : T_TOK;
    u32x4 a = (u32x4){0, 0, 0, 0}, b = a, g = a, na = a, nb = a, ngv = a;
    if (r_lo < r_hi) { a = *(const u32x4*)(of + (size_t)r_lo * 512 + lane * 8); b = *(const u32x4*)(ob + (size_t)r_lo * 512 + lane * 8); g = *(const u32x4*)(proj + (size_t)r_lo * EVN + 2048 + lane * 8); }
    for (int t = r_lo; t < r_hi; ++t) {
        if (t + 1 < r_hi) { na = *(const u32x4*)(of + (size_t)(t + 1) * 512 + lane * 8); nb = *(const u32x4*)(ob + (size_t)(t + 1) * 512 + lane * 8); ngv = *(const u32x4*)(proj + (size_t)(t + 1) * EVN + 2048 + lane * 8); }
        float o[8], gg[8];
#pragma unroll
        for (int j = 0; j < 4; ++j) { o[2 * j] = bflo(a[j]) + bflo(b[j]); o[2 * j + 1] = bfhi(a[j]) + bfhi(b[j]); gg[2 * j] = bflo(g[j]); gg[2 * j + 1] = bfhi(g[j]); }
        float ss = 0.f;
#pragma unroll
        for (int j = 0; j < 8; ++j) ss += o[j] * o[j];
#pragma unroll
        for (int m = 8; m > 0; m >>= 1) ss += __shfl_xor(ss, m, 64);
        const float r = rsqrtf(ss * (1.0f / 128.0f) + EPSN);
        float v[8];
#pragma unroll
        for (int j = 0; j < 8; ++j) v[j] = o[j] * r * gn[j] * (gg[j] * sigmoidf_(gg[j]));
        u32x4 w; w.x = cvt_pk_bf16(v[0], v[1]); w.y = cvt_pk_bf16(v[2], v[3]); w.z = cvt_pk_bf16(v[4], v[5]); w.w = cvt_pk_bf16(v[6], v[7]);
        *(u32x4*)(A + (size_t)t * 1024 + 512 + lane * 8) = w;
        a = na; b = nb; g = ngv;
    }
}

__device__ __forceinline__ void sgu_item(const Params& p, unsigned char* shm, int item) {
#ifdef SKIP_SGU
    return;
#endif
    const int tid = otid(), lane = tid & 63, wid = tid >> 6, quad = lane >> 4;
    const int c = item >> 2, g = item & 3, t0 = c * 128;
    const bf16_t* proj = (const bf16_t*)(p.ws + WS_BIG + BIG_PROJ);
    bf16_t* A = (bf16_t*)(p.ws + WS_ABUF);
    float* MU = (float*)shm; float* RS = MU + 128;
    unsigned short* VNT = (unsigned short*)(shm + 1024);
    unsigned short* WSA = (unsigned short*)(shm + 1024 + 34816);
    {
        u32x4 v[16];
#pragma unroll
        for (int rr = 0; rr < 16; ++rr) v[rr] = *(const u32x4*)(proj + (size_t)(t0 + wid * 16 + rr) * EVN + 512 + lane * 8);
#pragma unroll
        for (int rr = 0; rr < 16; ++rr) {
            float s = 0.f, ss = 0.f;
#pragma unroll
            for (int j = 0; j < 4; ++j) { const float a = bflo(v[rr][j]), b = bfhi(v[rr][j]); s += a + b; ss += a * a + b * b; }
            s = wave_sum(s); ss = wave_sum(ss);
            if (lane == 0) { const float mu = s * (1.0f / 512.0f); const float var = fmaxf(ss * (1.0f / 512.0f) - mu * mu, 0.f); MU[wid * 16 + rr] = mu; RS[wid * 16 + rr] = rsqrtf(var + EPSN); }
        }
    }
    {
        const bf16_t* wsg = (const bf16_t*)(p.ws + WS_WSGU) + (size_t)g * 16384;
#pragma unroll
        for (int i = 0; i < 4; ++i) { const int e = tid + 512 * i, row = e >> 4, c8 = (e & 15) * 8; *(u32x4*)(WSA + row * 136 + c8) = *(const u32x4*)(wsg + row * 128 + c8); }
    }
    lds_barrier();
    {
        const int q = tid >> 2, d32 = (tid & 3) * 32;
        const float mu = MU[q], rs = RS[q];
        const bf16_t* src = proj + (size_t)(t0 + q) * EVN + 512 + g * 128 + d32;
        const float* lg = p.in[15] + g * 128 + d32; const float* lb = p.in[16] + g * 128 + d32;
#pragma unroll
        for (int i = 0; i < 4; ++i) {
            const u32x4 w = *(const u32x4*)(src + i * 8);
#pragma unroll
            for (int j = 0; j < 4; ++j) {
                const int d = d32 + i * 8 + 2 * j;
                const float a = (bflo(w[j]) - mu) * rs * lg[i * 8 + 2 * j] + lb[i * 8 + 2 * j];
                const float b = (bfhi(w[j]) - mu) * rs * lg[i * 8 + 2 * j + 1] + lb[i * 8 + 2 * j + 1];
                VNT[d * 136 + q] = f2bf(a); VNT[(d + 1) * 136 + q] = f2bf(b);
            }
        }
    }
    lds_barrier();
    {
        f32x4 acc[8];
#pragma unroll
        for (int dt = 0; dt < 8; ++dt) acc[dt] = (f32x4){0.f, 0.f, 0.f, 0.f};
#pragma unroll
        for (int ks = 0; ks < 4; ++ks) {
            const bf16x8 b = ldfrag(WSA, 136, wid * 16, ks * 32, lane);
#pragma unroll
            for (int dt = 0; dt < 8; ++dt) { const bf16x8 a = ldfrag(VNT, 136, dt * 16, ks * 32, lane); acc[dt] = MFMA16(a, b, acc[dt]); }
        }
        const int pp = wid * 16 + (lane & 15), t = t0 + pp;
        const float bsv = p.in[18][g * 128 + pp];
#pragma unroll
        for (int dt = 0; dt < 8; ++dt) {
            const int d = dt * 16 + quad * 4;
            const uint2 uw = *(const uint2*)(proj + (size_t)t * EVN + g * 128 + d);
            uint2 w; w.x = cvt_pk_bf16(bflo(uw.x) * (acc[dt][0] + bsv), bfhi(uw.x) * (acc[dt][1] + bsv)); w.y = cvt_pk_bf16(bflo(uw.y) * (acc[dt][2] + bsv), bfhi(uw.y) * (acc[dt][3] + bsv));
            *(uint2*)(A + (size_t)t * 1024 + g * 128 + d) = w;
        }
    }
    lds_barrier();
}

__device__ __forceinline__ float fexp(float x) { return __builtin_amdgcn_exp2f(x * 1.4426950408889634f); }
__device__ __forceinline__ float flog(float x) { return __builtin_amdgcn_logf(x) * 0.6931471805599453f; }
__device__ __forceinline__ void gla_item(const Params& p, unsigned char* shm, int item) {
    const int tid = otid(), lane = tid & 63, wid = tid >> 6, quad = lane >> 4, l15 = lane & 15;
#ifdef SKIP_GLAP
    if (item >= 128) return;
#endif
    int s, rem;
    if (item < 128) { s = 16 + (item >> 5); rem = item & 31; } else { s = (item - 128) >> 5; rem = (item - 128) & 31; }
    const int h = rem >> 3, dir = (rem >> 2) & 1, sl = rem & 3;
    const int ts = (s < 16) ? s * 256 : T_PROMPT + (s - 16) * 4096, L = (s < 16) ? 256 : 4096, nc = L >> 6;
    const bf16_t* proj = (const bf16_t*)(p.ws + WS_BIG + BIG_PROJ);
    bf16_t* O = (bf16_t*)(p.ws + WS_BIG + (dir ? BIG_OB : BIG_OF));
    unsigned short* QR = (unsigned short*)(shm + 0);
    unsigned short* KR = (unsigned short*)(shm + 8192);
    unsigned short* LR = (unsigned short*)(shm + 82944);
    float* LA = (float*)(shm + 18432);
    float* SEG = (float*)(shm + 34816);
    unsigned short* QE = (unsigned short*)(shm + 36864);
    unsigned short* KE = (unsigned short*)(shm + 46080);
    unsigned short* KDT = (unsigned short*)(shm + 55296);
    unsigned short* VT = (unsigned short*)(shm + 64512);
    unsigned short* ST = (unsigned short*)(shm + 69120);
    unsigned short* ATT = (unsigned short*)(shm + 73728);
    float* DEC = (float*)(shm + 88064);
    const int lrow = tid >> 3, lc8 = (tid & 7) * 8;
    u32x4 qreg, kreg, vreg = (u32x4){0, 0, 0, 0};
    auto issue = [&](int n) {
        const int t0 = dir ? (ts + L - 64 * (n + 1)) : (ts + 64 * n);
        const int tq = dir ? (t0 + 63 - lrow) : (t0 + lrow);
        qreg = *(const u32x4*)(proj + (size_t)tq * EVN + 1024 + h * 64 + lc8);
        kreg = *(const u32x4*)(proj + (size_t)tq * EVN + 1280 + h * 64 + lc8);
        if (tid < 256) { const int vr = tid >> 2; const int tv = dir ? (t0 + 63 - vr) : (t0 + vr); vreg = *(const u32x4*)(proj + (size_t)tv * EVN + 1536 + h * 128 + sl * 32 + (tid & 3) * 8); }
        else if (tid < 384) { const int e = tid - 256, r = e >> 1; const int tl = dir ? (t0 + 63 - r) : (t0 + r); vreg = *(const u32x4*)(proj + (size_t)tl * EVN + 2560 + dir * 16 + (e & 1) * 8); }
    };
    issue(0);
    const int gmt = (wid * 2) >> 2, gnt0 = (wid * 2) & 3;
    bf16x8 gwf[2]; float gbv[2];
#pragma unroll
    for (int tt = 0; tt < 2; ++tt) {
        const int dkc = h * 64 + (gnt0 + tt) * 16 + l15;
        float wv[8];
#pragma unroll
        for (int j = 0; j < 8; ++j) wv[j] = (quad < 2) ? p.in[19][(dir * 16 + quad * 8 + j) * 256 + dkc] : 0.f;
        u32x4 pw; pw.x = cvt_pk_bf16(wv[0], wv[1]); pw.y = cvt_pk_bf16(wv[2], wv[3]); pw.z = cvt_pk_bf16(wv[4], wv[5]); pw.w = cvt_pk_bf16(wv[6], wv[7]);
        gwf[tt] = __builtin_bit_cast(bf16x8, pw);
        gbv[tt] = p.in[20][dir * 256 + dkc];
    }
    { unsigned z0 = 0; asm volatile("" : "+v"(z0));
      if (tid < 128) *(u32x4*)(LR + (tid >> 1) * 40 + 16 + (tid & 1) * 8) = (u32x4){z0, z0, z0, z0}; }
    const int mt = wid >> 1, nt = wid & 1;
    f32x4 Sacc = (f32x4){0.f, 0.f, 0.f, 0.f};
    if (s >= 16) {
        const float* st = p.in[3] + ((size_t)(((s - 16) * 2 + dir) * 4 + h) * 64) * 128;
#pragma unroll
        for (int j = 0; j < 4; ++j) Sacc[j] = st[(mt * 16 + quad * 4 + j) * 128 + sl * 32 + nt * 16 + l15];
    }
    unsigned dbgc = 0;
    uint2 pend_w = make_uint2(0u, 0u); bf16_t* pend_ptr = nullptr;
    for (int n = 0; n < nc; ++n) {
        const int t0 = dir ? (ts + L - 64 * (n + 1)) : (ts + 64 * n);
        *(u32x4*)(QR + lrow * 64 + lc8) = qreg; *(u32x4*)(KR + lrow * 64 + lc8) = kreg;
        if (tid < 256) { const int vr = tid >> 2, d8 = (tid & 3) * 8;
#pragma unroll
            for (int j = 0; j < 4; ++j) { VT[(d8 + 2 * j) * 72 + vr] = (unsigned short)(vreg[j] & 0xffffu); VT[(d8 + 2 * j + 1) * 72 + vr] = (unsigned short)(vreg[j] >> 16); } }
        else if (tid < 384) { const int e = tid - 256; *(u32x4*)(LR + (e >> 1) * 40 + (e & 1) * 8) = vreg; }
        if (n > 0) *(uint2*)pend_ptr = pend_w;
        if (n + 1 < nc) issue(n + 1);
        lds_barrier();
        {
            const bf16x8 af = ldfrag(LR, 40, gmt * 16, 0, lane);
#pragma unroll
            for (int tt = 0; tt < 2; ++tt) {
                f32x4 zc = (f32x4){0.f, 0.f, 0.f, 0.f};
                zc = MFMA16(af, gwf[tt], zc);
#pragma unroll
                for (int j = 0; j < 4; ++j) {
                    const float z = zc[j] + gbv[tt];
                    LA[(gmt * 16 + quad * 4 + j) * 64 + (gnt0 + tt) * 16 + l15] = (fminf(z, 0.f) - flog(1.0f + fexp(-fabsf(z)))) * 0.0625f;
                }
            }
        }
        lds_barrier();
        const int dk = lane, seg = wid;
        float cs[8];
        {
            float run = 0.f;
#pragma unroll
            for (int i = 0; i < 8; ++i) { run += LA[(seg * 8 + i) * 64 + dk]; cs[i] = run; }
            SEG[seg * 64 + dk] = run;
        }
        lds_barrier();
        {
            float pre = 0.f, tot = 0.f;
#pragma unroll
            for (int s2 = 0; s2 < 8; ++s2) { const float v = SEG[s2 * 64 + dk]; if (s2 < seg) pre += v; tot += v; }
            float kd[8];
            const float etot = fexp(tot);
#pragma unroll
            for (int i = 0; i < 8; ++i) {
                const int row = seg * 8 + i;
                const float b = pre + cs[i];
                const float q = bf2f(QR[row * 64 + dk]) * 0.125f, k = bf2f(KR[row * 64 + dk]);
#ifdef DBG_GLA
                if (!(fabsf(b) < 80.f)) dbgc |= 4u;
                if (!(fabsf(q) < 1e4f) || !(fabsf(k) < 1e4f)) dbgc |= 8u;
#endif
                const float eb = fexp(b), ke = k * __builtin_amdgcn_rcpf(eb);
                QE[row * 72 + dk] = f2bf(q * eb);
                KE[row * 72 + dk] = f2bf(ke);
                kd[i] = ke * etot;
            }
            u32x4 w; w.x = cvt_pk_bf16(kd[0], kd[1]); w.y = cvt_pk_bf16(kd[2], kd[3]); w.z = cvt_pk_bf16(kd[4], kd[5]); w.w = cvt_pk_bf16(kd[6], kd[7]);
            *(u32x4*)(KDT + dk * 72 + seg * 8) = w;
            if (seg == 0) DEC[dk] = etot;
            uint2 sw; sw.x = cvt_pk_bf16(Sacc[0], Sacc[1]); sw.y = cvt_pk_bf16(Sacc[2], Sacc[3]);
            *(uint2*)(ST + (nt * 16 + l15) * 72 + mt * 16 + quad * 4) = sw;
        }
        lds_barrier();
#pragma unroll
        for (int tt = 0; tt < 2; ++tt) {
            const int idx = wid * 2 + tt, it = idx >> 2, jt = idx & 3;
            f32x4 acc = (f32x4){0.f, 0.f, 0.f, 0.f};
            if (jt <= it) {
#pragma unroll
                for (int ks = 0; ks < 2; ++ks) { const bf16x8 a = ldfrag(KE, 72, jt * 16, ks * 32, lane), b = ldfrag(QE, 72, it * 16, ks * 32, lane); acc = MFMA16(a, b, acc); }
            }
#ifdef DBG_GLA
            for (int j = 0; j < 4; ++j) if (!(fabsf(acc[j]) < 1e30f)) dbgc |= 16u;
#endif
            const int i = it * 16 + l15, j0 = jt * 16 + quad * 4;
            uint2 w; w.x = cvt_pk_bf16(i >= j0 ? acc[0] : 0.f, i >= j0 + 1 ? acc[1] : 0.f); w.y = cvt_pk_bf16(i >= j0 + 2 ? acc[2] : 0.f, i >= j0 + 3 ? acc[3] : 0.f);
            *(uint2*)(ATT + i * 72 + j0) = w;
        }
        lds_barrier();
        {
            f32x4 acc = (f32x4){0.f, 0.f, 0.f, 0.f};
#pragma unroll
            for (int ks = 0; ks < 2; ++ks) { const bf16x8 a = ldfrag(VT, 72, nt * 16, ks * 32, lane), b = ldfrag(ATT, 72, mt * 16, ks * 32, lane); acc = MFMA16(a, b, acc); }
#pragma unroll
            for (int ks = 0; ks < 2; ++ks) { const bf16x8 a = ldfrag(ST, 72, nt * 16, ks * 32, lane), b = ldfrag(QE, 72, mt * 16, ks * 32, lane); acc = MFMA16(a, b, acc); }
#ifdef DBG_GLA
            for (int j = 0; j < 4; ++j) if (!(fabsf(acc[j]) < 1e30f)) dbgc |= 32u;
#endif
            const int i = mt * 16 + l15; const int t = dir ? (t0 + 63 - i) : (t0 + i);
            uint2 w; w.x = cvt_pk_bf16(acc[0], acc[1]); w.y = cvt_pk_bf16(acc[2], acc[3]);
            pend_w = w; pend_ptr = O + (size_t)t * 512 + h * 128 + sl * 32 + nt * 16 + quad * 4;
        }
        {
#pragma unroll
            for (int j = 0; j < 4; ++j) Sacc[j] *= DEC[mt * 16 + quad * 4 + j];
#pragma unroll
            for (int ks = 0; ks < 2; ++ks) { const bf16x8 a = ldfrag(KDT, 72, mt * 16, ks * 32, lane), b = ldfrag(VT, 72, nt * 16, ks * 32, lane); Sacc = MFMA16(a, b, Sacc); }
        }
        lds_barrier();
    }
    *(uint2*)pend_ptr = pend_w;
    if (s < 16) {
        float* so = p.out + (size_t)T_TOK * 1024 + ((size_t)((s * 2 + dir) * 4 + h) * 64) * 128;
#pragma unroll
        for (int j = 0; j < 4; ++j) so[(mt * 16 + quad * 4 + j) * 128 + sl * 32 + nt * 16 + l15] = Sacc[j];
    }
}

__device__ __forceinline__ void phase_mix_even(const Params& p, unsigned char* shm) {
    constexpr int N_GLA = 640, N_ALL = 1280;
    if (gridDim.x == 256) {
        if (blockIdx.x < 128) gla_item(p, shm, blockIdx.x);
        else for (int it = 128 + (blockIdx.x - 128); it < N_ALL; it += 128) { if (it < N_GLA) gla_item(p, shm, it); else sgu_item(p, shm, it - N_GLA); }
    } else {
        for (int it = blockIdx.x; it < N_ALL; it += gridDim.x) { if (it < N_GLA) gla_item(p, shm, it); else sgu_item(p, shm, it - N_GLA); }
    }
}

template <int PASS>
__device__ __forceinline__ void phase_rg(const Params& p, unsigned char* shm) {
    const int tid = otid(), lane = tid & 63, wid = tid >> 6, quad = lane >> 4, l15 = lane & 15;
    const bf16_t* rgp = (const bf16_t*)(p.ws + WS_BIG + BIG_RGP);
    unsigned short* WG = (unsigned short*)(shm);
    float* XC = (float*)(shm + 36864);
    float* AF = (float*)(shm + 53248); float* BF = AF + 4096; float* AB = BF + 4096; float* BB = AB + 4096;
    unsigned short* XCB = (unsigned short*)(shm + 118784);
    unsigned short* XB = (unsigned short*)(shm + 128000);
    float2* SG = (float2*)(shm + 136576);
    const int row = tid >> 3, c8 = (tid & 7) * 8;
    const int jt = wid & 3, tp = wid >> 2;
    int cur_hb = -1;
    float sp[2], ba[2], bx[2], cbv[8], cwv[4][8];
    u32x4 xreg = (u32x4){0, 0, 0, 0}, xreg2 = (u32x4){0, 0, 0, 0}, greg = (u32x4){0, 0, 0, 0};
    auto issue = [&](int item) {
        const int c = item >> 4, hb = item & 15, t0 = c * 64;
        const int s_lo = (t0 < T_PROMPT) ? (t0 & ~255) : (T_PROMPT + ((t0 - T_PROMPT) & ~4095));
        const int s_hi = s_lo + ((t0 < T_PROMPT) ? 256 : 4096);
        const int tt = t0 - 2 + row;
        xreg = (u32x4){0, 0, 0, 0};
        if (tt >= s_lo && tt < s_hi) xreg = *(const u32x4*)(rgp + (size_t)tt * 2048 + hb * 64 + c8);
        if (tid < 24) {
            const int t2 = t0 + 62 + (tid >> 3);
            xreg2 = (u32x4){0, 0, 0, 0};
            if (t2 >= s_lo && t2 < s_hi) xreg2 = *(const u32x4*)(rgp + (size_t)t2 * 2048 + hb * 64 + c8);
        }
        if (PASS == 1) greg = *(const u32x4*)(rgp + (size_t)(t0 + row) * 2048 + 1024 + hb * 64 + c8);
    };
    u32x4 pend_w = (u32x4){0, 0, 0, 0}; bf16_t* pend_ptr = nullptr; float pend_a = 0.f, pend_b = 0.f; float* pend_s = nullptr;
    int item = blockIdx.x;
    if (item < 5120) issue(item);
    for (; item < 5120; item += gridDim.x) {
        const int c = item >> 4, hb = item & 15, t0 = c * 64;
        if (hb != cur_hb) {
            lds_barrier();
            cur_hb = hb;
            const bf16_t* wg = (const bf16_t*)(p.ws + WS_WRGG) + (size_t)hb * 256 * 64;
#pragma unroll
            for (int i = 0; i < 4; ++i) { const int e = tid + 512 * i, r = e >> 3, cc = (e & 7) * 8; *(u32x4*)(WG + r * 72 + cc) = *(const u32x4*)(wg + r * 64 + cc); }
            const int gch = hb * 64 + jt * 16 + l15;
#pragma unroll
            for (int d = 0; d < 2; ++d) {
                const float lam = p.in[29][d * 1024 + gch];
                sp[d] = 8.0f * (fmaxf(-lam, 0.f) + __logf(1.0f + __expf(-fabsf(lam))));
                ba[d] = p.in[26][d * 1024 + gch]; bx[d] = p.in[28][d * 1024 + gch];
            }
#pragma unroll
            for (int j = 0; j < 8; ++j) { cbv[j] = p.in[24][hb * 64 + c8 + j];
#pragma unroll
                for (int tap = 0; tap < 4; ++tap) cwv[tap][j] = p.in[23][tap * 1024 + hb * 64 + c8 + j]; }
        }
        *(u32x4*)(XB + row * 64 + c8) = xreg;
        if (tid < 24) *(u32x4*)(XB + (64 + (tid >> 3)) * 64 + c8) = xreg2;
        const u32x4 gg = greg;
        if (PASS == 0) { if (pend_s) { pend_s[0] = pend_a; pend_s[1024] = pend_b; } } else { if (pend_ptr) *(u32x4*)pend_ptr = pend_w; }
        if (item + (int)gridDim.x < 5120) issue(item + gridDim.x);
        lds_barrier();
        {
            float xc[8];
#pragma unroll
            for (int j = 0; j < 8; ++j) xc[j] = cbv[j];
#pragma unroll
            for (int tap = 0; tap < 4; ++tap) {
                const u32x4 v = *(const u32x4*)(XB + (row + tap) * 64 + c8);
#pragma unroll
                for (int j = 0; j < 4; ++j) { xc[2 * j] += cwv[tap][2 * j] * bflo(v[j]); xc[2 * j + 1] += cwv[tap][2 * j + 1] * bfhi(v[j]); }
            }
            *(f32x4*)(XC + row * 64 + c8) = (f32x4){xc[0], xc[1], xc[2], xc[3]};
            *(f32x4*)(XC + row * 64 + c8 + 4) = (f32x4){xc[4], xc[5], xc[6], xc[7]};
            u32x4 w; w.x = cvt_pk_bf16(xc[0], xc[1]); w.y = cvt_pk_bf16(xc[2], xc[3]); w.z = cvt_pk_bf16(xc[4], xc[5]); w.w = cvt_pk_bf16(xc[6], xc[7]);
            *(u32x4*)(XCB + row * 72 + c8) = w;
        }
        lds_barrier();
        {
            f32x4 acc[2][4];
#pragma unroll
            for (int a = 0; a < 2; ++a)
#pragma unroll
                for (int b = 0; b < 4; ++b) acc[a][b] = (f32x4){0.f, 0.f, 0.f, 0.f};
#pragma unroll
            for (int ks = 0; ks < 2; ++ks) {
                const bf16x8 a0 = ldfrag(XCB, 72, (2 * tp) * 16, ks * 32, lane), a1 = ldfrag(XCB, 72, (2 * tp + 1) * 16, ks * 32, lane);
#pragma unroll
                for (int mat = 0; mat < 4; ++mat) { const bf16x8 b = ldfrag(WG, 72, mat * 64 + jt * 16, ks * 32, lane); acc[0][mat] = MFMA16(a0, b, acc[0][mat]); acc[1][mat] = MFMA16(a1, b, acc[1][mat]); }
            }
            const int ch = jt * 16 + l15;
#pragma unroll
            for (int t2 = 0; t2 < 2; ++t2)
#pragma unroll
                for (int j = 0; j < 4; ++j) {
                    const int tok = (2 * tp + t2) * 16 + quad * 4 + j;
                    const float x = XC[tok * 64 + ch];
#pragma unroll
                    for (int d = 0; d < 2; ++d) {
                        const float e1 = fexp(-(acc[t2][2 * d][j] + ba[d])), e2 = fexp(-(acc[t2][2 * d + 1][j] + bx[d]));
                        const float p1 = 1.0f + e1, p2 = 1.0f + e2, inv = __builtin_amdgcn_rcpf(p1 * p2);
                        const float r = p2 * inv, ig = p1 * inv;
                        const float a = fexp(-r * sp[d]);
                        const float bt = __builtin_amdgcn_sqrtf(fmaxf(1.0f - a * a, 0.f)) * ig * x;
                        (d ? AB : AF)[tok * 64 + ch] = a; (d ? BB : BF)[tok * 64 + ch] = bt;
                    }
                }
        }
        lds_barrier();
        {
            const int ch = tid & 63, d = (tid >> 6) & 1, q = tid >> 7;
            const float* Ap = d ? AB : AF; float* Bp = d ? BB : BF;
            float av[16], bv[16];
#pragma unroll
            for (int i = 0; i < 16; ++i) { const int st = q * 16 + i, tok = d ? 63 - st : st; av[i] = Ap[tok * 64 + ch]; bv[i] = Bp[tok * 64 + ch]; }
            float A = 1.f, B = 0.f;
#pragma unroll
            for (int i = 0; i < 16; ++i) { B = av[i] * B + bv[i]; A *= av[i]; }
            SG[(q * 2 + d) * 64 + ch] = make_float2(A, B);
            lds_barrier();
            if (PASS == 0) {
                if (q == 0) {
                    float A2 = 1.f, B2 = 0.f;
#pragma unroll
                    for (int k = 0; k < 4; ++k) { const float2 sg = SG[(k * 2 + d) * 64 + ch]; B2 = sg.x * B2 + sg.y; A2 *= sg.x; }
                    pend_s = (float*)(p.ws + WS_BIG + BIG_RGSUM) + (size_t)(c * 2 + d) * 2048 + hb * 64 + ch; pend_a = A2; pend_b = B2;
                }
            } else {
                float hcur = ((const float*)(p.ws + WS_BIG + BIG_RGCAR))[(size_t)(c * 2 + d) * 1024 + hb * 64 + ch];
                for (int k = 0; k < q; ++k) { const float2 sg = SG[(k * 2 + d) * 64 + ch]; hcur = sg.x * hcur + sg.y; }
#pragma unroll
                for (int i = 0; i < 16; ++i) { const int st = q * 16 + i, tok = d ? 63 - st : st; hcur = av[i] * hcur + bv[i]; Bp[tok * 64 + ch] = hcur; }
            }
        }
        if (PASS == 1) {
            lds_barrier();
            {
                const int t = t0 + row;
                const f32x4 f0 = *(const f32x4*)(BF + row * 64 + c8), f1 = *(const f32x4*)(BF + row * 64 + c8 + 4);
                const f32x4 b0 = *(const f32x4*)(BB + row * 64 + c8), b1 = *(const f32x4*)(BB + row * 64 + c8 + 4);
                u32x4 w;
                w.x = cvt_pk_bf16((f0[0] + b0[0]) * bflo(gg[0]), (f0[1] + b0[1]) * bfhi(gg[0]));
                w.y = cvt_pk_bf16((f0[2] + b0[2]) * bflo(gg[1]), (f0[3] + b0[3]) * bfhi(gg[1]));
                w.z = cvt_pk_bf16((f1[0] + b1[0]) * bflo(gg[2]), (f1[1] + b1[1]) * bfhi(gg[2]));
                w.w = cvt_pk_bf16((f1[2] + b1[2]) * bflo(gg[3]), (f1[3] + b1[3]) * bfhi(gg[3]));
                pend_w = w; pend_ptr = (bf16_t*)(p.ws + WS_ABUF) + (size_t)t * 1024 + hb * 64 + c8;
            }
        }
    }
    if (PASS == 0) { if (pend_s) { pend_s[0] = pend_a; pend_s[1024] = pend_b; } } else { if (pend_ptr) *(u32x4*)pend_ptr = pend_w; }
    lds_barrier();
}

__device__ __forceinline__ void phase_rg_carry(const Params& p) {
    const int idx = blockIdx.x * 512 + otid();
    for (int e = idx; e < 20 * 2 * 1024; e += gridDim.x * 512) {
        const int s = e >> 11, d = (e >> 10) & 1, ch = e & 1023;
        const int nc = (s < 16) ? 4 : 64, cbase = (s < 16) ? s * 4 : 64 + (s - 16) * 64;
        const float* sum = (const float*)(p.ws + WS_BIG + BIG_RGSUM);
        float* car = (float*)(p.ws + WS_BIG + BIG_RGCAR);
        float h = (s < 16) ? 0.f : p.in[4][((s - 16) * 2 + d) * 1024 + ch];
        for (int n0 = 0; n0 < nc; n0 += 4) {
            float A[4], B[4];
#pragma unroll
            for (int j = 0; j < 4; ++j) { const int n = d ? (nc - 1 - (n0 + j)) : (n0 + j); const float* sp = sum + (size_t)((cbase + n) * 2 + d) * 2048 + ch; A[j] = sp[0]; B[j] = sp[1024]; }
#pragma unroll
            for (int j = 0; j < 4; ++j) { const int n = d ? (nc - 1 - (n0 + j)) : (n0 + j); car[(size_t)((cbase + n) * 2 + d) * 1024 + ch] = h; h = A[j] * h + B[j]; }
        }
        if (s < 16) p.out[(size_t)T_TOK * 1024 + 1048576 + (s * 2 + d) * 1024 + ch] = h;
    }
}

#define XB_TMO      128
#define XB_XCNT(j)  (256  + 64 * (j))
#define XB_XSUB(j)  (1280 + 64 * (j))
#define XB_XGEN(j)  (2304 + 64 * (j))
#define XB_TOP      3328
#define XB_TOPGEN   3392
#define XCD_BAR_WORDS 3456
#define XB_SPIN_CAP (1u << 18)
#define LAS __attribute__((address_space(3)))

__device__ __forceinline__ unsigned xb_ld(unsigned* p)              { return __hip_atomic_load(p, __ATOMIC_RELAXED, __HIP_MEMORY_SCOPE_AGENT); }
__device__ __forceinline__ unsigned xb_add(unsigned* p, unsigned v) { return __hip_atomic_fetch_add(p, v, __ATOMIC_RELAXED, __HIP_MEMORY_SCOPE_AGENT); }
__device__ __forceinline__ unsigned xb_xcc_id() { return (unsigned)__builtin_amdgcn_s_getreg((3 << 11) | 20) & 0xFu; }
#define XB_SPIN(cond, bar) do { unsigned _sp = 0; while (cond) { __builtin_amdgcn_s_sleep(1); \
    if ((++_sp & 255u) == 0u) { if (xb_ld(&(bar)[XB_TMO])) break; if (_sp > XB_SPIN_CAP) { atomicAdd(&(bar)[XB_TMO], 1u); break; } } } } while (0)

struct XcdBarrier {
    unsigned* bar; unsigned x;
    volatile LAS unsigned* st;
};

__device__ __forceinline__ XcdBarrier xcd_barrier_post(unsigned* bar, volatile LAS unsigned* st) {
    XcdBarrier b; b.bar = bar; b.x = xb_xcc_id(); b.st = st;
    if (threadIdx.x == 0) (void)xb_add(&bar[XB_XCNT(b.x)], 1u);
    return b;
}
__device__ __forceinline__ void xcd_barrier_complete(unsigned* bar, unsigned x, unsigned& nloc, unsigned& nx) {
    const unsigned G = gridDim.x * gridDim.y * gridDim.z;
    unsigned sum, cnt, mine, sp = 0u;
    for (;;) {
        sum = 0u; cnt = 0u; mine = 0u;
#pragma unroll
        for (unsigned j = 0; j < 16; ++j) { const unsigned c = xb_ld(&bar[XB_XCNT(j)]); sum += c; cnt += (c > 0u) ? 1u : 0u; mine = (j == x) ? c : mine; }
        if (sum == G) break;
        __builtin_amdgcn_s_sleep(1);
        if ((++sp & 255u) == 0u) { if (xb_ld(&bar[XB_TMO])) break; if (sp > XB_SPIN_CAP) { atomicAdd(&bar[XB_TMO], 1u); break; } }
    }
    nloc = mine > 0u ? mine : 1u; nx = cnt > 0u ? cnt : 1u;
}

__device__ __forceinline__ void xcd_barrier(const XcdBarrier& b) {
    asm volatile("s_waitcnt vmcnt(0)" ::: "memory");
    __syncthreads();
    if (threadIdx.x == 0) {
        unsigned* bar = b.bar;
        __builtin_amdgcn_s_waitcnt(0);
        unsigned nloc = b.st[0], nx = b.st[1];
        if (nloc == 0u) { xcd_barrier_complete(bar, b.x, nloc, nx); b.st[0] = nloc; b.st[1] = nx; }
        const unsigned old = xb_add(&bar[XB_XSUB(b.x)], 1u);
        const unsigned gen = old / nloc;
        if (old + 1u == (gen + 1u) * nloc) {
            __builtin_amdgcn_fence(__ATOMIC_RELEASE, "agent");
            asm volatile("s_waitcnt vmcnt(0)" ::: "memory");
            const unsigned og = xb_add(&bar[XB_TOP], 1u);
            const unsigned tg = og / nx;
            if (og + 1u == (tg + 1u) * nx) xb_add(&bar[XB_TOPGEN], 1u);
            else XB_SPIN(xb_ld(&bar[XB_TOPGEN]) == tg, bar);
            __builtin_amdgcn_fence(__ATOMIC_ACQUIRE, "agent");
            xb_add(&bar[XB_XGEN(b.x)], 1u);
            asm volatile("s_waitcnt vmcnt(0)" ::: "memory");
        } else {
            XB_SPIN(xb_ld(&bar[XB_XGEN(b.x)]) == gen, bar);
            __builtin_amdgcn_fence(__ATOMIC_ACQUIRE, "agent");
            asm volatile("s_waitcnt vmcnt(0)" ::: "memory");
        }
    }
    __syncthreads();
}

constexpr size_t WS_CNT = WS_BAR + 14336;
__device__ __forceinline__ void xcd_arrive(unsigned* xcnt, unsigned* gcnt, const XcdBarrier& xb) {
    asm volatile("s_waitcnt vmcnt(0)" ::: "memory");
    __syncthreads();
    if (threadIdx.x == 0) {
        const unsigned nloc = xb.st[0];
        const unsigned old = __hip_atomic_fetch_add(xcnt + xb.x, 1u, __ATOMIC_RELAXED, __HIP_MEMORY_SCOPE_AGENT);
        if (old + 1u == nloc) {
            __builtin_amdgcn_fence(__ATOMIC_RELEASE, "agent");
            asm volatile("s_waitcnt vmcnt(0)" ::: "memory");
            __hip_atomic_fetch_add(gcnt, nloc, __ATOMIC_RELAXED, __HIP_MEMORY_SCOPE_AGENT);
        }
    }
}
__device__ __forceinline__ void wg_wait(unsigned* cnt, unsigned need) {
    if (threadIdx.x == 0) {
        unsigned sp = 0;
        while (__hip_atomic_load(cnt, __ATOMIC_RELAXED, __HIP_MEMORY_SCOPE_AGENT) < need) { __builtin_amdgcn_s_sleep(2); if (++sp > (1u << 22)) break; }
        __builtin_amdgcn_fence(__ATOMIC_ACQUIRE, "agent");
        asm volatile("s_waitcnt vmcnt(0)" ::: "memory");
    }
    __syncthreads();
}

__device__ __forceinline__ void run_phase(const Params& p, unsigned char* shm, int ph, int dbg, const XcdBarrier& xb) {
    const float* MOD = (const float*)(p.ws + WS_MOD);
    const float* NG = p.in[8];
    bf16_t* ABUF = (bf16_t*)(p.ws + WS_ABUF);
    unsigned char* BIG = p.ws + WS_BIG;
    const bool is_gemm = (ph == 2) | (ph == 5) | (ph == 7) | (ph == 8) | (ph == 10) | (ph == 14) | (ph == 16) | (ph == 17);
    if (is_gemm) {
        EpiGen E; const bf16_t* A = ABUF; const bf16_t* Bt; int N, K = 1024;
        E.bias = nullptr;
        if (ph == 2) { E.mode = 0; E.O = BIG + BIG_PROJ; E.ldc = EVN; E.ncols = EVN; Bt = (const bf16_t*)(p.ws + WS_WEVIN); N = EVNP; }
        else if (ph == 5) { E.mode = 5; E.O = BIG + BIG_Y; E.ldc = 1024; E.ncols = 1024; Bt = (const bf16_t*)(p.ws + WS_WEVOUT); N = 1024; }
        else if (ph == 14) { E.mode = 5; E.O = BIG + BIG_Y; E.ldc = 1024; E.ncols = 1024; Bt = (const bf16_t*)(p.ws + WS_WRGOUT); N = 1024; }
        else if (ph == 10) { E.mode = 3; E.O = BIG + BIG_RGP; E.ldc = 2048; E.ncols = 2048; Bt = (const bf16_t*)(p.ws + WS_WRGIN); N = 2048; }
        else if (ph == 7 || ph == 16) { const int l = (ph == 16); E.mode = 1; E.O = BIG + BIG_H; E.ldc = 4096; E.ncols = 4096; E.bias = p.in[10] + l * 4096; Bt = (const bf16_t*)(p.ws + WS_WMLP1) + (size_t)l * 4096 * 1024; N = 4096; }
        else { const int l = (ph == 17); E.mode = 2; E.O = ABUF; E.ldc = 1024; E.ncols = 1024; E.bias = p.in[12] + l * 1024; A = (const bf16_t*)(BIG + BIG_H); Bt = (const bf16_t*)(p.ws + WS_WMLP2) + (size_t)l * 1024 * 4096; N = 1024; K = 4096; }
        if ((E.mode == 2 || E.mode == 5) && gridDim.x == 256) {
            unsigned* xcA = (unsigned*)(p.ws + WS_CNT) + 128 * (ph == 5 ? 0 : ph == 8 ? 1 : ph == 14 ? 2 : 3);
            unsigned* cntA = xcA + 64;
            const int nb = (E.mode == 2) ? 128 : 64;
            const int hsplit = 16384;
            run_gemm(shm, A, Bt, 16384, 1024, K, K, 256, (int)blockIdx.x, E);
            xcd_arrive(xcA, cntA, xb);
            if ((int)blockIdx.x < nb) {
                if (E.mode == 2) {
                    const int sp = blockIdx.x & 1;
                    EpiGen E2 = E;
                    E2.O = sp ? (void*)(p.ws + WS_SCR) : (void*)((bf16_t*)E.O + (size_t)16384 * 1024);
                    E2.bias = sp ? nullptr : E.bias;
                    run_gemm(shm, A + (size_t)16384 * 4096 + sp * 2048, Bt + sp * 2048, 4096, 1024, 2048, 4096, 64, (int)(blockIdx.x >> 1), E2);
                } else {
                    EpiGen E2 = E; E2.O = (void*)((bf16_t*)E.O + (size_t)16384 * 1024);
                    run_gemm(shm, A + (size_t)16384 * 1024, Bt, 4096, 1024, 1024, 1024, 64, (int)blockIdx.x, E2);
                }
            } else {
                wg_wait(cntA, 256u);
                const int w0 = nb * 8, nwv = (256 - nb) * 8;
                if (ph == 5) phase_row<2, true, true, true>(p, BIG + BIG_Y, NG + 1 * 1024, MOD + 2048, NG + 2 * 1024, MOD, 3072, 4096, false, 0, hsplit, w0, nwv);
                else if (ph == 8) phase_row<2, true>(p, ABUF, NG + 3 * 1024, MOD + 5120, NG + 4 * 1024, MOD + 5 * 6144, 0, 1024, true, 0, hsplit, w0, nwv);
                else if (ph == 14) phase_row<2, true>(p, BIG + BIG_Y, NG + 5 * 1024, MOD + 5 * 6144 + 2048, NG + 6 * 1024, MOD + 5 * 6144, 3072, 4096, false, 0, hsplit, w0, nwv);
                else phase_row<2, false>(p, ABUF, NG + 7 * 1024, MOD + 5 * 6144 + 5120, nullptr, nullptr, 0, 0, true, 0, hsplit, w0, nwv);
            }
            xcd_barrier(xb);
            if (ph == 5) phase_row<2, true, true, true>(p, BIG + BIG_Y, NG + 1 * 1024, MOD + 2048, NG + 2 * 1024, MOD, 3072, 4096, false, hsplit, T_TOK, 0, 0);
            else if (ph == 8) phase_row<2, true>(p, ABUF, NG + 3 * 1024, MOD + 5120, NG + 4 * 1024, MOD + 5 * 6144, 0, 1024, true, hsplit, T_TOK, 0, 0);
            else if (ph == 14) phase_row<2, true>(p, BIG + BIG_Y, NG + 5 * 1024, MOD + 5 * 6144 + 2048, NG + 6 * 1024, MOD + 5 * 6144, 3072, 4096, false, hsplit, T_TOK, 0, 0);
            else phase_row<2, false>(p, ABUF, NG + 7 * 1024, MOD + 5 * 6144 + 5120, nullptr, nullptr, 0, 0, true, hsplit, T_TOK, 0, 0);
            return;
        }
        run_gemm(shm, A, Bt, T_TOK, N, K, K, (int)gridDim.x, (int)blockIdx.x, E);
        if (gridDim.x == 256) {
            if (ph == 2 && blockIdx.x >= 112) for (int d = (int)blockIdx.x - 112; d < 704; d += 144) convert_weight_tile(p, (float*)shm, deferred1_tile(d));
            if (ph == 10 && blockIdx.x >= 128) for (int d = (int)blockIdx.x - 128; d < 512; d += 128) convert_weight_tile(p, (float*)shm, deferred2_tile(d));
        }
        return;
    }
    switch (ph) {
    case 0: phase_prep(p, shm); break;
    case 1: phase_row<0, true, false, false>(p, nullptr, nullptr, nullptr, NG + 0 * 1024, MOD, 0, 1024, false); break;
    case 3: phase_mix_even(p, shm); break;
#ifdef EXTRA_PH
    case 60: if (blockIdx.x < 128) gla_item(p, shm, blockIdx.x); break;
    case 61: if (blockIdx.x >= 128) for (int it = blockIdx.x; it < 1280; it += 128) { if (it < 640) gla_item(p, shm, it); else sgu_item(p, shm, it - 640); } break;
    case 62: if (blockIdx.x >= 128) for (int it = blockIdx.x; it < 640; it += 128) gla_item(p, shm, it); break;
#endif
    case 4: phase_gla_combine(p); break;
    case 6: phase_row<2, true, true, true>(p, BIG + BIG_Y, NG + 1 * 1024, MOD + 2048, NG + 2 * 1024, MOD, 3072, 4096, false); break;
    case 9: phase_row<2, true>(p, ABUF, NG + 3 * 1024, MOD + 5120, NG + 4 * 1024, MOD + 5 * 6144, 0, 1024, true); break;
    case 11: phase_rg<0>(p, shm); break;
    case 12: phase_rg_carry(p); break;
    case 13: phase_rg<1>(p, shm); break;
    case 15: phase_row<2, true>(p, BIG + BIG_Y, NG + 5 * 1024, MOD + 5 * 6144 + 2048, NG + 6 * 1024, MOD + 5 * 6144, 3072, 4096, false); break;
    case 18: phase_row<2, false>(p, ABUF, NG + 7 * 1024, MOD + 5 * 6144 + 5120, nullptr, nullptr, 0, 0, true); break;
#ifdef DBG_PROBE
    case 97: {
        const int k = dbg;
        unsigned* flag = (unsigned*)(p.ws + WS_END);
        bool bad = false;
        const size_t g0 = (size_t)blockIdx.x * 512 + otid(), gs = (size_t)gridDim.x * 512;
        for (size_t i = g0; i < (size_t)T_TOK * 1024; i += gs) { if (!(fabsf(p.out[i]) < 1e30f)) bad = true; }
        if (k >= 1) for (size_t i = g0; i < (size_t)T_TOK * 1024; i += gs) { if ((((const unsigned short*)(p.ws + WS_ABUF))[i] & 0x7f80u) == 0x7f80u) bad = true; }
        const unsigned char* b = nullptr; size_t n = 0; bool f32 = false;
        if (k == 0) { b = p.ws + WS_MOD; n = 61440; f32 = true; }
        else if (k == 2) { b = BIG + BIG_PROJ; n = (size_t)T_TOK * EVN; }
        else if (k == 3) { b = BIG + BIG_OF; n = (size_t)T_TOK * 1024; }
        else if (k == 5 || k == 14) { b = BIG + BIG_Y; n = (size_t)T_TOK * 1024; f32 = true; }
        else if (k == 7 || k == 16) { b = BIG + BIG_H; n = (size_t)T_TOK * 4096; }
        else if (k == 10) { b = BIG + BIG_RGP; n = (size_t)T_TOK * 2048; }
        else if (k == 11) { b = BIG + BIG_RGSUM; n = (size_t)320 * 4096; f32 = true; }
        else if (k == 12) { b = BIG + BIG_RGCAR; n = (size_t)320 * 2048; f32 = true; }
        for (size_t i = g0; i < n; i += gs) { if (f32) { if (!(fabsf(((const float*)b)[i]) < 1e30f)) bad = true; } else { if ((((const unsigned short*)b)[i] & 0x7f80u) == 0x7f80u) bad = true; } }
        if (bad) atomicMin(flag, (unsigned)k);
    } break;
    case 95: {
        unsigned* flag = (unsigned*)(p.ws + WS_END);
        unsigned code = 0;
        const size_t g0 = (size_t)blockIdx.x * 512 + otid(), gs = (size_t)gridDim.x * 512;
        const unsigned short* ab = (const unsigned short*)(p.ws + WS_ABUF);
        const unsigned short* of = (const unsigned short*)(BIG + BIG_OF);
        const unsigned short* ob = (const unsigned short*)(BIG + BIG_OB);
        for (size_t i = g0; i < (size_t)T_TOK * 512; i += gs) {
            const size_t t = i >> 9, c = i & 511;
            unsigned cc = 0;
            if ((ab[t * 1024 + c] & 0x7f80u) == 0x7f80u) cc |= 1u;
            if ((of[i] & 0x7f80u) == 0x7f80u) cc |= 2u;
            if ((ob[i] & 0x7f80u) == 0x7f80u) cc |= 4u;
            if (cc) cc |= (t < T_PROMPT) ? 8u : 16u;
            code |= cc;
        }
        if (dbg >= 100) { if (code & 6u) atomicOr(flag + 1, 1u << (dbg - 100)); } else if (code) atomicOr(flag + 1, code);
    } break;
    case 94: {
        const unsigned f = ((const unsigned*)(p.ws + WS_END))[1];
        const float v = 1000.0f * (float)(f + 1);
        for (size_t i = (size_t)blockIdx.x * 512 + otid(); i < (size_t)22052864; i += (size_t)gridDim.x * 512) p.out[i] = v;
    } break;
    case 93: break;
    case 96: {
        const unsigned f = *(const unsigned*)(p.ws + WS_END);
        const float v = (f > 100u) ? 50000.0f : 1000.0f * (float)(f + 1);
        for (size_t i = (size_t)blockIdx.x * 512 + otid(); i < (size_t)22052864; i += (size_t)gridDim.x * 512) p.out[i] = v;
    } break;
    case 98: {
        for (size_t i = (size_t)blockIdx.x * 512 + otid(); i < (size_t)22052864; i += (size_t)gridDim.x * 512) {
            const float v = p.out[i];
            if (!(fabsf(v) < 1e30f)) p.out[i] = 12345.0f;
        }
    } break;
    case 99: {
        const unsigned short* a = (const unsigned short*)p.ws;
        const size_t NOUT = 22052864, NW = WS_END / 2;
        for (size_t i = (size_t)blockIdx.x * 512 + otid(); i < NOUT; i += (size_t)gridDim.x * 512) {
            unsigned s = (i < (size_t)T_TOK * 1024) ? ((__float_as_uint(p.out[i]) >> 8) & 0xffffu) : 0u;
            for (int j = 0; j < 6; ++j) { const size_t idx = i + (size_t)j * NOUT; if (idx < NW) s += a[idx]; }
            p.out[i] = (float)s;
        }
    } break;
#endif
    default: break;
    }
}

__global__ void __launch_bounds__(512, 2) fwd_megakernel(Params p) {
    extern __shared__ __attribute__((aligned(16))) unsigned char shm[];
    cg::grid_group grid = cg::this_grid();
    volatile LAS unsigned* st = (volatile LAS unsigned*)(shm + LDS_BYTES - 16);
    if (threadIdx.x < 4) st[threadIdx.x] = 0u;
    __syncthreads();
    if (blockIdx.x == 0) { unsigned* bw = (unsigned*)(p.ws + WS_BAR); for (int i = threadIdx.x; i < 4096; i += 512) bw[i] = 0u; }
    XcdBarrier xb; xb.bar = (unsigned*)(p.ws + WS_BAR); xb.x = xb_xcc_id(); xb.st = st;
    for (int i = 0; i < p.nseq; ++i) {
        if (i == 1) { grid.sync(); if (threadIdx.x == 0) (void)xb_add(&xb.bar[XB_XCNT(xb.x)], 1u); }
        else if (i > 1) xcd_barrier(xb);
        run_phase(p, shm, (int)p.seq[i], (int)p.dbgv[i], xb);
    }
}

extern "C" void kernel_launch(void* const* d_in, const int* in_sizes, int n_in, void* d_out, int out_size, void* d_ws, size_t ws_size, hipStream_t stream) {
    static int grid_blocks = 0;
    if (!grid_blocks) {
        int dev = 0, cus = 0, per_cu = 0;
        hipGetDevice(&dev);
        hipDeviceGetAttribute(&cus, hipDeviceAttributeMultiprocessorCount, dev);
        hipFuncSetAttribute((const void*)fwd_megakernel, hipFuncAttributeMaxDynamicSharedMemorySize, LDS_BYTES);
        hipOccupancyMaxActiveBlocksPerMultiprocessor(&per_cu, (const void*)fwd_megakernel, 512, LDS_BYTES);
        if (per_cu < 1) { fprintf(stderr, "kernel_launch: occupancy query reports %d blocks per CU\n", per_cu); per_cu = 1; }
        if (per_cu > 1) per_cu = 1;
        grid_blocks = cus * per_cu;
        if (ws_size < WS_END) fprintf(stderr, "kernel_launch: workspace too small: %zu < %zu\n", ws_size, (size_t)WS_END);
    }
    Params p{};
    for (int i = 0; i < 31; ++i) p.in[i] = (const float*)d_in[i];
    p.out = (float*)d_out; p.ws = (unsigned char*)d_ws;
    int n = 0;
#if defined(DBG_PROBE) && DBG_PROBE == 1
    hipMemsetAsync((char*)d_ws + WS_END, 0xff, 16, stream);
    for (int ph = 0; ph < NPHASE; ++ph) { p.seq[n] = (unsigned char)ph; p.dbgv[n++] = 0; p.seq[n] = 97; p.dbgv[n++] = (unsigned char)ph; }
    p.seq[n] = 96; p.dbgv[n++] = 0;
#elif defined(DBG_PROBE) && DBG_PROBE == 3
    hipMemsetAsync((char*)d_ws + WS_END, 0xff, 16, stream);
    for (int ph = 0; ph < 4; ++ph) { p.seq[n] = (unsigned char)ph; p.dbgv[n++] = 0; }
    p.seq[n] = 97; p.dbgv[n++] = 3; p.seq[n] = 96; p.dbgv[n++] = 0;
#elif defined(DBG_PROBE) && DBG_PROBE == 2
    hipMemsetAsync((char*)d_ws + WS_END, 0, 16, stream);
    for (int ph = 0; ph < 4; ++ph) { p.seq[n] = (unsigned char)ph; p.dbgv[n++] = 0; }
    p.seq[n] = DBG_P4; p.dbgv[n++] = 0; p.seq[n] = 94; p.dbgv[n++] = 0;
#else
    for (int ph = 0; ph < NPHASE; ++ph) {
        if (grid_blocks == 256 && (ph == 6 || ph == 9 || ph == 15 || ph == 18)) continue;
        p.seq[n] = (unsigned char)ph; p.dbgv[n++] = 0;
#ifdef EXTRA_PH
        if (ph == 3) { p.seq[n] = EXTRA_PH; p.dbgv[n++] = 0; }
#endif
#ifdef EXTRA_SYNCS
        if (ph == 5) for (int q = 0; q < EXTRA_SYNCS; ++q) { p.seq[n] = 50; p.dbgv[n++] = 0; }
#endif
#ifdef DUP_MASK
        if ((DUP_MASK >> ph) & 1) { p.seq[n] = (unsigned char)ph; p.dbgv[n++] = 0; }
#endif
    }
#endif
    p.nseq = n;
    void* args[] = {&p};
    hipError_t e = hipLaunchCooperativeKernel((const void*)fwd_megakernel, dim3(grid_blocks), dim3(512), args, LDS_BYTES, stream);
    if (e != hipSuccess) fprintf(stderr, "cooperative launch failed: %s (grid %d)\n", hipGetErrorString(e), grid_blocks);
}
```

```cpp
#include <hip/hip_runtime.h>
#include <hip/hip_cooperative_groups.h>
#include <cstdio>
namespace pg8 {
#define PG8_LAS __attribute__((address_space(3)))
typedef unsigned short bf16_t;
typedef short bf16x8 __attribute__((ext_vector_type(8)));
typedef float f32x4 __attribute__((ext_vector_type(4)));
typedef unsigned u32x4 __attribute__((ext_vector_type(4)));
constexpr int BM = 256, BK = 64, HALF = 128, HTB = HALF * BK * 2  , STAGE_BYTES = 8 * HTB, NXCD = 8, WGM = 8;

__host__ __device__ __forceinline__ int lds_byte(int r, int c) { const int st = (r >> 4) * 2 + (c >> 5), rr = r & 15, cc = c & 31, ob = rr * 64 + cc * 2; return st * 1024 + (ob ^ (((ob >> 9) & 1) << 5)); }
__host__ __device__ __forceinline__ void stage_rc(int b, int& R, int& C) { const int st = b / 1024, sb = b % 1024, swz = sb ^ (((sb >> 9) & 1) << 5); R = (st >> 1) * 16 + swz / 64; C = (st & 1) * 32 + (swz % 64) / 2; }
__host__ __device__ __forceinline__ int perm32(int rho) { const int n = rho >> 4, i = rho & 15; return 8 * (i >> 2) + 4 * n + (i & 3); }

struct Unit { int pm, pn; };
struct Gemm { const bf16_t* A; const bf16_t* Bt; int M, N, K, ld; };

struct StaticOrder {
    int nM, nN, nwg, G, c;
    __host__ __device__ void init(int M, int N, int G_, int c_) { nM = M / BM; nN = N / BM; nwg = nM * nN; G = G_; c = c_; }
    __host__ __device__ bool next(int i, Unit& u) const {
        const long L = (long)i * G + c; if (L >= nwg) return false;
        int wgid = (int)L; { const int q = nwg / NXCD, r = nwg % NXCD, xcd = wgid % NXCD, off = wgid / NXCD; wgid = (xcd < r ? xcd * (q + 1) : r * (q + 1) + (xcd - r) * q) + off; }
        const int nig = WGM * nN, gid = wgid / nig, fm = gid * WGM, gsz = (nM - fm) < WGM ? (nM - fm) : WGM;
        u.pm = fm + ((wgid % nig) % gsz); u.pn = (wgid % nig) / gsz; return true;
    }
    __device__ __forceinline__ void a_ready(const Unit&) const {}
    __device__ __forceinline__ void done(const Unit&) const {}
};
typedef __bf16 bf16x2_n __attribute__((ext_vector_type(2)));
typedef float f32x2_n __attribute__((ext_vector_type(2)));
__device__ __forceinline__ unsigned cvt_pk_bf16(float lo, float hi) { f32x2_n v = {lo, hi}; bf16x2_n b = __builtin_convertvector(v, bf16x2_n); return __builtin_bit_cast(unsigned, b); }
typedef float f32x2 __attribute__((ext_vector_type(2)));
template <class Epi, class Sched, bool STAMP = false>
__device__ __forceinline__ void gemm_phase(PG8_LAS unsigned char* lds, const Gemm g, const Sched& S, const Epi& E, unsigned long long* stamps) {
    int tid_o = threadIdx.x; asm volatile("" : "+v"(tid_o)); const int tid = tid_o, wid = __builtin_amdgcn_readfirstlane(tid >> 6), lane = tid & 63, wr = wid >> 2, wc = wid & 3, fr = lane & 15, fq = lane >> 4;
    const int K = g.ld, nt = g.K / BK;
    int ts_lo = 0, ts_hi = 0, nts = 0; const unsigned long long rt_entry = STAMP ? (unsigned long long)wall_clock64() : 0ull;
#define PG8_STAMP() do { if (STAMP && wid == 0 && nts < 64) { const unsigned long long _c = (unsigned long long)clock64(); \
        ts_lo = (lane == nts) ? (int)(unsigned)_c : ts_lo; ts_hi = (lane == nts) ? (int)(unsigned)(_c >> 32) : ts_hi; ++nts; } } while (0)
    PG8_STAMP();
    unsigned voffA[2], voffB[2];
#pragma unroll
    for (int i = 0; i < 2; ++i) { int R, C; stage_rc(tid * 16 + i * 8192, R, C); const int Rb = Epi::PERM ? ((R & ~31) + perm32(R & 31)) : R;
        voffA[i] = (unsigned)(R * K + C) * 2u; voffB[i] = (unsigned)(Rb * K + C) * 2u; }
    const size_t kstep = (size_t)(BK * 2);
    const size_t hstep = (size_t)HALF * K * 2;
    const size_t tstep = 2 * hstep;
    const unsigned ldsw = (unsigned)wid * 1024u;
    const int aoff = lds_byte(wr * 64 + fr, fq * 8), boff = lds_byte(wc * 32 + fr, fq * 8);
#define PG8_SA(b, h) (((b) * 2 + (h)) * HTB)
#define PG8_SB(b, h) ((4 + (b) * 2 + (h)) * HTB)
#define PG8_STAGE(bufoff, gbase, voff) do { _Pragma("unroll") for (int _i = 0; _i < 2; ++_i) \
        __builtin_amdgcn_global_load_lds((const unsigned*)((const char*)(gbase) + (voff)[_i]), (PG8_LAS unsigned*)(lds + (bufoff) + ldsw + _i * 8192), 16, 0, 0); } while (0)
#define PG8_LDA(dst, b, h) do { _Pragma("unroll") for (int m = 0; m < 4; ++m) _Pragma("unroll") for (int k = 0; k < 2; ++k) dst[m][k] = *(const PG8_LAS bf16x8*)(lds + PG8_SA(b, h) + aoff + m * 2048 + k * 1024); } while (0)
#define PG8_LDB(dst, b, h) do { _Pragma("unroll") for (int n = 0; n < 2; ++n) _Pragma("unroll") for (int k = 0; k < 2; ++k) dst[n][k] = *(const PG8_LAS bf16x8*)(lds + PG8_SB(b, h) + boff + n * 2048 + k * 1024); } while (0)
#define PG8_MMA(ai, bj, At, Bt) do { __builtin_amdgcn_s_setprio(1); _Pragma("unroll") for (int m = 0; m < 4; ++m) _Pragma("unroll") for (int n = 0; n < 2; ++n) _Pragma("unroll") for (int k = 0; k < 2; ++k) \
        acc[ai][bj][m][n] = __builtin_amdgcn_mfma_f32_16x16x32_bf16(Bt[n][k], At[m][k], acc[ai][bj][m][n], 0, 0, 0); __builtin_amdgcn_s_setprio(0); } while (0)
#define PG8_WAIT_V(n) asm volatile("s_waitcnt vmcnt(" #n ")" ::: "memory")
#define PG8_WAIT_L(n) asm volatile("s_waitcnt lgkmcnt(" #n ")" ::: "memory")
#define PG8_BAR __builtin_amdgcn_s_barrier()
#define PG8_SCHED __builtin_amdgcn_sched_barrier(0)
    Unit cur, nxt; int ui = 0;
    if (!S.next(0, cur)) return;
    f32x4 acc[2][2][4][2];
#pragma unroll
    for (int a = 0; a < 2; ++a)
#pragma unroll
        for (int b = 0; b < 2; ++b)
#pragma unroll
            for (int m = 0; m < 4; ++m)
#pragma unroll
                for (int n = 0; n < 2; ++n) acc[a][b][m][n] = (f32x4){0.f, 0.f, 0.f, 0.f};
    bf16x8 At[4][2], B0[2][2], B1[2][2];
    const char* cA = (const char*)g.A + (size_t)cur.pm * tstep; const char* cB = (const char*)g.Bt + (size_t)cur.pn * tstep;
    S.a_ready(cur);
    PG8_STAGE(PG8_SB(0, 0), cB, voffB); PG8_STAGE(PG8_SA(0, 0), cA, voffA); PG8_STAGE(PG8_SB(0, 1), cB + hstep, voffB); PG8_STAGE(PG8_SA(0, 1), cA + hstep, voffA);
    if (wr == 1) PG8_BAR;
    PG8_WAIT_V(4); PG8_BAR;
    PG8_STAGE(PG8_SB(1, 0), cB + kstep, voffB); PG8_STAGE(PG8_SA(1, 0), cA + kstep, voffA); PG8_STAGE(PG8_SB(1, 1), cB + hstep + kstep, voffB);
    PG8_WAIT_V(6); PG8_BAR;
    PG8_STAMP();
    for (;;) {
        const bool has_next = S.next(ui + 1, nxt);
        const char* nA = has_next ? (const char*)g.A + (size_t)nxt.pm * tstep : cA; const char* nB = has_next ? (const char*)g.Bt + (size_t)nxt.pn * tstep : cB;
        for (int t = 0; t < nt; t += 2) {
            const bool last = (t == nt - 2);
            const char* a1 = cA + (size_t)(t + 1) * kstep;
            const char* a2 = last ? nA : cA + (size_t)(t + 2) * kstep; const char* b2 = last ? nB : cB + (size_t)(t + 2) * kstep;
            const char* a3 = a2 + kstep; const char* b3 = b2 + kstep;
            if (last && has_next) S.a_ready(nxt);
            PG8_LDB(B0, 0, 0); PG8_SCHED; PG8_LDA(At, 0, 0); PG8_STAGE(PG8_SA(1, 1), a1 + hstep, voffA);
            PG8_WAIT_L(8); PG8_BAR; PG8_WAIT_L(0); PG8_MMA(0, 0, At, B0); PG8_BAR; PG8_SCHED;
            PG8_LDB(B1, 0, 1); PG8_STAGE(PG8_SB(0, 0), b2, voffB);
            PG8_BAR; PG8_WAIT_L(0); PG8_MMA(0, 1, At, B1); PG8_BAR;
            PG8_LDA(At, 0, 1); PG8_STAGE(PG8_SA(0, 0), a2, voffA);
            PG8_BAR; PG8_WAIT_L(0); PG8_MMA(1, 0, At, B0); PG8_BAR; PG8_SCHED;
            PG8_STAGE(PG8_SB(0, 1), b2 + hstep, voffB);
            PG8_WAIT_V(6); PG8_BAR; PG8_MMA(1, 1, At, B1); PG8_BAR;
            PG8_LDB(B0, 1, 0); PG8_SCHED; PG8_LDA(At, 1, 0); PG8_STAGE(PG8_SA(0, 1), a2 + hstep, voffA);
            PG8_WAIT_L(8); PG8_BAR; PG8_WAIT_L(0); PG8_MMA(0, 0, At, B0); PG8_BAR; PG8_SCHED;
            PG8_LDB(B1, 1, 1); PG8_STAGE(PG8_SB(1, 0), b3, voffB);
            PG8_BAR; PG8_WAIT_L(0); PG8_MMA(0, 1, At, B1); PG8_BAR;
            PG8_LDA(At, 1, 1); PG8_STAGE(PG8_SA(1, 0), a3, voffA);
            PG8_BAR; PG8_WAIT_L(0); PG8_MMA(1, 0, At, B0); PG8_BAR; PG8_SCHED;
            PG8_STAGE(PG8_SB(1, 1), b3 + hstep, voffB);
            PG8_WAIT_V(6); PG8_BAR; PG8_MMA(1, 1, At, B1); PG8_BAR;
        }
        PG8_STAMP();
        if constexpr (!Epi::AFTER_DRAIN) { E(acc, cur, wr, wc, fr, fq); S.done(cur); }
        PG8_STAMP();
        if (!has_next) break;
#pragma unroll
        for (int a = 0; a < 2; ++a)
#pragma unroll
            for (int b = 0; b < 2; ++b)
#pragma unroll
                for (int m = 0; m < 4; ++m)
#pragma unroll
                    for (int n = 0; n < 2; ++n) acc[a][b][m][n] = (f32x4){0.f, 0.f, 0.f, 0.f};
        cur = nxt; cA = nA; cB = nB; ++ui;
    }
    PG8_WAIT_V(0);
    if (wr == 0) PG8_BAR;
    PG8_BAR;
    if constexpr (Epi::AFTER_DRAIN) { E.fused(acc, cur, wr, wc, fr, fq, lds, wid, lane); S.done(cur); }
    PG8_STAMP();
    if (STAMP && wid == 0) { stamps[lane] = lane < nts ? (((unsigned long long)(unsigned)ts_hi << 32) | (unsigned)ts_lo) : 0ull;
        if (lane == 62) stamps[62] = rt_entry; if (lane == 63) stamps[63] = (unsigned long long)wall_clock64(); }
#undef PG8_STAMP
#undef PG8_SA
#undef PG8_SB
#undef PG8_STAGE
#undef PG8_LDA
#undef PG8_LDB
#undef PG8_MMA
#undef PG8_WAIT_V
#undef PG8_WAIT_L
#undef PG8_BAR
#undef PG8_SCHED
}
}

namespace cg = cooperative_groups;
using pg8::bf16_t; using pg8::bf16x8; using pg8::f32x4; using pg8::u32x4; using pg8::cvt_pk_bf16;

#ifndef MK_LAUNCHES
#define MK_LAUNCHES 1
#endif

constexpr int T_TOK = 20480, T_PROMPT = 4096, DM = 1024, DFF = 4096, EVN = 2592, EVNP = 2816;
constexpr int LDS_BYTES = 147456;
constexpr int NPHASE = 19;
constexpr float EPSN = 1e-6f;

constexpr size_t WS_MOD    = 0;
constexpr size_t WS_WEVIN  = 262144;
constexpr size_t WS_WEVOUT = WS_WEVIN  + (size_t)EVNP * 1024 * 2;
constexpr size_t WS_WMLP1  = WS_WEVOUT + (size_t)1024 * 1024 * 2;
constexpr size_t WS_WMLP2  = WS_WMLP1  + (size_t)2 * 4096 * 1024 * 2;
constexpr size_t WS_WRGIN  = WS_WMLP2  + (size_t)2 * 4096 * 1024 * 2;
constexpr size_t WS_WRGOUT = WS_WRGIN  + (size_t)2048 * 1024 * 2;
constexpr size_t WS_WRGG   = WS_WRGOUT + (size_t)1024 * 1024 * 2;
constexpr size_t WS_WSGU   = WS_WRGG   + (size_t)16 * 256 * 64 * 2;
constexpr size_t WS_ABUF   = WS_WSGU   + (size_t)4 * 128 * 128 * 2;
constexpr size_t WS_BIG    = WS_ABUF   + (size_t)T_TOK * 1024 * 2;
constexpr size_t BIG_BYTES = (size_t)T_TOK * 4096 * 2;
constexpr size_t WS_END    = WS_BIG + BIG_BYTES;
static_assert(WS_END <= 268435456ull, "workspace map exceeds 256 MiB");
constexpr size_t BIG_PROJ  = 0;
constexpr size_t BIG_OF    = (size_t)T_TOK * EVN * 2;
constexpr size_t BIG_OB    = BIG_OF + (size_t)T_TOK * 512 * 2;
static_assert(BIG_OB + (size_t)T_TOK * 512 * 2 <= BIG_BYTES, "");
constexpr size_t BIG_Y     = 0;
constexpr size_t BIG_H     = 0;
constexpr size_t BIG_RGP   = 0;
constexpr size_t BIG_RGSUM = (size_t)T_TOK * 2048 * 2;
constexpr size_t WS_BAR = WS_END + 256;
static_assert(WS_BAR + 3456 * 4 <= 268435456ull, "");
constexpr size_t WS_SCR = WS_BAR + 16384;
static_assert(WS_SCR + (size_t)4096 * 1024 * 2 <= 268435456ull, "");
constexpr size_t BIG_RGCAR = BIG_RGSUM + (size_t)320 * 2 * 2 * 1024 * 4;

struct Params {
    const float* in[31];
    float* out;
    unsigned char* ws;
    int nseq, pad;
    unsigned char seq[64];
    unsigned char dbgv[64];
};

__device__ __forceinline__ float bf2f(unsigned short b) { return __uint_as_float(((unsigned)b) << 16); }
__device__ __forceinline__ float bflo(unsigned w) { return __uint_as_float(w << 16); }
__device__ __forceinline__ float bfhi(unsigned w) { return __uint_as_float(w & 0xffff0000u); }
__device__ __forceinline__ unsigned short f2bf(float f) { return (unsigned short)(cvt_pk_bf16(f, 0.f) & 0xffffu); }
__device__ __forceinline__ float wave_sum(float v) {
#pragma unroll
    for (int o = 32; o > 0; o >>= 1) v += __shfl_xor(v, o, 64);
    return v;
}
__device__ __forceinline__ float gelu_tanh(float x) {
    const float u = -2.302208198f * (x + 0.044715f * x * x * x);
    return x * __builtin_amdgcn_rcpf(1.0f + __builtin_amdgcn_exp2f(u));
}
__device__ __forceinline__ float sigmoidf_(float x) { return __builtin_amdgcn_rcpf(1.0f + __expf(-x)); }
__device__ __forceinline__ bf16x8 ldfrag(const unsigned short* base, int pitch, int r0, int k0, int lane) {
    return *(const bf16x8*)(base + (r0 + (lane & 15)) * pitch + k0 + (lane >> 4) * 8);
}
__device__ __forceinline__ int otid() { int t = threadIdx.x; asm volatile("" : "+v"(t)); return t; }
__device__ __forceinline__ void lds_barrier() { asm volatile("s_waitcnt lgkmcnt(0)" ::: "memory"); __builtin_amdgcn_s_barrier(); asm volatile("" ::: "memory"); }
#define MFMA16(a, b, c) __builtin_amdgcn_mfma_f32_16x16x32_bf16((a), (b), (c), 0, 0, 0)

struct EpiGen {
    static constexpr bool PERM = true, AFTER_DRAIN = false;
    void* O; int ldc; const float* bias; int ncols; int mode;
    __device__ __forceinline__ void operator()(const f32x4 (&acc)[2][2][4][2], const pg8::Unit& u, int wr, int wc, int fr, int fq) const {
        const int row0 = u.pm * 256 + wr * 64 + fr, col0 = u.pn * 256 + wc * 32 + 8 * fq;
        const bool act = (mode == 0) ? (u.pn < 4) : ((mode == 3) ? (u.pn >= 4) : false);
        if (mode == 4) {
#pragma unroll
            for (int ai = 0; ai < 2; ++ai)
#pragma unroll
                for (int m = 0; m < 4; ++m) { float* rowp = (float*)O + (size_t)(row0 + ai * 128 + m * 16) * ldc + col0;
#pragma unroll
                    for (int bj = 0; bj < 2; ++bj) { *(f32x4*)(rowp + bj * 128) = acc[ai][bj][m][0]; *(f32x4*)(rowp + bj * 128 + 4) = acc[ai][bj][m][1]; } }
            return;
        }
#pragma unroll
        for (int bj = 0; bj < 2; ++bj) {
            const int col = col0 + bj * 128;
            if (col >= ncols) continue;
            f32x4 b0 = (f32x4){0.f, 0.f, 0.f, 0.f}, b1 = b0;
            if (bias) { b0 = *(const f32x4*)(bias + col); b1 = *(const f32x4*)(bias + col + 4); }
#pragma unroll
            for (int ai = 0; ai < 2; ++ai)
#pragma unroll
                for (int m = 0; m < 4; ++m) {
                    f32x4 v0 = acc[ai][bj][m][0] + b0, v1 = acc[ai][bj][m][1] + b1;
                    if (mode == 1) {
#pragma unroll
                        for (int j = 0; j < 4; ++j) { float a = fmaxf(v0[j], 0.f), b = fmaxf(v1[j], 0.f); v0[j] = a * a; v1[j] = b * b; }
                    }
                    if (act) {
#pragma unroll
                        for (int j = 0; j < 4; ++j) { v0[j] = gelu_tanh(v0[j]); v1[j] = gelu_tanh(v1[j]); }
                    }
                    u32x4 w; w.x = cvt_pk_bf16(v0[0], v0[1]); w.y = cvt_pk_bf16(v0[2], v0[3]); w.z = cvt_pk_bf16(v1[0], v1[1]); w.w = cvt_pk_bf16(v1[2], v1[3]);
                    *(u32x4*)((bf16_t*)O + (size_t)(row0 + ai * 128 + m * 16) * ldc + col) = w;
                }
        }
    }
};

template <class Epi>
__device__ __forceinline__ void run_gemm(unsigned char* shm, const bf16_t* A, const bf16_t* Bt, int M, int N, int K, int ld, int G, int c, const Epi& E) {
    pg8::Gemm g; g.A = A; g.Bt = Bt; g.M = M; g.N = N; g.K = K; g.ld = ld;
    pg8::StaticOrder S; S.init(M, N, G, c);
    pg8::gemm_phase<Epi, pg8::StaticOrder, false>((PG8_LAS unsigned char*)shm, g, S, E, nullptr);
}

__device__ __forceinline__ void transpose_tile(const float* src, int ldsrc, int k0, int n0, int nvalid, int nstore, bf16_t* dst, int lddst, float* tile) {
    const int tid = otid();
    {
        const int kk = tid >> 6, n4 = (tid & 63) * 4;
        float4 v[8];
#pragma unroll
        for (int i = 0; i < 8; ++i) {
            v[i] = make_float4(0.f, 0.f, 0.f, 0.f);
            if (n0 + n4 < nvalid) v[i] = *(const float4*)(src + (size_t)(k0 + kk + 8 * i) * ldsrc + n0 + n4);
        }
#pragma unroll
        for (int i = 0; i < 8; ++i) { float* tp = tile + (kk + 8 * i) * 257 + n4; tp[0] = v[i].x; tp[1] = v[i].y; tp[2] = v[i].z; tp[3] = v[i].w; }
    }
    __syncthreads();
    {
        const int nn = tid >> 1, k32 = (tid & 1) * 32;
        if (n0 + nn < nstore) {
            bf16_t* dp = dst + (size_t)(n0 + nn) * lddst + k0 + k32;
#pragma unroll
            for (int q = 0; q < 4; ++q) {
                float f[8];
#pragma unroll
                for (int j = 0; j < 8; ++j) f[j] = tile[(k32 + q * 8 + j) * 257 + nn];
                u32x4 w; w.x = cvt_pk_bf16(f[0], f[1]); w.y = cvt_pk_bf16(f[2], f[3]); w.z = cvt_pk_bf16(f[4], f[5]); w.w = cvt_pk_bf16(f[6], f[7]);
                *(u32x4*)(dp + q * 8) = w;
            }
        }
    }
    __syncthreads();
}

__device__ __forceinline__ void convert_weight_tile(const Params& p, float* fl, int idx) {
    const float* src; bf16_t* dst; int ld, nv, ns, ldd, nkt;
    if (idx < 176) { src = p.in[13]; dst = (bf16_t*)(p.ws + WS_WEVIN); ld = EVN; nv = EVN; ns = EVNP; ldd = 1024; nkt = 16; }
    else if ((idx -= 176) < 64) { src = p.in[14]; dst = (bf16_t*)(p.ws + WS_WEVOUT); ld = 1024; nv = 1024; ns = 1024; ldd = 1024; nkt = 16; }
    else if ((idx -= 64) < 512) { const int l = idx >> 8; idx &= 255; src = p.in[9] + (size_t)l * 1024 * 4096; dst = (bf16_t*)(p.ws + WS_WMLP1) + (size_t)l * 4096 * 1024; ld = 4096; nv = 4096; ns = 4096; ldd = 1024; nkt = 16; }
    else if ((idx -= 512) < 512) { const int l = idx >> 8; idx &= 255; src = p.in[11] + (size_t)l * 4096 * 1024; dst = (bf16_t*)(p.ws + WS_WMLP2) + (size_t)l * 1024 * 4096; ld = 1024; nv = 1024; ns = 1024; ldd = 4096; nkt = 64; }
    else if ((idx -= 512) < 128) { src = p.in[22]; dst = (bf16_t*)(p.ws + WS_WRGIN); ld = 2048; nv = 2048; ns = 2048; ldd = 1024; nkt = 16; }
    else if ((idx -= 128) < 64) { src = p.in[30]; dst = (bf16_t*)(p.ws + WS_WRGOUT); ld = 1024; nv = 1024; ns = 1024; ldd = 1024; nkt = 16; }
    else { idx -= 64; const int d = idx >> 5, mat = (idx >> 4) & 1, h = idx & 15;
        src = (mat ? p.in[27] : p.in[25]) + (size_t)(d * 16 + h) * 4096; dst = (bf16_t*)(p.ws + WS_WRGG) + (size_t)h * 256 * 64 + (size_t)(d * 2 + mat) * 4096; ld = 64; nv = 64; ns = 64; ldd = 64; nkt = 1; idx = 0; }
    const int kt = idx % nkt, nt = idx / nkt;
    transpose_tile(src, ld, kt * 64, nt * 256, nv, ns, dst, ldd, fl);
}
__device__ __forceinline__ int deferred1_tile(int d) { return d < 256 ? 240 + d : d < 512 ? 752 + (d - 256) : d < 640 ? 1264 + (d - 512) : 1392 + (d - 640); }
__device__ __forceinline__ int deferred2_tile(int d) { return d < 256 ? 496 + d : 1008 + (d - 256); }
__device__ __forceinline__ void phase_prep(const Params& p, unsigned char* shm) {
    const int tid = otid();
    float* fl = (float*)shm;
    constexpr int N_GEMV = 192, N_SGU = 16;
    const bool early = (gridDim.x == 256);
    const int N_TR = early ? 304 : 1520;
    for (int item = blockIdx.x; item < N_GEMV + N_TR + N_SGU; item += gridDim.x) {
        if (item < N_GEMV) {
            const int l = item / 96, n0 = (item % 96) * 64;
            float* S = fl;
            float* R = fl + 5120;
            const int r = tid >> 4, c4 = (tid & 15) * 4;
            const float* W = p.in[6] + (size_t)l * 1024 * 6144 + n0 + c4;
            float4 w[8];
#pragma unroll
            for (int j = 0; j < 8; ++j) w[j] = *(const float4*)(W + (size_t)(r + 32 * j) * 6144);
            for (int e = tid; e < 5120; e += 512) {
                const int c = e >> 10, k = e & 1023;
                const float v = (c == 0) ? p.in[5][k] : p.in[2][(c - 1) * 1024 + k];
                S[e] = v * sigmoidf_(v);
            }
            __syncthreads();
            float acc[5][4];
#pragma unroll
            for (int c = 0; c < 5; ++c)
#pragma unroll
                for (int j = 0; j < 4; ++j) acc[c][j] = 0.f;
            for (int i0 = 0; i0 < 32; i0 += 8) {
                float4 wn[8];
                if (i0 + 8 < 32) {
#pragma unroll
                    for (int j = 0; j < 8; ++j) wn[j] = *(const float4*)(W + (size_t)(r + 32 * (i0 + 8 + j)) * 6144);
                }
#pragma unroll
                for (int j = 0; j < 8; ++j) {
                    const int k = r + 32 * (i0 + j);
#pragma unroll
                    for (int c = 0; c < 5; ++c) { const float sv = S[c * 1024 + k]; acc[c][0] += sv * w[j].x; acc[c][1] += sv * w[j].y; acc[c][2] += sv * w[j].z; acc[c][3] += sv * w[j].w; }
                }
                if (i0 + 8 < 32) {
#pragma unroll
                    for (int j = 0; j < 8; ++j) w[j] = wn[j];
                }
            }
#pragma unroll
            for (int c = 0; c < 5; ++c)
#pragma unroll
                for (int j = 0; j < 4; ++j) R[(r * 5 + c) * 64 + c4 + j] = acc[c][j];
            __syncthreads();
            if (tid < 320) {
                const int c = tid >> 6, n = tid & 63;
                float s = p.in[7][l * 6144 + n0 + n];
                for (int rr = 0; rr < 32; ++rr) s += R[(rr * 5 + c) * 64 + n];
                ((float*)(p.ws + WS_MOD))[(l * 5 + c) * 6144 + n0 + n] = s;
            }
            __syncthreads();
        } else if (item < N_GEMV + N_TR) {
            const int e = item - N_GEMV;
            convert_weight_tile(p, fl, early ? (e < 240 ? e : 1456 + (e - 240)) : e);
        } else {
            const int it = item - N_GEMV - N_TR;
            const int e = it * 4096 + tid * 8;
            const float4 a = *(const float4*)(p.in[17] + e), b = *(const float4*)(p.in[17] + e + 4);
            u32x4 w; w.x = cvt_pk_bf16(a.x, a.y); w.y = cvt_pk_bf16(a.z, a.w); w.z = cvt_pk_bf16(b.x, b.y); w.w = cvt_pk_bf16(b.z, b.w);
            *(u32x4*)((bf16_t*)(p.ws + WS_WSGU) + e) = w;
        }
    }
}

template <int SRC, bool NEXT, bool XIN = false, bool XST = true>
__device__ __forceinline__ void phase_row(const Params& p, const void* ysrc, const float* ng_res, const float* modg  ,
                          const float* ng_next, const float* modn  , int sh_off, int sc_off, bool part,
                          int row_lo = 0, int row_hi = T_TOK, int wave0 = 0, int nwaves = 0) {
    const int tid_ = otid(); const int lane = tid_ & 63, wid = tid_ >> 6;
    bf16_t* A = (bf16_t*)(p.ws + WS_ABUF);
    float om[4];
    if (SRC == 0 || XIN) {
#pragma unroll
        for (int e = 0; e < 4; ++e) om[e] = exp2f(-(float)(lane * 4 + e) * (13.287712379549449f / 256.0f));
    }
    const int nw = nwaves ? nwaves : (int)gridDim.x * 8, R = (row_hi - row_lo + nw - 1) / nw;
    const int gw = (int)blockIdx.x * 8 + wid - wave0;
    int r_lo = row_lo + gw * R, r_hi = (r_lo + R < row_hi) ? (r_lo + R) : row_hi;
    if (gw < 0 || gw >= nw) { r_lo = 0; r_hi = 0; }
    const bool dopart = (SRC == 2) && part && (gridDim.x == 256);
    int cur_cond = -1;
    float4 gn[4], nn[4], shv[4];
    float4 cx[4], nx[4];
    float4 cy[4], ny[4];
    uint2 cyb[4], nyb[4], cpb[4], npb[4];
#pragma unroll
    for (int i = 0; i < 4; ++i) { cx[i] = nx[i] = cy[i] = ny[i] = make_float4(0.f, 0.f, 0.f, 0.f); cyb[i] = nyb[i] = cpb[i] = npb[i] = make_uint2(0u, 0u); }
    auto load_row = [&](int t, float4 (&x)[4], float4 (&y)[4], uint2 (&yb)[4], uint2 (&pb)[4]) {
        const float* xi = (SRC == 0 || XIN) ? ((t < T_PROMPT) ? (p.in[0] + (size_t)t * 1024) : (p.in[1] + (size_t)(t - T_PROMPT) * 1024)) : (p.out + (size_t)t * 1024);
#pragma unroll
        for (int i = 0; i < 4; ++i) x[i] = *(const float4*)(xi + lane * 4 + 256 * i);
        if (SRC == 1) {
#pragma unroll
            for (int i = 0; i < 4; ++i) y[i] = *(const float4*)((const float*)ysrc + (size_t)t * 1024 + lane * 4 + 256 * i);
        }
        if (SRC == 2) {
#pragma unroll
            for (int i = 0; i < 4; ++i) yb[i] = *(const uint2*)((const bf16_t*)ysrc + (size_t)t * 1024 + lane * 4 + 256 * i);
            if (dopart && t >= 16384) {
#pragma unroll
                for (int i = 0; i < 4; ++i) pb[i] = *(const uint2*)((const bf16_t*)(p.ws + WS_SCR) + (size_t)(t - 16384) * 1024 + lane * 4 + 256 * i);
            }
        }
    };
    if (r_lo < r_hi) load_row(r_lo, cx, cy, cyb, cpb);
    for (int t = r_lo; t < r_hi; ++t) {
        if (t + 1 < r_hi) load_row(t + 1, nx, ny, nyb, npb);
        const int cond = (t < T_PROMPT) ? 0 : 1 + ((t - T_PROMPT) >> 12);
        if (cond != cur_cond) {
            cur_cond = cond;
#pragma unroll
            for (int i = 0; i < 4; ++i) {
                if (SRC != 0) {
                    const float4 g = *(const float4*)(modg + cond * 6144 + lane * 4 + 256 * i), n = *(const float4*)(ng_res + lane * 4 + 256 * i);
                    gn[i] = make_float4(g.x * n.x, g.y * n.y, g.z * n.z, g.w * n.w);
                }
                if (NEXT) {
                    const float* mp = modn + cond * 6144 + lane * 4 + 256 * i;
                    const float4 n = *(const float4*)(ng_next + lane * 4 + 256 * i), sc = *(const float4*)(mp + sc_off);
                    shv[i] = *(const float4*)(mp + sh_off);
                    nn[i] = make_float4(n.x * (1.f + sc.x), n.y * (1.f + sc.y), n.z * (1.f + sc.z), n.w * (1.f + sc.w));
                }
            }
        }
        float4 xv[4];
#pragma unroll
        for (int i = 0; i < 4; ++i) xv[i] = cx[i];
        float* xo = p.out + (size_t)t * 1024 + lane * 4;
        if ((SRC == 0 || XIN) && t >= T_PROMPT) {
            const int tl = (t - T_PROMPT) & 4095;
            const float rr = (float)(tl >> 6), cc = (float)(tl & 63);
#pragma unroll
            for (int i = 0; i < 4; ++i) {
                const float base = (i < 2) ? rr : cc;
                float pe[4];
#pragma unroll
                for (int e = 0; e < 4; ++e) {
                    const float a = base * om[e];
                    const float k = rintf(a * 0.15915494309189535f);
                    float y = fmaf(-k, 6.28318548202514648f, a); y = fmaf(-k, -1.7484555e-07f, y);
                    pe[e] = (i & 1) ? __cosf(y) : __sinf(y);
                }
                xv[i].x += pe[0]; xv[i].y += pe[1]; xv[i].z += pe[2]; xv[i].w += pe[3];
            }
        }
        if (SRC != 0) {
            float4 yv[4];
            if (SRC == 1) {
#pragma unroll
                for (int i = 0; i < 4; ++i) yv[i] = cy[i];
            } else {
#pragma unroll
                for (int i = 0; i < 4; ++i) yv[i] = make_float4(bflo(cyb[i].x), bfhi(cyb[i].x), bflo(cyb[i].y), bfhi(cyb[i].y));
                if (dopart && t >= 16384) {
#pragma unroll
                    for (int i = 0; i < 4; ++i) { yv[i].x += bflo(cpb[i].x); yv[i].y += bfhi(cpb[i].x); yv[i].z += bflo(cpb[i].y); yv[i].w += bfhi(cpb[i].y); }
                }
            }
            float ss = 0.f;
#pragma unroll
            for (int i = 0; i < 4; ++i) ss += yv[i].x * yv[i].x + yv[i].y * yv[i].y + yv[i].z * yv[i].z + yv[i].w * yv[i].w;
            ss = wave_sum(ss);
            const float r = rsqrtf(ss * (1.0f / 1024.0f) + EPSN);
#pragma unroll
            for (int i = 0; i < 4; ++i) {
                xv[i].x += gn[i].x * (yv[i].x * r); xv[i].y += gn[i].y * (yv[i].y * r); xv[i].z += gn[i].z * (yv[i].z * r); xv[i].w += gn[i].w * (yv[i].w * r);
            }
        }
        if (XST) {
#pragma unroll
            for (int i = 0; i < 4; ++i) *(float4*)(xo + 256 * i) = xv[i];
        }
        if (NEXT) {
            float ss = 0.f;
#pragma unroll
            for (int i = 0; i < 4; ++i) ss += xv[i].x * xv[i].x + xv[i].y * xv[i].y + xv[i].z * xv[i].z + xv[i].w * xv[i].w;
            ss = wave_sum(ss);
            const float r = rsqrtf(ss * (1.0f / 1024.0f) + EPSN);
#pragma unroll
            for (int i = 0; i < 4; ++i) {
                const float h0 = xv[i].x * r * nn[i].x + shv[i].x, h1 = xv[i].y * r * nn[i].y + shv[i].y;
                const float h2 = xv[i].z * r * nn[i].z + shv[i].z, h3 = xv[i].w * r * nn[i].w + shv[i].w;
                uint2 w; w.x = cvt_pk_bf16(h0, h1); w.y = cvt_pk_bf16(h2, h3);
                *(uint2*)(A + (size_t)t * 1024 + lane * 4 + 256 * i) = w;
            }
        }
#pragma unroll
        for (int i = 0; i < 4; ++i) { cx[i] = nx[i]; cy[i] = ny[i]; cyb[i] = nyb[i]; cpb[i] = npb[i]; }
    }
}

__device__ __forceinline__ void phase_gla_combine(const Params& p) {
    const int tid_ = otid(); const int lane = tid_ & 63, wid = tid_ >> 6;
    const bf16_t* proj = (const bf16_t*)(p.ws + WS_BIG + BIG_PROJ);
    const bf16_t* of = (const bf16_t*)(p.ws + WS_BIG + BIG_OF);
    const bf16_t* ob = (const bf16_t*)(p.ws + WS_BIG + BIG_OB);
    bf16_t* A = (bf16_t*)(p.ws + WS_ABUF);
    const float4 gn0 = *(const float4*)(p.in[21] + lane * 8), gn1 = *(const float4*)(p.in[21] + lane * 8 + 4);
    const float gn[8] = {gn0.x, gn0.y, gn0.z, gn0.w, gn1.x, gn1.y, gn1.z, gn1.w};
    const int nw = gridDim.x * 8, R = (T_TOK + nw - 1) / nw, gw = blockIdx.x * 8 + wid;
    const int r_lo = gw * R, r_hi = (r_lo + R < T_TOK) ? (r_lo + R) : T_TOK;
    u32x4 a = (u32x4){0, 0, 0, 0}, b = a, g = a, na = a, nb = a, ngv = a;
    if (r_lo < r_hi) { a = *(const u32x4*)(of + (size_t)r_lo * 512 + lane * 8); b = *(const u32x4*)(ob + (size_t)r_lo * 512 + lane * 8); g = *(const u32x4*)(proj + (size_t)r_lo * EVN + 2048 + lane * 8); }
    for (int t = r_lo; t < r_hi; ++t) {
        if (t + 1 < r_hi) { na = *(const u32x4*)(of + (size_t)(t + 1) * 512 + lane * 8); nb = *(const u32x4*)(ob + (size_t)(t + 1) * 512 + lane * 8); ngv = *(const u32x4*)(proj + (size_t)(t + 1) * EVN + 2048 + lane * 8); }
        float o[8], gg[8];
#pragma unroll
        for (int j = 0; j < 4; ++j) { o[2 * j] = bflo(a[j]) + bflo(b[j]); o[2 * j + 1] = bfhi(a[j]) + bfhi(b[j]); gg[2 * j] = bflo(g[j]); gg[2 * j + 1] = bfhi(g[j]); }
        float ss = 0.f;
#pragma unroll
        for (int j = 0; j < 8; ++j) ss += o[j] * o[j];
#pragma unroll
        for (int m = 8; m > 0; m >>= 1) ss += __shfl_xor(ss, m, 64);
        const float r = rsqrtf(ss * (1.0f / 128.0f) + EPSN);
        float v[8];
#pragma unroll
        for (int j = 0; j < 8; ++j) v[j] = o[j] * r * gn[j] * (gg[j] * sigmoidf_(gg[j]));
        u32x4 w; w.x = cvt_pk_bf16(v[0], v[1]); w.y = cvt_pk_bf16(v[2], v[3]); w.z = cvt_pk_bf16(v[4], v[5]); w.w = cvt_pk_bf16(v[6], v[7]);
        *(u32x4*)(A + (size_t)t * 1024 + 512 + lane * 8) = w;
        a = na; b = nb; g = ngv;
    }
}

__device__ __forceinline__ void sgu_item(const Params& p, unsigned char* shm, int item) {
#ifdef SKIP_SGU
    return;
#endif
    const int tid = otid(), lane = tid & 63, wid = tid >> 6, quad = lane >> 4;
    const int c = item >> 2, g = item & 3, t0 = c * 128;
    const bf16_t* proj = (const bf16_t*)(p.ws + WS_BIG + BIG_PROJ);
    bf16_t* A = (bf16_t*)(p.ws + WS_ABUF);
    float* MU = (float*)shm; float* RS = MU + 128;
    unsigned short* VNT = (unsigned short*)(shm + 1024);
    unsigned short* WSA = (unsigned short*)(shm + 1024 + 34816);
    {
        u32x4 v[16];
#pragma unroll
        for (int rr = 0; rr < 16; ++rr) v[rr] = *(const u32x4*)(proj + (size_t)(t0 + wid * 16 + rr) * EVN + 512 + lane * 8);
#pragma unroll
        for (int rr = 0; rr < 16; ++rr) {
            float s = 0.f, ss = 0.f;
#pragma unroll
            for (int j = 0; j < 4; ++j) { const float a = bflo(v[rr][j]), b = bfhi(v[rr][j]); s += a + b; ss += a * a + b * b; }
            s = wave_sum(s); ss = wave_sum(ss);
            if (lane == 0) { const float mu = s * (1.0f / 512.0f); const float var = fmaxf(ss * (1.0f / 512.0f) - mu * mu, 0.f); MU[wid * 16 + rr] = mu; RS[wid * 16 + rr] = rsqrtf(var + EPSN); }
        }
    }
    {
        const bf16_t* wsg = (const bf16_t*)(p.ws + WS_WSGU) + (size_t)g * 16384;
#pragma unroll
        for (int i = 0; i < 4; ++i) { const int e = tid + 512 * i, row = e >> 4, c8 = (e & 15) * 8; *(u32x4*)(WSA + row * 136 + c8) = *(const u32x4*)(wsg + row * 128 + c8); }
    }
    lds_barrier();
    {
        const int q = tid >> 2, d32 = (tid & 3) * 32;
        const float mu = MU[q], rs = RS[q];
        const bf16_t* src = proj + (size_t)(t0 + q) * EVN + 512 + g * 128 + d32;
        const float* lg = p.in[15] + g * 128 + d32; const float* lb = p.in[16] + g * 128 + d32;
#pragma unroll
        for (int i = 0; i < 4; ++i) {
            const u32x4 w = *(const u32x4*)(src + i * 8);
#pragma unroll
            for (int j = 0; j < 4; ++j) {
                const int d = d32 + i * 8 + 2 * j;
                const float a = (bflo(w[j]) - mu) * rs * lg[i * 8 + 2 * j] + lb[i * 8 + 2 * j];
                const float b = (bfhi(w[j]) - mu) * rs * lg[i * 8 + 2 * j + 1] + lb[i * 8 + 2 * j + 1];
                VNT[d * 136 + q] = f2bf(a); VNT[(d + 1) * 136 + q] = f2bf(b);
            }
        }
    }
    lds_barrier();
    {
        f32x4 acc[8];
#pragma unroll
        for (int dt = 0; dt < 8; ++dt) acc[dt] = (f32x4){0.f, 0.f, 0.f, 0.f};
#pragma unroll
        for (int ks = 0; ks < 4; ++ks) {
            const bf16x8 b = ldfrag(WSA, 136, wid * 16, ks * 32, lane);
#pragma unroll
            for (int dt = 0; dt < 8; ++dt) { const bf16x8 a = ldfrag(VNT, 136, dt * 16, ks * 32, lane); acc[dt] = MFMA16(a, b, acc[dt]); }
        }
        const int pp = wid * 16 + (lane & 15), t = t0 + pp;
        const float bsv = p.in[18][g * 128 + pp];
#pragma unroll
        for (int dt = 0; dt < 8; ++dt) {
            const int d = dt * 16 + quad * 4;
            const uint2 uw = *(const uint2*)(proj + (size_t)t * EVN + g * 128 + d);
            uint2 w; w.x = cvt_pk_bf16(bflo(uw.x) * (acc[dt][0] + bsv), bfhi(uw.x) * (acc[dt][1] + bsv)); w.y = cvt_pk_bf16(bflo(uw.y) * (acc[dt][2] + bsv), bfhi(uw.y) * (acc[dt][3] + bsv));
            *(uint2*)(A + (size_t)t * 1024 + g * 128 + d) = w;
        }
    }
    lds_barrier();
}

__device__ __forceinline__ float fexp(float x) { return __builtin_amdgcn_exp2f(x * 1.4426950408889634f); }
__device__ __forceinline__ float flog(float x) { return __builtin_amdgcn_logf(x) * 0.6931471805599453f; }
__device__ __forceinline__ void gla_item(const Params& p, unsigned char* shm, int item) {
    const int tid = otid(), lane = tid & 63, wid = tid >> 6, quad = lane >> 4, l15 = lane & 15;
#ifdef SKIP_GLAP
    if (item >= 128) return;
#endif
    int s, rem;
    if (item < 128) { s = 16 + (item >> 5); rem = item & 31; } else { s = (item - 128) >> 5; rem = (item - 128) & 31; }
    const int h = rem >> 3, dir = (rem >> 2) & 1, sl = rem & 3;
    const int ts = (s < 16) ? s * 256 : T_PROMPT + (s - 16) * 4096, L = (s < 16) ? 256 : 4096, nc = L >> 6;
    const bf16_t* proj = (const bf16_t*)(p.ws + WS_BIG + BIG_PROJ);
    bf16_t* O = (bf16_t*)(p.ws + WS_BIG + (dir ? BIG_OB : BIG_OF));
    unsigned short* QR = (unsigned short*)(shm + 0);
    unsigned short* KR = (unsigned short*)(shm + 8192);
    unsigned short* LR = (unsigned short*)(shm + 82944);
    float* LA = (float*)(shm + 18432);
    float* SEG = (float*)(shm + 34816);
    unsigned short* QE = (unsigned short*)(shm + 36864);
    unsigned short* KE = (unsigned short*)(shm + 46080);
    unsigned short* KDT = (unsigned short*)(shm + 55296);
    unsigned short* VT = (unsigned short*)(shm + 64512);
    unsigned short* ST = (unsigned short*)(shm + 69120);
    unsigned short* ATT = (unsigned short*)(shm + 73728);
    float* DEC = (float*)(shm + 88064);
    const int lrow = tid >> 3, lc8 = (tid & 7) * 8;
    u32x4 qreg, kreg, vreg = (u32x4){0, 0, 0, 0};
    auto issue = [&](int n) {
        const int t0 = dir ? (ts + L - 64 * (n + 1)) : (ts + 64 * n);
        const int tq = dir ? (t0 + 63 - lrow) : (t0 + lrow);
        qreg = *(const u32x4*)(proj + (size_t)tq * EVN + 1024 + h * 64 + lc8);
        kreg = *(const u32x4*)(proj + (size_t)tq * EVN + 1280 + h * 64 + lc8);
        if (tid < 256) { const int vr = tid >> 2; const int tv = dir ? (t0 + 63 - vr) : (t0 + vr); vreg = *(const u32x4*)(proj + (size_t)tv * EVN + 1536 + h * 128 + sl * 32 + (tid & 3) * 8); }
        else if (tid < 384) { const int e = tid - 256, r = e >> 1; const int tl = dir ? (t0 + 63 - r) : (t0 + r); vreg = *(const u32x4*)(proj + (size_t)tl * EVN + 2560 + dir * 16 + (e & 1) * 8); }
    };
    issue(0);
    const int gmt = (wid * 2) >> 2, gnt0 = (wid * 2) & 3;
    bf16x8 gwf[2]; float gbv[2];
#pragma unroll
    for (int tt = 0; tt < 2; ++tt) {
        const int dkc = h * 64 + (gnt0 + tt) * 16 + l15;
        float wv[8];
#pragma unroll
        for (int j = 0; j < 8; ++j) wv[j] = (quad < 2) ? p.in[19][(dir * 16 + quad * 8 + j) * 256 + dkc] : 0.f;
        u32x4 pw; pw.x = cvt_pk_bf16(wv[0], wv[1]); pw.y = cvt_pk_bf16(wv[2], wv[3]); pw.z = cvt_pk_bf16(wv[4], wv[5]); pw.w = cvt_pk_bf16(wv[6], wv[7]);
        gwf[tt] = __builtin_bit_cast(bf16x8, pw);
        gbv[tt] = p.in[20][dir * 256 + dkc];
    }
    { unsigned z0 = 0; asm volatile("" : "+v"(z0));
      if (tid < 128) *(u32x4*)(LR + (tid >> 1) * 40 + 16 + (tid & 1) * 8) = (u32x4){z0, z0, z0, z0}; }
    const int mt = wid >> 1, nt = wid & 1;
    f32x4 Sacc = (f32x4){0.f, 0.f, 0.f, 0.f};
    if (s >= 16) {
        const float* st = p.in[3] + ((size_t)(((s - 16) * 2 + dir) * 4 + h) * 64) * 128;
#pragma unroll
        for (int j = 0; j < 4; ++j) Sacc[j] = st[(mt * 16 + quad * 4 + j) * 128 + sl * 32 + nt * 16 + l15];
    }
    unsigned dbgc = 0;
    uint2 pend_w = make_uint2(0u, 0u); bf16_t* pend_ptr = nullptr;
    for (int n = 0; n < nc; ++n) {
        const int t0 = dir ? (ts + L - 64 * (n + 1)) : (ts + 64 * n);
        *(u32x4*)(QR + lrow * 64 + lc8) = qreg; *(u32x4*)(KR + lrow * 64 + lc8) = kreg;
        if (tid < 256) { const int vr = tid >> 2, d8 = (tid & 3) * 8;
#pragma unroll
            for (int j = 0; j < 4; ++j) { VT[(d8 + 2 * j) * 72 + vr] = (unsigned short)(vreg[j] & 0xffffu); VT[(d8 + 2 * j + 1) * 72 + vr] = (unsigned short)(vreg[j] >> 16); } }
        else if (tid < 384) { const int e = tid - 256; *(u32x4*)(LR + (e >> 1) * 40 + (e & 1) * 8) = vreg; }
        if (n > 0) *(uint2*)pend_ptr = pend_w;
        if (n + 1 < nc) issue(n + 1);
        lds_barrier();
        {
            const bf16x8 af = ldfrag(LR, 40, gmt * 16, 0, lane);
#pragma unroll
            for (int tt = 0; tt < 2; ++tt) {
                f32x4 zc = (f32x4){0.f, 0.f, 0.f, 0.f};
                zc = MFMA16(af, gwf[tt], zc);
#pragma unroll
                for (int j = 0; j < 4; ++j) {
                    const float z = zc[j] + gbv[tt];
                    LA[(gmt * 16 + quad * 4 + j) * 64 + (gnt0 + tt) * 16 + l15] = (fminf(z, 0.f) - flog(1.0f + fexp(-fabsf(z)))) * 0.0625f;
                }
            }
        }
        lds_barrier();
        const int dk = lane, seg = wid;
        float cs[8];
        {
            float run = 0.f;
#pragma unroll
            for (int i = 0; i < 8; ++i) { run += LA[(seg * 8 + i) * 64 + dk]; cs[i] = run; }
            SEG[seg * 64 + dk] = run;
        }
        lds_barrier();
        {
            float pre = 0.f, tot = 0.f;
#pragma unroll
            for (int s2 = 0; s2 < 8; ++s2) { const float v = SEG[s2 * 64 + dk]; if (s2 < seg) pre += v; tot += v; }
            float kd[8];
            const float etot = fexp(tot);
#pragma unroll
            for (int i = 0; i < 8; ++i) {
                const int row = seg * 8 + i;
                const float b = pre + cs[i];
                const float q = bf2f(QR[row * 64 + dk]) * 0.125f, k = bf2f(KR[row * 64 + dk]);
#ifdef DBG_GLA
                if (!(fabsf(b) < 80.f)) dbgc |= 4u;
                if (!(fabsf(q) < 1e4f) || !(fabsf(k) < 1e4f)) dbgc |= 8u;
#endif
                const float eb = fexp(b), ke = k * __builtin_amdgcn_rcpf(eb);
                QE[row * 72 + dk] = f2bf(q * eb);
                KE[row * 72 + dk] = f2bf(ke);
                kd[i] = ke * etot;
            }
            u32x4 w; w.x = cvt_pk_bf16(kd[0], kd[1]); w.y = cvt_pk_bf16(kd[2], kd[3]); w.z = cvt_pk_bf16(kd[4], kd[5]); w.w = cvt_pk_bf16(kd[6], kd[7]);
            *(u32x4*)(KDT + dk * 72 + seg * 8) = w;
            if (seg == 0) DEC[dk] = etot;
            uint2 sw; sw.x = cvt_pk_bf16(Sacc[0], Sacc[1]); sw.y = cvt_pk_bf16(Sacc[2], Sacc[3]);
            *(uint2*)(ST + (nt * 16 + l15) * 72 + mt * 16 + quad * 4) = sw;
        }
        lds_barrier();
#pragma unroll
        for (int tt = 0; tt < 2; ++tt) {
            const int idx = wid * 2 + tt, it = idx >> 2, jt = idx & 3;
            f32x4 acc = (f32x4){0.f, 0.f, 0.f, 0.f};
            if (jt <= it) {
#pragma unroll
                for (int ks = 0; ks < 2; ++ks) { const bf16x8 a = ldfrag(KE, 72, jt * 16, ks * 32, lane), b = ldfrag(QE, 72, it * 16, ks * 32, lane); acc = MFMA16(a, b, acc); }
            }
#ifdef DBG_GLA
            for (int j = 0; j < 4; ++j) if (!(fabsf(acc[j]) < 1e30f)) dbgc |= 16u;
#endif
            const int i = it * 16 + l15, j0 = jt * 16 + quad * 4;
            uint2 w; w.x = cvt_pk_bf16(i >= j0 ? acc[0] : 0.f, i >= j0 + 1 ? acc[1] : 0.f); w.y = cvt_pk_bf16(i >= j0 + 2 ? acc[2] : 0.f, i >= j0 + 3 ? acc[3] : 0.f);
            *(uint2*)(ATT + i * 72 + j0) = w;
        }
        lds_barrier();
        {
            f32x4 acc = (f32x4){0.f, 0.f, 0.f, 0.f};
#pragma unroll
            for (int ks = 0; ks < 2; ++ks) { const bf16x8 a = ldfrag(VT, 72, nt * 16, ks * 32, lane), b = ldfrag(ATT, 72, mt * 16, ks * 32, lane); acc = MFMA16(a, b, acc); }
#pragma unroll
            for (int ks = 0; ks < 2; ++ks) { const bf16x8 a = ldfrag(ST, 72, nt * 16, ks * 32, lane), b = ldfrag(QE, 72, mt * 16, ks * 32, lane); acc = MFMA16(a, b, acc); }
#ifdef DBG_GLA
            for (int j = 0; j < 4; ++j) if (!(fabsf(acc[j]) < 1e30f)) dbgc |= 32u;
#endif
            const int i = mt * 16 + l15; const int t = dir ? (t0 + 63 - i) : (t0 + i);
            uint2 w; w.x = cvt_pk_bf16(acc[0], acc[1]); w.y = cvt_pk_bf16(acc[2], acc[3]);
            pend_w = w; pend_ptr = O + (size_t)t * 512 + h * 128 + sl * 32 + nt * 16 + quad * 4;
        }
        {
#pragma unroll
            for (int j = 0; j < 4; ++j) Sacc[j] *= DEC[mt * 16 + quad * 4 + j];
#pragma unroll
            for (int ks = 0; ks < 2; ++ks) { const bf16x8 a = ldfrag(KDT, 72, mt * 16, ks * 32, lane), b = ldfrag(VT, 72, nt * 16, ks * 32, lane); Sacc = MFMA16(a, b, Sacc); }
        }
        lds_barrier();
    }
    *(uint2*)pend_ptr = pend_w;
    if (s < 16) {
        float* so = p.out + (size_t)T_TOK * 1024 + ((size_t)((s * 2 + dir) * 4 + h) * 64) * 128;
#pragma unroll
        for (int j = 0; j < 4; ++j) so[(mt * 16 + quad * 4 + j) * 128 + sl * 32 + nt * 16 + l15] = Sacc[j];
    }
}

__device__ __forceinline__ void phase_mix_even(const Params& p, unsigned char* shm) {
    constexpr int N_GLA = 640, N_ALL = 1280;
    if (gridDim.x == 256) {
        if (blockIdx.x < 128) gla_item(p, shm, blockIdx.x);
        else for (int it = 128 + (blockIdx.x - 128); it < N_ALL; it += 128) { if (it < N_GLA) gla_item(p, shm, it); else sgu_item(p, shm, it - N_GLA); }
    } else {
        for (int it = blockIdx.x; it < N_ALL; it += gridDim.x) { if (it < N_GLA) gla_item(p, shm, it); else sgu_item(p, shm, it - N_GLA); }
    }
}

template <int PASS>
__device__ __forceinline__ void phase_rg(const Params& p, unsigned char* shm) {
    const int tid = otid(), lane = tid & 63, wid = tid >> 6, quad = lane >> 4, l15 = lane & 15;
    const bf16_t* rgp = (const bf16_t*)(p.ws + WS_BIG + BIG_RGP);
    unsigned short* WG = (unsigned short*)(shm);
    float* XC = (float*)(shm + 36864);
    float* AF = (float*)(shm + 53248); float* BF = AF + 4096; float* AB = BF + 4096; float* BB = AB + 4096;
    unsigned short* XCB = (unsigned short*)(shm + 118784);
    unsigned short* XB = (unsigned short*)(shm + 128000);
    float2* SG = (float2*)(shm + 136576);
    const int row = tid >> 3, c8 = (tid & 7) * 8;
    const int jt = wid & 3, tp = wid >> 2;
    int cur_hb = -1;
    float sp[2], ba[2], bx[2], cbv[8], cwv[4][8];
    u32x4 xreg = (u32x4){0, 0, 0, 0}, xreg2 = (u32x4){0, 0, 0, 0}, greg = (u32x4){0, 0, 0, 0};
    auto issue = [&](int item) {
        const int c = item >> 4, hb = item & 15, t0 = c * 64;
        const int s_lo = (t0 < T_PROMPT) ? (t0 & ~255) : (T_PROMPT + ((t0 - T_PROMPT) & ~4095));
        const int s_hi = s_lo + ((t0 < T_PROMPT) ? 256 : 4096);
        const int tt = t0 - 2 + row;
        xreg = (u32x4){0, 0, 0, 0};
        if (tt >= s_lo && tt < s_hi) xreg = *(const u32x4*)(rgp + (size_t)tt * 2048 + hb * 64 + c8);
        if (tid < 24) {
            const int t2 = t0 + 62 + (tid >> 3);
            xreg2 = (u32x4){0, 0, 0, 0};
            if (t2 >= s_lo && t2 < s_hi) xreg2 = *(const u32x4*)(rgp + (size_t)t2 * 2048 + hb * 64 + c8);
        }
        if (PASS == 1) greg = *(const u32x4*)(rgp + (size_t)(t0 + row) * 2048 + 1024 + hb * 64 + c8);
    };
    u32x4 pend_w = (u32x4){0, 0, 0, 0}; bf16_t* pend_ptr = nullptr; float pend_a = 0.f, pend_b = 0.f; float* pend_s = nullptr;
    int item = blockIdx.x;
    if (item < 5120) issue(item);
    for (; item < 5120; item += gridDim.x) {
        const int c = item >> 4, hb = item & 15, t0 = c * 64;
        if (hb != cur_hb) {
            lds_barrier();
            cur_hb = hb;
            const bf16_t* wg = (const bf16_t*)(p.ws + WS_WRGG) + (size_t)hb * 256 * 64;
#pragma unroll
            for (int i = 0; i < 4; ++i) { const int e = tid + 512 * i, r = e >> 3, cc = (e & 7) * 8; *(u32x4*)(WG + r * 72 + cc) = *(const u32x4*)(wg + r * 64 + cc); }
            const int gch = hb * 64 + jt * 16 + l15;
#pragma unroll
            for (int d = 0; d < 2; ++d) {
                const float lam = p.in[29][d * 1024 + gch];
                sp[d] = 8.0f * (fmaxf(-lam, 0.f) + __logf(1.0f + __expf(-fabsf(lam))));
                ba[d] = p.in[26][d * 1024 + gch]; bx[d] = p.in[28][d * 1024 + gch];
            }
#pragma unroll
            for (int j = 0; j < 8; ++j) { cbv[j] = p.in[24][hb * 64 + c8 + j];
#pragma unroll
                for (int tap = 0; tap < 4; ++tap) cwv[tap][j] = p.in[23][tap * 1024 + hb * 64 + c8 + j]; }
        }
        *(u32x4*)(XB + row * 64 + c8) = xreg;
        if (tid < 24) *(u32x4*)(XB + (64 + (tid >> 3)) * 64 + c8) = xreg2;
        const u32x4 gg = greg;
        if (PASS == 0) { if (pend_s) { pend_s[0] = pend_a; pend_s[1024] = pend_b; } } else { if (pend_ptr) *(u32x4*)pend_ptr = pend_w; }
        if (item + (int)gridDim.x < 5120) issue(item + gridDim.x);
        lds_barrier();
        {
            float xc[8];
#pragma unroll
            for (int j = 0; j < 8; ++j) xc[j] = cbv[j];
#pragma unroll
            for (int tap = 0; tap < 4; ++tap) {
                const u32x4 v = *(const u32x4*)(XB + (row + tap) * 64 + c8);
#pragma unroll
                for (int j = 0; j < 4; ++j) { xc[2 * j] += cwv[tap][2 * j] * bflo(v[j]); xc[2 * j + 1] += cwv[tap][2 * j + 1] * bfhi(v[j]); }
            }
            *(f32x4*)(XC + row * 64 + c8) = (f32x4){xc[0], xc[1], xc[2], xc[3]};
            *(f32x4*)(XC + row * 64 + c8 + 4) = (f32x4){xc[4], xc[5], xc[6], xc[7]};
            u32x4 w; w.x = cvt_pk_bf16(xc[0], xc[1]); w.y = cvt_pk_bf16(xc[2], xc[3]); w.z = cvt_pk_bf16(xc[4], xc[5]); w.w = cvt_pk_bf16(xc[6], xc[7]);
            *(u32x4*)(XCB + row * 72 + c8) = w;
        }
        lds_barrier();
        {
            f32x4 acc[2][4];
#pragma unroll
            for (int a = 0; a < 2; ++a)
#pragma unroll
                for (int b = 0; b < 4; ++b) acc[a][b] = (f32x4){0.f, 0.f, 0.f, 0.f};
#pragma unroll
            for (int ks = 0; ks < 2; ++ks) {
                const bf16x8 a0 = ldfrag(XCB, 72, (2 * tp) * 16, ks * 32, lane), a1 = ldfrag(XCB, 72, (2 * tp + 1) * 16, ks * 32, lane);
#pragma unroll
                for (int mat = 0; mat < 4; ++mat) { const bf16x8 b = ldfrag(WG, 72, mat * 64 + jt * 16, ks * 32, lane); acc[0][mat] = MFMA16(a0, b, acc[0][mat]); acc[1][mat] = MFMA16(a1, b, acc[1][mat]); }
            }
            const int ch = jt * 16 + l15;
#pragma unroll
            for (int t2 = 0; t2 < 2; ++t2)
#pragma unroll
                for (int j = 0; j < 4; ++j) {
                    const int tok = (2 * tp + t2) * 16 + quad * 4 + j;
                    const float x = XC[tok * 64 + ch];
#pragma unroll
                    for (int d = 0; d < 2; ++d) {
                        const float e1 = fexp(-(acc[t2][2 * d][j] + ba[d])), e2 = fexp(-(acc[t2][2 * d + 1][j] + bx[d]));
                        const float p1 = 1.0f + e1, p2 = 1.0f + e2, inv = __builtin_amdgcn_rcpf(p1 * p2);
                        const float r = p2 * inv, ig = p1 * inv;
                        const float a = fexp(-r * sp[d]);
                        const float bt = __builtin_amdgcn_sqrtf(fmaxf(1.0f - a * a, 0.f)) * ig * x;
                        (d ? AB : AF)[tok * 64 + ch] = a; (d ? BB : BF)[tok * 64 + ch] = bt;
                    }
                }
        }
        lds_barrier();
        {
            const int ch = tid & 63, d = (tid >> 6) & 1, q = tid >> 7;
            const float* Ap = d ? AB : AF; float* Bp = d ? BB : BF;
            float av[16], bv[16];
#pragma unroll
            for (int i = 0; i < 16; ++i) { const int st = q * 16 + i, tok = d ? 63 - st : st; av[i] = Ap[tok * 64 + ch]; bv[i] = Bp[tok * 64 + ch]; }
            float A = 1.f, B = 0.f;
#pragma unroll
            for (int i = 0; i < 16; ++i) { B = av[i] * B + bv[i]; A *= av[i]; }
            SG[(q * 2 + d) * 64 + ch] = make_float2(A, B);
            lds_barrier();
            if (PASS == 0) {
                if (q == 0) {
                    float A2 = 1.f, B2 = 0.f;
#pragma unroll
                    for (int k = 0; k < 4; ++k) { const float2 sg = SG[(k * 2 + d) * 64 + ch]; B2 = sg.x * B2 + sg.y; A2 *= sg.x; }
                    pend_s = (float*)(p.ws + WS_BIG + BIG_RGSUM) + (size_t)(c * 2 + d) * 2048 + hb * 64 + ch; pend_a = A2; pend_b = B2;
                }
            } else {
                float hcur = ((const float*)(p.ws + WS_BIG + BIG_RGCAR))[(size_t)(c * 2 + d) * 1024 + hb * 64 + ch];
                for (int k = 0; k < q; ++k) { const float2 sg = SG[(k * 2 + d) * 64 + ch]; hcur = sg.x * hcur + sg.y; }
#pragma unroll
                for (int i = 0; i < 16; ++i) { const int st = q * 16 + i, tok = d ? 63 - st : st; hcur = av[i] * hcur + bv[i]; Bp[tok * 64 + ch] = hcur; }
            }
        }
        if (PASS == 1) {
            lds_barrier();
            {
                const int t = t0 + row;
                const f32x4 f0 = *(const f32x4*)(BF + row * 64 + c8), f1 = *(const f32x4*)(BF + row * 64 + c8 + 4);
                const f32x4 b0 = *(const f32x4*)(BB + row * 64 + c8), b1 = *(const f32x4*)(BB + row * 64 + c8 + 4);
                u32x4 w;
                w.x = cvt_pk_bf16((f0[0] + b0[0]) * bflo(gg[0]), (f0[1] + b0[1]) * bfhi(gg[0]));
                w.y = cvt_pk_bf16((f0[2] + b0[2]) * bflo(gg[1]), (f0[3] + b0[3]) * bfhi(gg[1]));
                w.z = cvt_pk_bf16((f1[0] + b1[0]) * bflo(gg[2]), (f1[1] + b1[1]) * bfhi(gg[2]));
                w.w = cvt_pk_bf16((f1[2] + b1[2]) * bflo(gg[3]), (f1[3] + b1[3]) * bfhi(gg[3]));
                pend_w = w; pend_ptr = (bf16_t*)(p.ws + WS_ABUF) + (size_t)t * 1024 + hb * 64 + c8;
            }
        }
    }
    if (PASS == 0) { if (pend_s) { pend_s[0] = pend_a; pend_s[1024] = pend_b; } } else { if (pend_ptr) *(u32x4*)pend_ptr = pend_w; }
    lds_barrier();
}

__device__ __forceinline__ void phase_rg_carry(const Params& p) {
    const int idx = blockIdx.x * 512 + otid();
    for (int e = idx; e < 20 * 2 * 1024; e += gridDim.x * 512) {
        const int s = e >> 11, d = (e >> 10) & 1, ch = e & 1023;
        const int nc = (s < 16) ? 4 : 64, cbase = (s < 16) ? s * 4 : 64 + (s - 16) * 64;
        const float* sum = (const float*)(p.ws + WS_BIG + BIG_RGSUM);
        float* car = (float*)(p.ws + WS_BIG + BIG_RGCAR);
        float h = (s < 16) ? 0.f : p.in[4][((s - 16) * 2 + d) * 1024 + ch];
        for (int n0 = 0; n0 < nc; n0 += 4) {
            float A[4], B[4];
#pragma unroll
            for (int j = 0; j < 4; ++j) { const int n = d ? (nc - 1 - (n0 + j)) : (n0 + j); const float* sp = sum + (size_t)((cbase + n) * 2 + d) * 2048 + ch; A[j] = sp[0]; B[j] = sp[1024]; }
#pragma unroll
            for (int j = 0; j < 4; ++j) { const int n = d ? (nc - 1 - (n0 + j)) : (n0 + j); car[(size_t)((cbase + n) * 2 + d) * 1024 + ch] = h; h = A[j] * h + B[j]; }
        }
        if (s < 16) p.out[(size_t)T_TOK * 1024 + 1048576 + (s * 2 + d) * 1024 + ch] = h;
    }
}

#define XB_TMO      128
#define XB_XCNT(j)  (256  + 64 * (j))
#define XB_XSUB(j)  (1280 + 64 * (j))
#define XB_XGEN(j)  (2304 + 64 * (j))
#define XB_TOP      3328
#define XB_TOPGEN   3392
#define XCD_BAR_WORDS 3456
#define XB_SPIN_CAP (1u << 18)
#define LAS __attribute__((address_space(3)))

__device__ __forceinline__ unsigned xb_ld(unsigned* p)              { return __hip_atomic_load(p, __ATOMIC_RELAXED, __HIP_MEMORY_SCOPE_AGENT); }
__device__ __forceinline__ unsigned xb_add(unsigned* p, unsigned v) { return __hip_atomic_fetch_add(p, v, __ATOMIC_RELAXED, __HIP_MEMORY_SCOPE_AGENT); }
__device__ __forceinline__ unsigned xb_xcc_id() { return (unsigned)__builtin_amdgcn_s_getreg((3 << 11) | 20) & 0xFu; }
#define XB_SPIN(cond, bar) do { unsigned _sp = 0; while (cond) { __builtin_amdgcn_s_sleep(1); \
    if ((++_sp & 255u) == 0u) { if (xb_ld(&(bar)[XB_TMO])) break; if (_sp > XB_SPIN_CAP) { atomicAdd(&(bar)[XB_TMO], 1u); break; } } } } while (0)

struct XcdBarrier {
    unsigned* bar; unsigned x;
    volatile LAS unsigned* st;
};

__device__ __forceinline__ XcdBarrier xcd_barrier_post(unsigned* bar, volatile LAS unsigned* st) {
    XcdBarrier b; b.bar = bar; b.x = xb_xcc_id(); b.st = st;
    if (threadIdx.x == 0) (void)xb_add(&bar[XB_XCNT(b.x)], 1u);
    return b;
}
__device__ __forceinline__ void xcd_barrier_complete(unsigned* bar, unsigned x, unsigned& nloc, unsigned& nx) {
    const unsigned G = gridDim.x * gridDim.y * gridDim.z;
    unsigned sum, cnt, mine, sp = 0u;
    for (;;) {
        sum = 0u; cnt = 0u; mine = 0u;
#pragma unroll
        for (unsigned j = 0; j < 16; ++j) { const unsigned c = xb_ld(&bar[XB_XCNT(j)]); sum += c; cnt += (c > 0u) ? 1u : 0u; mine = (j == x) ? c : mine; }
        if (sum == G) break;
        __builtin_amdgcn_s_sleep(1);
        if ((++sp & 255u) == 0u) { if (xb_ld(&bar[XB_TMO])) break; if (sp > XB_SPIN_CAP) { atomicAdd(&bar[XB_TMO], 1u); break; } }
    }
    nloc = mine > 0u ? mine : 1u; nx = cnt > 0u ? cnt : 1u;
}

__device__ __forceinline__ void xcd_barrier(const XcdBarrier& b) {
    asm volatile("s_waitcnt vmcnt(0)" ::: "memory");
    __syncthreads();
    if (threadIdx.x == 0) {
        unsigned* bar = b.bar;
        __builtin_amdgcn_s_waitcnt(0);
        unsigned nloc = b.st[0], nx = b.st[1];
        if (nloc == 0u) { xcd_barrier_complete(bar, b.x, nloc, nx); b.st[0] = nloc; b.st[1] = nx; }
        const unsigned old = xb_add(&bar[XB_XSUB(b.x)], 1u);
        const unsigned gen = old / nloc;
        if (old + 1u == (gen + 1u) * nloc) {
            __builtin_amdgcn_fence(__ATOMIC_RELEASE, "agent");
            asm volatile("s_waitcnt vmcnt(0)" ::: "memory");
            const unsigned og = xb_add(&bar[XB_TOP], 1u);
            const unsigned tg = og / nx;
            if (og + 1u == (tg + 1u) * nx) xb_add(&bar[XB_TOPGEN], 1u);
            else XB_SPIN(xb_ld(&bar[XB_TOPGEN]) == tg, bar);
            __builtin_amdgcn_fence(__ATOMIC_ACQUIRE, "agent");
            xb_add(&bar[XB_XGEN(b.x)], 1u);
            asm volatile("s_waitcnt vmcnt(0)" ::: "memory");
        } else {
            XB_SPIN(xb_ld(&bar[XB_XGEN(b.x)]) == gen, bar);
            __builtin_amdgcn_fence(__ATOMIC_ACQUIRE, "agent");
            asm volatile("s_waitcnt vmcnt(0)" ::: "memory");
        }
    }
    __syncthreads();
}

constexpr size_t WS_CNT = WS_BAR + 14336;
__device__ __forceinline__ void xcd_arrive(unsigned* xcnt, unsigned* gcnt, const XcdBarrier& xb) {
    asm volatile("s_waitcnt vmcnt(0)" ::: "memory");
    __syncthreads();
    if (threadIdx.x == 0) {
        const unsigned nloc = xb.st[0];
        const unsigned old = __hip_atomic_fetch_add(xcnt + xb.x, 1u, __ATOMIC_RELAXED, __HIP_MEMORY_SCOPE_AGENT);
        if (old + 1u == nloc) {
            __builtin_amdgcn_fence(__ATOMIC_RELEASE, "agent");
            asm volatile("s_waitcnt vmcnt(0)" ::: "memory");
            __hip_atomic_fetch_add(gcnt, nloc, __ATOMIC_RELAXED, __HIP_MEMORY_SCOPE_AGENT);
        }
    }
}
__device__ __forceinline__ void wg_wait(unsigned* cnt, unsigned need) {
    if (threadIdx.x == 0) {
        unsigned sp = 0;
        while (__hip_atomic_load(cnt, __ATOMIC_RELAXED, __HIP_MEMORY_SCOPE_AGENT) < need) { __builtin_amdgcn_s_sleep(10); if (++sp > (1u << 20)) break; }
        __builtin_amdgcn_fence(__ATOMIC_ACQUIRE, "agent");
        asm volatile("s_waitcnt vmcnt(0)" ::: "memory");
    }
    __syncthreads();
}

__device__ __forceinline__ void run_phase(const Params& p, unsigned char* shm, int ph, int dbg, const XcdBarrier& xb) {
    const float* MOD = (const float*)(p.ws + WS_MOD);
    const float* NG = p.in[8];
    bf16_t* ABUF = (bf16_t*)(p.ws + WS_ABUF);
    unsigned char* BIG = p.ws + WS_BIG;
    const bool is_gemm = (ph == 2) | (ph == 5) | (ph == 7) | (ph == 8) | (ph == 10) | (ph == 14) | (ph == 16) | (ph == 17);
    if (is_gemm) {
        EpiGen E; const bf16_t* A = ABUF; const bf16_t* Bt; int N, K = 1024;
        E.bias = nullptr;
        if (ph == 2) { E.mode = 0; E.O = BIG + BIG_PROJ; E.ldc = EVN; E.ncols = EVN; Bt = (const bf16_t*)(p.ws + WS_WEVIN); N = EVNP; }
        else if (ph == 5) { E.mode = 5; E.O = BIG + BIG_Y; E.ldc = 1024; E.ncols = 1024; Bt = (const bf16_t*)(p.ws + WS_WEVOUT); N = 1024; }
        else if (ph == 14) { E.mode = 5; E.O = BIG + BIG_Y; E.ldc = 1024; E.ncols = 1024; Bt = (const bf16_t*)(p.ws + WS_WRGOUT); N = 1024; }
        else if (ph == 10) { E.mode = 3; E.O = BIG + BIG_RGP; E.ldc = 2048; E.ncols = 2048; Bt = (const bf16_t*)(p.ws + WS_WRGIN); N = 2048; }
        else if (ph == 7 || ph == 16) { const int l = (ph == 16); E.mode = 1; E.O = BIG + BIG_H; E.ldc = 4096; E.ncols = 4096; E.bias = p.in[10] + l * 4096; Bt = (const bf16_t*)(p.ws + WS_WMLP1) + (size_t)l * 4096 * 1024; N = 4096; }
        else { const int l = (ph == 17); E.mode = 2; E.O = ABUF; E.ldc = 1024; E.ncols = 1024; E.bias = p.in[12] + l * 1024; A = (const bf16_t*)(BIG + BIG_H); Bt = (const bf16_t*)(p.ws + WS_WMLP2) + (size_t)l * 1024 * 4096; N = 1024; K = 4096; }
        if ((E.mode == 2 || E.mode == 5) && gridDim.x == 256) {
            unsigned* xcA = (unsigned*)(p.ws + WS_CNT) + 128 * (ph == 5 ? 0 : ph == 8 ? 1 : ph == 14 ? 2 : 3);
            unsigned* cntA = xcA + 64;
            const int nb = (E.mode == 2) ? 128 : 64;
            const int hsplit = 16384;
            run_gemm(shm, A, Bt, 16384, 1024, K, K, 256, (int)blockIdx.x, E);
            xcd_arrive(xcA, cntA, xb);
            if ((int)blockIdx.x < nb) {
                if (E.mode == 2) {
                    const int sp = blockIdx.x & 1;
                    EpiGen E2 = E;
                    E2.O = sp ? (void*)(p.ws + WS_SCR) : (void*)((bf16_t*)E.O + (size_t)16384 * 1024);
                    E2.bias = sp ? nullptr : E.bias;
                    run_gemm(shm, A + (size_t)16384 * 4096 + sp * 2048, Bt + sp * 2048, 4096, 1024, 2048, 4096, 64, (int)(blockIdx.x >> 1), E2);
                } else {
                    EpiGen E2 = E; E2.O = (void*)((bf16_t*)E.O + (size_t)16384 * 1024);
                    run_gemm(shm, A + (size_t)16384 * 1024, Bt, 4096, 1024, 1024, 1024, 64, (int)blockIdx.x, E2);
                }
            } else {
                wg_wait(cntA, 256u);
                const int w0 = nb * 8, nwv = (256 - nb) * 8;
                if (ph == 5) phase_row<2, true, true, true>(p, BIG + BIG_Y, NG + 1 * 1024, MOD + 2048, NG + 2 * 1024, MOD, 3072, 4096, false, 0, hsplit, w0, nwv);
                else if (ph == 8) phase_row<2, true>(p, ABUF, NG + 3 * 1024, MOD + 5120, NG + 4 * 1024, MOD + 5 * 6144, 0, 1024, true, 0, hsplit, w0, nwv);
                else if (ph == 14) phase_row<2, true>(p, BIG + BIG_Y, NG + 5 * 1024, MOD + 5 * 6144 + 2048, NG + 6 * 1024, MOD + 5 * 6144, 3072, 4096, false, 0, hsplit, w0, nwv);
                else phase_row<2, false>(p, ABUF, NG + 7 * 1024, MOD + 5 * 6144 + 5120, nullptr, nullptr, 0, 0, true, 0, hsplit, w0, nwv);
            }
            xcd_barrier(xb);
            if (ph == 5) phase_row<2, true, true, true>(p, BIG + BIG_Y, NG + 1 * 1024, MOD + 2048, NG + 2 * 1024, MOD, 3072, 4096, false, hsplit, T_TOK, 0, 0);
            else if (ph == 8) phase_row<2, true>(p, ABUF, NG + 3 * 1024, MOD + 5120, NG + 4 * 1024, MOD + 5 * 6144, 0, 1024, true, hsplit, T_TOK, 0, 0);
            else if (ph == 14) phase_row<2, true>(p, BIG + BIG_Y, NG + 5 * 1024, MOD + 5 * 6144 + 2048, NG + 6 * 1024, MOD + 5 * 6144, 3072, 4096, false, hsplit, T_TOK, 0, 0);
            else phase_row<2, false>(p, ABUF, NG + 7 * 1024, MOD + 5 * 6144 + 5120, nullptr, nullptr, 0, 0, true, hsplit, T_TOK, 0, 0);
            return;
        }
        run_gemm(shm, A, Bt, T_TOK, N, K, K, (int)gridDim.x, (int)blockIdx.x, E);
        if (gridDim.x == 256) {
            if (ph == 2 && blockIdx.x >= 112) for (int d = (int)blockIdx.x - 112; d < 704; d += 144) convert_weight_tile(p, (float*)shm, deferred1_tile(d));
            if (ph == 10 && blockIdx.x >= 128) for (int d = (int)blockIdx.x - 128; d < 512; d += 128) convert_weight_tile(p, (float*)shm, deferred2_tile(d));
        }
        return;
    }
    switch (ph) {
    case 0: phase_prep(p, shm); break;
    case 1: phase_row<0, true, false, false>(p, nullptr, nullptr, nullptr, NG + 0 * 1024, MOD, 0, 1024, false); break;
    case 3: phase_mix_even(p, shm); break;
#ifdef EXTRA_PH
    case 60: if (blockIdx.x < 128) gla_item(p, shm, blockIdx.x); break;
    case 61: if (blockIdx.x >= 128) for (int it = blockIdx.x; it < 1280; it += 128) { if (it < 640) gla_item(p, shm, it); else sgu_item(p, shm, it - 640); } break;
    case 62: if (blockIdx.x >= 128) for (int it = blockIdx.x; it < 640; it += 128) gla_item(p, shm, it); break;
#endif
    case 4: phase_gla_combine(p); break;
    case 6: phase_row<2, true, true, true>(p, BIG + BIG_Y, NG + 1 * 1024, MOD + 2048, NG + 2 * 1024, MOD, 3072, 4096, false); break;
    case 9: phase_row<2, true>(p, ABUF, NG + 3 * 1024, MOD + 5120, NG + 4 * 1024, MOD + 5 * 6144, 0, 1024, true); break;
    case 11: phase_rg<0>(p, shm); break;
    case 12: phase_rg_carry(p); break;
    case 13: phase_rg<1>(p, shm); break;
    case 15: phase_row<2, true>(p, BIG + BIG_Y, NG + 5 * 1024, MOD + 5 * 6144 + 2048, NG + 6 * 1024, MOD + 5 * 6144, 3072, 4096, false); break;
    case 18: phase_row<2, false>(p, ABUF, NG + 7 * 1024, MOD + 5 * 6144 + 5120, nullptr, nullptr, 0, 0, true); break;
#ifdef DBG_PROBE
    case 97: {
        const int k = dbg;
        unsigned* flag = (unsigned*)(p.ws + WS_END);
        bool bad = false;
        const size_t g0 = (size_t)blockIdx.x * 512 + otid(), gs = (size_t)gridDim.x * 512;
        for (size_t i = g0; i < (size_t)T_TOK * 1024; i += gs) { if (!(fabsf(p.out[i]) < 1e30f)) bad = true; }
        if (k >= 1) for (size_t i = g0; i < (size_t)T_TOK * 1024; i += gs) { if ((((const unsigned short*)(p.ws + WS_ABUF))[i] & 0x7f80u) == 0x7f80u) bad = true; }
        const unsigned char* b = nullptr; size_t n = 0; bool f32 = false;
        if (k == 0) { b = p.ws + WS_MOD; n = 61440; f32 = true; }
        else if (k == 2) { b = BIG + BIG_PROJ; n = (size_t)T_TOK * EVN; }
        else if (k == 3) { b = BIG + BIG_OF; n = (size_t)T_TOK * 1024; }
        else if (k == 5 || k == 14) { b = BIG + BIG_Y; n = (size_t)T_TOK * 1024; f32 = true; }
        else if (k == 7 || k == 16) { b = BIG + BIG_H; n = (size_t)T_TOK * 4096; }
        else if (k == 10) { b = BIG + BIG_RGP; n = (size_t)T_TOK * 2048; }
        else if (k == 11) { b = BIG + BIG_RGSUM; n = (size_t)320 * 4096; f32 = true; }
        else if (k == 12) { b = BIG + BIG_RGCAR; n = (size_t)320 * 2048; f32 = true; }
        for (size_t i = g0; i < n; i += gs) { if (f32) { if (!(fabsf(((const float*)b)[i]) < 1e30f)) bad = true; } else { if ((((const unsigned short*)b)[i] & 0x7f80u) == 0x7f80u) bad = true; } }
        if (bad) atomicMin(flag, (unsigned)k);
    } break;
    case 95: {
        unsigned* flag = (unsigned*)(p.ws + WS_END);
        unsigned code = 0;
        const size_t g0 = (size_t)blockIdx.x * 512 + otid(), gs = (size_t)gridDim.x * 512;
        const unsigned short* ab = (const unsigned short*)(p.ws + WS_ABUF);
        const unsigned short* of = (const unsigned short*)(BIG + BIG_OF);
        const unsigned short* ob = (const unsigned short*)(BIG + BIG_OB);
        for (size_t i = g0; i < (size_t)T_TOK * 512; i += gs) {
            const size_t t = i >> 9, c = i & 511;
            unsigned cc = 0;
            if ((ab[t * 1024 + c] & 0x7f80u) == 0x7f80u) cc |= 1u;
            if ((of[i] & 0x7f80u) == 0x7f80u) cc |= 2u;
            if ((ob[i] & 0x7f80u) == 0x7f80u) cc |= 4u;
            if (cc) cc |= (t < T_PROMPT) ? 8u : 16u;
            code |= cc;
        }
        if (dbg >= 100) { if (code & 6u) atomicOr(flag + 1, 1u << (dbg - 100)); } else if (code) atomicOr(flag + 1, code);
    } break;
    case 94: {
        const unsigned f = ((const unsigned*)(p.ws + WS_END))[1];
        const float v = 1000.0f * (float)(f + 1);
        for (size_t i = (size_t)blockIdx.x * 512 + otid(); i < (size_t)22052864; i += (size_t)gridDim.x * 512) p.out[i] = v;
    } break;
    case 93: break;
    case 96: {
        const unsigned f = *(const unsigned*)(p.ws + WS_END);
        const float v = (f > 100u) ? 50000.0f : 1000.0f * (float)(f + 1);
        for (size_t i = (size_t)blockIdx.x * 512 + otid(); i < (size_t)22052864; i += (size_t)gridDim.x * 512) p.out[i] = v;
    } break;
    case 98: {
        for (size_t i = (size_t)blockIdx.x * 512 + otid(); i < (size_t)22052864; i += (size_t)gridDim.x * 512) {
            const float v = p.out[i];
            if (!(fabsf(v) < 1e30f)) p.out[i] = 12345.0f;
        }
    } break;
    case 99: {
        const unsigned short* a = (const unsigned short*)p.ws;
        const size_t NOUT = 22052864, NW = WS_END / 2;
        for (size_t i = (size_t)blockIdx.x * 512 + otid(); i < NOUT; i += (size_t)gridDim.x * 512) {
            unsigned s = (i < (size_t)T_TOK * 1024) ? ((__float_as_uint(p.out[i]) >> 8) & 0xffffu) : 0u;
            for (int j = 0; j < 6; ++j) { const size_t idx = i + (size_t)j * NOUT; if (idx < NW) s += a[idx]; }
            p.out[i] = (float)s;
        }
    } break;
#endif
    default: break;
    }
}

__global__ void __launch_bounds__(512, 2) fwd_megakernel(Params p) {
    extern __shared__ __attribute__((aligned(16))) unsigned char shm[];
    cg::grid_group grid = cg::this_grid();
    volatile LAS unsigned* st = (volatile LAS unsigned*)(shm + LDS_BYTES - 16);
    if (threadIdx.x < 4) st[threadIdx.x] = 0u;
    __syncthreads();
    if (blockIdx.x == 0) { unsigned* bw = (unsigned*)(p.ws + WS_BAR); for (int i = threadIdx.x; i < 4096; i += 512) bw[i] = 0u; }
    XcdBarrier xb; xb.bar = (unsigned*)(p.ws + WS_BAR); xb.x = xb_xcc_id(); xb.st = st;
    for (int i = 0; i < p.nseq; ++i) {
        if (i == 1) { grid.sync(); if (threadIdx.x == 0) (void)xb_add(&xb.bar[XB_XCNT(xb.x)], 1u); }
        else if (i > 1) xcd_barrier(xb);
        run_phase(p, shm, (int)p.seq[i], (int)p.dbgv[i], xb);
    }
}

extern "C" void kernel_launch(void* const* d_in, const int* in_sizes, int n_in, void* d_out, int out_size, void* d_ws, size_t ws_size, hipStream_t stream) {
    static int grid_blocks = 0;
    if (!grid_blocks) {
        int dev = 0, cus = 0, per_cu = 0;
        hipGetDevice(&dev);
        hipDeviceGetAttribute(&cus, hipDeviceAttributeMultiprocessorCount, dev);
        hipFuncSetAttribute((const void*)fwd_megakernel, hipFuncAttributeMaxDynamicSharedMemorySize, LDS_BYTES);
        hipOccupancyMaxActiveBlocksPerMultiprocessor(&per_cu, (const void*)fwd_megakernel, 512, LDS_BYTES);
        if (per_cu < 1) { fprintf(stderr, "kernel_launch: occupancy query reports %d blocks per CU\n", per_cu); per_cu = 1; }
        if (per_cu > 1) per_cu = 1;
        grid_blocks = cus * per_cu;
        if (ws_size < WS_END) fprintf(stderr, "kernel_launch: workspace too small: %zu < %zu\n", ws_size, (size_t)WS_END);
    }
    Params p{};
    for (int i = 0; i < 31; ++i) p.in[i] = (const float*)d_in[i];
    p.out = (float*)d_out; p.ws = (unsigned char*)d_ws;
    int n = 0;
#if defined(DBG_PROBE) && DBG_PROBE == 1
    hipMemsetAsync((char*)d_ws + WS_END, 0xff, 16, stream);
    for (int ph = 0; ph < NPHASE; ++ph) { p.seq[n] = (unsigned char)ph; p.dbgv[n++] = 0; p.seq[n] = 97; p.dbgv[n++] = (unsigned char)ph; }
    p.seq[n] = 96; p.dbgv[n++] = 0;
#elif defined(DBG_PROBE) && DBG_PROBE == 3
    hipMemsetAsync((char*)d_ws + WS_END, 0xff, 16, stream);
    for (int ph = 0; ph < 4; ++ph) { p.seq[n] = (unsigned char)ph; p.dbgv[n++] = 0; }
    p.seq[n] = 97; p.dbgv[n++] = 3; p.seq[n] = 96; p.dbgv[n++] = 0;
#elif defined(DBG_PROBE) && DBG_PROBE == 2
    hipMemsetAsync((char*)d_ws + WS_END, 0, 16, stream);
    for (int ph = 0; ph < 4; ++ph) { p.seq[n] = (unsigned char)ph; p.dbgv[n++] = 0; }
    p.seq[n] = DBG_P4; p.dbgv[n++] = 0; p.seq[n] = 94; p.dbgv[n++] = 0;
#else
    for (int ph = 0; ph < NPHASE; ++ph) {
        if (grid_blocks == 256 && (ph == 6 || ph == 9 || ph == 15 || ph == 18)) continue;
        p.seq[n] = (unsigned char)ph; p.dbgv[n++] = 0;
#ifdef EXTRA_PH
        if (ph == 3) { p.seq[n] = EXTRA_PH; p.dbgv[n++] = 0; }
#endif
#ifdef EXTRA_SYNCS
        if (ph == 5) for (int q = 0; q < EXTRA_SYNCS; ++q) { p.seq[n] = 50; p.dbgv[n++] = 0; }
#endif
#ifdef DUP_MASK
        if ((DUP_MASK >> ph) & 1) { p.seq[n] = (unsigned char)ph; p.dbgv[n++] = 0; }
#endif
    }
#endif
    p.nseq = n;
    void* args[] = {&p};
    hipError_t e = hipLaunchCooperativeKernel((const void*)fwd_megakernel, dim3(grid_blocks), dim3(512), args, LDS_BYTES, stream);
    if (e != hipSuccess) fprintf(stderr, "cooperative launch failed: %s (grid %d)\n", hipGetErrorString(e), grid_blocks);
}
```
